# Optimizing an MI355X kernel written in HIP

```python
import math
import jax, jax.numpy as jnp
from jax import lax
import numpy as np

D_MODEL = 1024
BATCH = 16
SEQ = 2048
DEPTH = 4

A_HEADS = 8
A_HEAD_DIM = 64
A_WIDTH = A_HEADS * A_HEAD_DIM
IDX_HEADS = 4
IDX_DIM = 64
TOPK_MAX = 256
B_HEADS = 8
B_NOPE_DIM = 64
B_ROPE_DIM = 32
B_QK_DIM = B_NOPE_DIM + B_ROPE_DIM
B_V_DIM = 64
B_WIDTH = B_HEADS * B_V_DIM
Q_LORA = 256
KV_LORA = 128
ROPE_THETA = 10000.0
REL_BUCKETS = 32
REL_MAX_DIST = 128
N_BRANCHES = 2
D_FF = 4 * D_MODEL
Q_BLOCK = 128
EPS = 1e-6
NEG_INF = -1e30
IN_SIZES = (A_WIDTH, A_HEAD_DIM, A_HEAD_DIM, IDX_HEADS * IDX_DIM, IDX_DIM, IDX_HEADS,
            Q_LORA, KV_LORA, B_ROPE_DIM, N_BRANCHES * D_MODEL)
D_IN = sum(IN_SIZES)

kernel_name = "hybrid_dsa_mla_gated_trunk"


def rmsnorm(x, g):
    xf = x.astype(jnp.float32)
    y = xf * lax.rsqrt(jnp.mean(xf * xf, axis=-1, keepdims=True) + EPS)
    return (y * g.astype(jnp.float32)).astype(x.dtype)


def split_cols(z, sizes):
    cuts = [int(c) for c in np.cumsum(sizes)[:-1]]
    return jnp.split(z, cuts, axis=-1)


def rope_tables(positions):
    inv_freq = ROPE_THETA ** (-jnp.arange(0, B_ROPE_DIM, 2, dtype=jnp.float32) / B_ROPE_DIM)
    ang = positions.astype(jnp.float32)[..., None] * inv_freq
    return jnp.cos(ang), jnp.sin(ang)


def apply_rope(x, cos, sin):
    x1, x2 = jnp.split(x, 2, axis=-1)
    cos = cos.astype(x.dtype)
    sin = sin.astype(x.dtype)
    return jnp.concatenate([x1 * cos - x2 * sin, x1 * sin + x2 * cos], axis=-1)


def rel_bucket(dist):
    max_exact = REL_BUCKETS // 2
    n = jnp.maximum(dist, 0)
    nf = jnp.maximum(n.astype(jnp.float32), 1.0)
    log_b = max_exact + (jnp.log(nf / max_exact) / math.log(REL_MAX_DIST / max_exact)
                         * (REL_BUCKETS - max_exact)).astype(jnp.int32)
    return jnp.where(n < max_exact, n, jnp.minimum(log_b, REL_BUCKETS - 1))


def take_rows(arr, idx):
    return jax.vmap(lambda a, i: a[i])(arr, idx)


def dsa_sparse_attention(q, k, v, iq, ik, iw, positions, rel_table):
    bsz, L = q.shape[0], q.shape[1]
    k_top = min(TOPK_MAX, L // 4)
    key_idx = jnp.arange(L)
    ikf = ik.astype(jnp.float32)

    def one_block(bi):
        start = bi * Q_BLOCK
        qb = lax.dynamic_slice_in_dim(q, start, Q_BLOCK, axis=1)
        iqb = lax.dynamic_slice_in_dim(iq, start, Q_BLOCK, axis=1).astype(jnp.float32)
        iwb = lax.dynamic_slice_in_dim(iw, start, Q_BLOCK, axis=1).astype(jnp.float32) * IDX_HEADS ** -0.5
        posq = lax.dynamic_slice_in_dim(positions, start, Q_BLOCK, axis=1)
        q_idx = start + jnp.arange(Q_BLOCK)
        causal = key_idx[None, :] <= q_idx[:, None]
        dots = jnp.einsum('bqhd,bsd->bqhs', iqb, ikf) * IDX_DIM ** -0.5
        score = jnp.einsum('bqh,bqhs->bqs', iwb, jax.nn.relu(dots))
        score = jnp.where(causal[None], score, -jnp.inf)
        _, sel = lax.top_k(score, k_top)
        k_sel = take_rows(k, sel)
        v_sel = take_rows(v, sel)
        bias = rel_table[rel_bucket(posq[:, :, None] - take_rows(positions, sel))]
        logits = jnp.einsum('bqhd,bqkd->bqhk', qb, k_sel).astype(jnp.float32) * A_HEAD_DIM ** -0.5
        logits = logits + jnp.swapaxes(bias, 2, 3).astype(jnp.float32)
        valid = sel <= q_idx[None, :, None]
        logits = jnp.where(valid[:, :, None, :], logits, NEG_INF)
        p = jax.nn.softmax(logits, axis=-1).astype(v.dtype)
        return jnp.einsum('bqhk,bqkd->bqhd', p, v_sel)

    out = lax.map(one_block, jnp.arange(L // Q_BLOCK))
    return jnp.moveaxis(out, 0, 1).reshape(bsz, L, A_WIDTH)


def mla_attention(q_nope, q_rope, k_nope, k_rope, v):
    bsz, L = q_nope.shape[0], q_nope.shape[1]
    key_idx = jnp.arange(L)

    def one_block(bi):
        start = bi * Q_BLOCK
        qn = lax.dynamic_slice_in_dim(q_nope, start, Q_BLOCK, axis=1)
        qr = lax.dynamic_slice_in_dim(q_rope, start, Q_BLOCK, axis=1)
        q_idx = start + jnp.arange(Q_BLOCK)
        logits = (jnp.einsum('bqhd,bshd->bhqs', qn, k_nope)
                  + jnp.einsum('bqhr,bsr->bhqs', qr, k_rope)).astype(jnp.float32) * B_QK_DIM ** -0.5
        causal = key_idx[None, :] <= q_idx[:, None]
        logits = jnp.where(causal[None, None], logits, NEG_INF)
        p = jax.nn.softmax(logits, axis=-1).astype(v.dtype)
        return jnp.einsum('bhqs,bshd->bqhd', p, v)

    out = lax.map(one_block, jnp.arange(L // Q_BLOCK))
    return jnp.moveaxis(out, 0, 1).reshape(bsz, L, B_WIDTH)


def setup_inputs(seed: int = 0) -> dict:
    key = jax.random.key(seed)
    ks = jax.random.split(key, 20)
    f32 = jnp.float32

    def nrm(k, shape, scale):
        return jax.random.normal(k, shape, f32) * scale

    def gain(k, shape):
        return 1.0 + 0.02 * jax.random.normal(k, shape, f32)

    x = jax.random.normal(ks[0], (BATCH, SEQ, D_MODEL), f32)
    offset = jax.random.randint(ks[1], (BATCH, 1), 0, 4096, dtype=jnp.int32)
    positions = offset + jnp.arange(SEQ, dtype=jnp.int32)[None, :]
    return {
        "x": x,
        "positions": positions,
        "attn_norm_g": gain(ks[2], (DEPTH, D_MODEL)),
        "w_in": nrm(ks[3], (DEPTH, D_MODEL, D_IN), D_MODEL ** -0.5),
        "b_gate": nrm(ks[4], (DEPTH, N_BRANCHES * D_MODEL), 0.02),
        "q_latent_norm_g": gain(ks[5], (DEPTH, Q_LORA)),
        "kv_latent_norm_g": gain(ks[6], (DEPTH, KV_LORA)),
        "w_uq": nrm(ks[7], (DEPTH, Q_LORA, B_HEADS * B_QK_DIM), Q_LORA ** -0.5),
        "w_ukv": nrm(ks[8], (DEPTH, KV_LORA, B_HEADS * (B_NOPE_DIM + B_V_DIM)), KV_LORA ** -0.5),
        "w_branch_a": nrm(ks[9], (DEPTH, A_WIDTH, D_MODEL), A_WIDTH ** -0.5),
        "w_branch_b": nrm(ks[10], (DEPTH, B_WIDTH, D_MODEL), B_WIDTH ** -0.5),
        "w_out": nrm(ks[11], (DEPTH, D_MODEL, D_MODEL), D_MODEL ** -0.5),
        "mlp_norm_g": gain(ks[12], (DEPTH, D_MODEL)),
        "w_ff1": nrm(ks[13], (DEPTH, D_MODEL, D_FF), D_MODEL ** -0.5),
        "w_ff2": nrm(ks[14], (DEPTH, D_FF, D_MODEL), D_FF ** -0.5),
        "rel_bias": nrm(ks[15], (REL_BUCKETS, A_HEADS), 0.5),
        "final_norm_g": gain(ks[16], (D_MODEL,)),
    }


def reference(x, positions, attn_norm_g, w_in, b_gate, q_latent_norm_g, kv_latent_norm_g,
              w_uq, w_ukv, w_branch_a, w_branch_b, w_out, mlp_norm_g, w_ff1, w_ff2,
              rel_bias, final_norm_g):
    bsz, L, _ = x.shape
    cos, sin = rope_tables(positions)
    for l in range(DEPTH):
        h = rmsnorm(x, attn_norm_g[l])
        z = h @ w_in[l]
        a_q, a_k, a_v, i_q, i_k, i_w, c_q, c_kv, k_r, g = split_cols(z, IN_SIZES)
        y_a = dsa_sparse_attention(a_q.reshape(bsz, L, A_HEADS, A_HEAD_DIM), a_k, a_v,
                                   i_q.reshape(bsz, L, IDX_HEADS, IDX_DIM), i_k, i_w,
                                   positions, rel_bias)
        qb = (rmsnorm(c_q, q_latent_norm_g[l]) @ w_uq[l]).reshape(bsz, L, B_HEADS, B_QK_DIM)
        q_nope, q_rope = jnp.split(qb, [B_NOPE_DIM], axis=-1)
        q_rope = apply_rope(q_rope, cos[:, :, None], sin[:, :, None])
        kvb = (rmsnorm(c_kv, kv_latent_norm_g[l]) @ w_ukv[l]).reshape(bsz, L, B_HEADS, B_NOPE_DIM + B_V_DIM)
        k_nope, v_b = jnp.split(kvb, [B_NOPE_DIM], axis=-1)
        k_rope = apply_rope(k_r, cos, sin)
        y_b = mla_attention(q_nope, q_rope, k_nope, k_rope, v_b)
        gates = jax.nn.sigmoid((g + b_gate[l]).astype(jnp.float32)).astype(x.dtype)
        gates = gates.reshape(bsz, L, N_BRANCHES, D_MODEL)
        merged = gates[:, :, 0] * (y_a @ w_branch_a[l]) + gates[:, :, 1] * (y_b @ w_branch_b[l])
        x = x + merged @ w_out[l]
        h2 = rmsnorm(x, mlp_norm_g[l])
        x = x + jnp.square(jax.nn.relu(h2 @ w_ff1[l])) @ w_ff2[l]
    return rmsnorm(x, final_norm_g)
```

```cpp
#include <hip/hip_runtime.h>
#include <cstdio>
#include <cstdint>
namespace pg8 {
#define PG8_LAS __attribute__((address_space(3)))
typedef unsigned short bf16_t;
typedef short bf16x8 __attribute__((ext_vector_type(8)));
typedef float f32x4 __attribute__((ext_vector_type(4)));
typedef unsigned u32x4 __attribute__((ext_vector_type(4)));
constexpr int BM = 256, BK = 64, HALF = 128, HTB = HALF * BK * 2  , STAGE_BYTES = 8 * HTB, NXCD = 8, WGM = 8;

__host__ __device__ __forceinline__ int lds_byte(int r, int c) { const int st = (r >> 4) * 2 + (c >> 5), rr = r & 15, cc = c & 31, ob = rr * 64 + cc * 2; return st * 1024 + (ob ^ (((ob >> 9) & 1) << 5)); }
__host__ __device__ __forceinline__ void stage_rc(int b, int& R, int& C) { const int st = b / 1024, sb = b % 1024, swz = sb ^ (((sb >> 9) & 1) << 5); R = (st >> 1) * 16 + swz / 64; C = (st & 1) * 32 + (swz % 64) / 2; }
__host__ __device__ __forceinline__ int perm32(int rho) { const int n = rho >> 4, i = rho & 15; return 8 * (i >> 2) + 4 * n + (i & 3); }

struct Unit { int pm, pn; };
struct Gemm { const bf16_t* A; const bf16_t* Bt; int M, N, K; };

struct StaticOrder {
    int nM, nN, nwg, G, c;
    __host__ __device__ void init(int M, int N, int G_, int c_) { nM = M / BM; nN = N / BM; nwg = nM * nN; G = G_; c = c_; }
    __host__ __device__ bool next(int i, Unit& u) const {
        const long L = (long)i * G + c; if (L >= nwg) return false;
        int wgid = (int)L; { const int q = nwg / NXCD, r = nwg % NXCD, xcd = wgid % NXCD, off = wgid / NXCD; wgid = (xcd < r ? xcd * (q + 1) : r * (q + 1) + (xcd - r) * q) + off; }
        const int nig = WGM * nN, gid = wgid / nig, fm = gid * WGM, gsz = (nM - fm) < WGM ? (nM - fm) : WGM;
        u.pm = fm + ((wgid % nig) % gsz); u.pn = (wgid % nig) / gsz; return true;
    }
    __device__ __forceinline__ void a_ready(const Unit&) const {}
    __device__ __forceinline__ void done(const Unit&) const {}
};

typedef float f32x2c_t __attribute__((ext_vector_type(2))); typedef __bf16 bf16x2c_t __attribute__((ext_vector_type(2)));
__device__ __forceinline__ unsigned cvt_pk_bf16(float lo, float hi) { const f32x2c_t v = {lo, hi}; const bf16x2c_t b = __builtin_convertvector(v, bf16x2c_t); return __builtin_bit_cast(unsigned, b); }
typedef float f32x2 __attribute__((ext_vector_type(2)));
template <class Epi, class Sched, bool ALIGN_EPI = false, bool SP2 = false>
__device__ __forceinline__ void gemm_phase(PG8_LAS unsigned char* lds, const Gemm g, const Sched& S, const Epi& E) {
    int tid_ = threadIdx.x; asm volatile("" : "+v"(tid_));
    const int tid = tid_, wid = __builtin_amdgcn_readfirstlane(tid >> 6), lane = tid & 63, wr = wid >> 2, wc = wid & 3, fr = lane & 15, fq = lane >> 4;
    int Kx_ = g.K; asm volatile("" : "+s"(Kx_)); const int K = Kx_, nt = K / BK;
    unsigned voffA[2], voffB[2];
#pragma unroll
    for (int i = 0; i < 2; ++i) { int R, C; stage_rc(tid * 16 + i * 8192, R, C); const int Rb = Epi::PERM ? ((R & ~31) + perm32(R & 31)) : R;
        voffA[i] = (unsigned)(R * K + C) * 2u; voffB[i] = (unsigned)(Rb * K + C) * 2u; }
    const size_t kstep = (size_t)(BK * 2);
    const size_t hstep = (size_t)HALF * K * 2;
    const size_t tstep = 2 * hstep;
    const unsigned ldsw = (unsigned)wid * 1024u;
    const int aoff = lds_byte(wr * 64 + fr, fq * 8), boff = lds_byte(wc * 32 + fr, fq * 8);
#define PG8_SA(b, h) (((b) * 2 + (h)) * HTB)
#define PG8_SB(b, h) ((4 + (b) * 2 + (h)) * HTB)
#define PG8_STAGE(bufoff, gbase, voff) do { _Pragma("unroll") for (int _i = 0; _i < 2; ++_i) \
        __builtin_amdgcn_global_load_lds((const unsigned*)((const char*)(gbase) + (voff)[_i]), (PG8_LAS unsigned*)(lds + (bufoff) + ldsw + _i * 8192), 16, 0, 0); } while (0)
#define PG8_LDA(dst, b, h) do { _Pragma("unroll") for (int m = 0; m < 4; ++m) _Pragma("unroll") for (int k = 0; k < 2; ++k) dst[m][k] = *(const PG8_LAS bf16x8*)(lds + PG8_SA(b, h) + aoff + m * 2048 + k * 1024); } while (0)
#define PG8_LDB(dst, b, h) do { _Pragma("unroll") for (int n = 0; n < 2; ++n) _Pragma("unroll") for (int k = 0; k < 2; ++k) dst[n][k] = *(const PG8_LAS bf16x8*)(lds + PG8_SB(b, h) + boff + n * 2048 + k * 1024); } while (0)
#define PG8_MMA(ai, bj, At, Bt) do { __builtin_amdgcn_s_setprio(1); _Pragma("unroll") for (int m = 0; m < 4; ++m) _Pragma("unroll") for (int n = 0; n < 2; ++n) _Pragma("unroll") for (int k = 0; k < 2; ++k) \
        acc[ai][bj][m][n] = __builtin_amdgcn_mfma_f32_16x16x32_bf16(Bt[n][k], At[m][k], acc[ai][bj][m][n], 0, 0, 0); __builtin_amdgcn_s_setprio(0); } while (0)
#define PG8_WAIT_V(n) asm volatile("s_waitcnt vmcnt(" #n ")" ::: "memory")
#define PG8_WAIT_L(n) asm volatile("s_waitcnt lgkmcnt(" #n ")" ::: "memory")
#define PG8_BAR __builtin_amdgcn_s_barrier()
#define PG8_SCHED __builtin_amdgcn_sched_barrier(0)
    Unit cur, nxt; int ui = 0;
    if (!S.next(0, cur)) return;
    f32x4 acc[2][2][4][2];
#pragma unroll
    for (int a = 0; a < 2; ++a)
#pragma unroll
        for (int b = 0; b < 2; ++b)
#pragma unroll
            for (int m = 0; m < 4; ++m)
#pragma unroll
                for (int n = 0; n < 2; ++n) acc[a][b][m][n] = (f32x4){0.f, 0.f, 0.f, 0.f};
    bf16x8 At[4][2], B0[2][2], B1[2][2];
    const char* cA = (const char*)g.A + (size_t)cur.pm * tstep; const char* cB = (const char*)g.Bt + (size_t)cur.pn * tstep;
    S.a_ready(cur);
    if constexpr (SP2) {
        PG8_STAGE(PG8_SB(0, 0), cB, voffB); PG8_STAGE(PG8_SB(0, 1), cB + hstep, voffB); PG8_STAGE(PG8_SA(0, 0), cA, voffA); PG8_STAGE(PG8_SA(0, 1), cA + hstep, voffA);
        if (wr == 1) PG8_BAR;
        PG8_WAIT_V(2); PG8_BAR;
        PG8_STAGE(PG8_SB(1, 0), cB + kstep, voffB); PG8_STAGE(PG8_SA(1, 0), cA + kstep, voffA); PG8_STAGE(PG8_SB(1, 1), cB + hstep + kstep, voffB);
        PG8_WAIT_V(6); PG8_BAR;
    } else {
        PG8_STAGE(PG8_SB(0, 0), cB, voffB); PG8_STAGE(PG8_SA(0, 0), cA, voffA); PG8_STAGE(PG8_SB(0, 1), cB + hstep, voffB); PG8_STAGE(PG8_SA(0, 1), cA + hstep, voffA);
        if (wr == 1) PG8_BAR;
        PG8_WAIT_V(4); PG8_BAR;
        PG8_STAGE(PG8_SB(1, 0), cB + kstep, voffB); PG8_STAGE(PG8_SA(1, 0), cA + kstep, voffA); PG8_STAGE(PG8_SB(1, 1), cB + hstep + kstep, voffB);
        PG8_WAIT_V(6); PG8_BAR;
    }
    for (;;) {
        const bool has_next = S.next(ui + 1, nxt);
        const char* nA = has_next ? (const char*)g.A + (size_t)nxt.pm * tstep : cA; const char* nB = has_next ? (const char*)g.Bt + (size_t)nxt.pn * tstep : cB;
        for (int t = 0; t < nt; t += 2) {
            const bool last = (t == nt - 2);
            const char* a1 = cA + (size_t)(t + 1) * kstep;
            const char* a2 = last ? nA : cA + (size_t)(t + 2) * kstep; const char* b2 = last ? nB : cB + (size_t)(t + 2) * kstep;
            const char* a3 = a2 + kstep; const char* b3 = b2 + kstep;
            if (last && has_next) S.a_ready(nxt);
            if constexpr (SP2) {
            PG8_LDB(B0, 0, 0); PG8_LDB(B1, 0, 1); PG8_SCHED; PG8_LDA(At, 0, 0); PG8_STAGE(PG8_SA(1, 1), a1 + hstep, voffA);
            PG8_WAIT_V(8); PG8_WAIT_L(0); PG8_BAR; PG8_MMA(0, 0, At, B0); PG8_MMA(0, 1, At, B1); PG8_BAR; PG8_SCHED;
            PG8_LDA(At, 0, 1); PG8_STAGE(PG8_SB(0, 0), b2, voffB); PG8_STAGE(PG8_SB(0, 1), b2 + hstep, voffB); PG8_STAGE(PG8_SA(0, 0), a2, voffA);
            PG8_WAIT_V(8); PG8_WAIT_L(0); PG8_BAR; PG8_MMA(1, 0, At, B0); PG8_MMA(1, 1, At, B1); PG8_BAR; PG8_SCHED;
            PG8_LDB(B0, 1, 0); PG8_LDB(B1, 1, 1); PG8_SCHED; PG8_LDA(At, 1, 0); PG8_STAGE(PG8_SA(0, 1), a2 + hstep, voffA);
            PG8_WAIT_V(8); PG8_WAIT_L(0); PG8_BAR; PG8_MMA(0, 0, At, B0); PG8_MMA(0, 1, At, B1); PG8_BAR; PG8_SCHED;
            PG8_LDA(At, 1, 1); PG8_STAGE(PG8_SB(1, 0), b3, voffB); PG8_STAGE(PG8_SB(1, 1), b3 + hstep, voffB); PG8_STAGE(PG8_SA(1, 0), a3, voffA);
            PG8_WAIT_V(8); PG8_WAIT_L(0); PG8_BAR; PG8_MMA(1, 0, At, B0); PG8_MMA(1, 1, At, B1); PG8_BAR; PG8_SCHED;
            } else {
            PG8_LDB(B0, 0, 0); PG8_SCHED; PG8_LDA(At, 0, 0); PG8_STAGE(PG8_SA(1, 1), a1 + hstep, voffA);
            PG8_WAIT_L(8); PG8_BAR; PG8_WAIT_L(0); PG8_MMA(0, 0, At, B0); PG8_BAR; PG8_SCHED;
            PG8_LDB(B1, 0, 1); PG8_STAGE(PG8_SB(0, 0), b2, voffB);
            PG8_BAR; PG8_WAIT_L(0); PG8_MMA(0, 1, At, B1); PG8_BAR;
            PG8_LDA(At, 0, 1); PG8_STAGE(PG8_SA(0, 0), a2, voffA);
            PG8_BAR; PG8_WAIT_L(0); PG8_MMA(1, 0, At, B0); PG8_BAR; PG8_SCHED;
            PG8_STAGE(PG8_SB(0, 1), b2 + hstep, voffB);
            PG8_WAIT_V(6); PG8_BAR; PG8_MMA(1, 1, At, B1); PG8_BAR;
            PG8_LDB(B0, 1, 0); PG8_SCHED; PG8_LDA(At, 1, 0); PG8_STAGE(PG8_SA(0, 1), a2 + hstep, voffA);
            PG8_WAIT_L(8); PG8_BAR; PG8_WAIT_L(0); PG8_MMA(0, 0, At, B0); PG8_BAR; PG8_SCHED;
            PG8_LDB(B1, 1, 1); PG8_STAGE(PG8_SB(1, 0), b3, voffB);
            PG8_BAR; PG8_WAIT_L(0); PG8_MMA(0, 1, At, B1); PG8_BAR;
            PG8_LDA(At, 1, 1); PG8_STAGE(PG8_SA(1, 0), a3, voffA);
            PG8_BAR; PG8_WAIT_L(0); PG8_MMA(1, 0, At, B0); PG8_BAR; PG8_SCHED;
            PG8_STAGE(PG8_SB(1, 1), b3 + hstep, voffB);
            PG8_WAIT_V(6); PG8_BAR; PG8_MMA(1, 1, At, B1); PG8_BAR;
            }
        }
        if constexpr (ALIGN_EPI) { if (wr == 0) PG8_BAR; }
        if constexpr (!Epi::AFTER_DRAIN) { E(acc, cur, wr, wc, fr, fq); S.done(cur); }
        if (!has_next) break;
#pragma unroll
        for (int a = 0; a < 2; ++a)
#pragma unroll
            for (int b = 0; b < 2; ++b)
#pragma unroll
                for (int m = 0; m < 4; ++m)
#pragma unroll
                    for (int n = 0; n < 2; ++n) acc[a][b][m][n] = (f32x4){0.f, 0.f, 0.f, 0.f};
        cur = nxt; cA = nA; cB = nB; ++ui;
        if constexpr (ALIGN_EPI) { if (wr == 1) PG8_BAR; }
    }
    PG8_WAIT_V(0);
    if constexpr (!ALIGN_EPI) { if (wr == 0) PG8_BAR; }
    PG8_BAR;
    if constexpr (Epi::AFTER_DRAIN) { E.fused(acc, cur, wr, wc, fr, fq, lds, wid, lane); S.done(cur); }
#undef PG8_SA
#undef PG8_SB
#undef PG8_STAGE
#undef PG8_LDA
#undef PG8_LDB
#undef PG8_MMA
#undef PG8_WAIT_V
#undef PG8_WAIT_L
#undef PG8_BAR
#undef PG8_SCHED
}
}
#define LAS __attribute__((address_space(3)))
#define XB_TMO      128
#define XB_XCNT(j)  (256  + 64 * (j))
#define XB_XSUB(j)  (1280 + 64 * (j))
#define XB_XGEN(j)  (2304 + 64 * (j))
#define XB_TOP      3328
#define XB_TOPGEN   3392
#define XCD_BAR_WORDS 3456
#define XB_SPIN_CAP (1u << 18)

__device__ __forceinline__ unsigned xb_ld(unsigned* p)              { return __hip_atomic_load(p, __ATOMIC_RELAXED, __HIP_MEMORY_SCOPE_AGENT); }
__device__ __forceinline__ unsigned xb_add(unsigned* p, unsigned v) { return __hip_atomic_fetch_add(p, v, __ATOMIC_RELAXED, __HIP_MEMORY_SCOPE_AGENT); }
__device__ __forceinline__ unsigned xb_xcc_id() { return (unsigned)__builtin_amdgcn_s_getreg((3 << 11) | 20) & 0xFu; }
#define XB_SPIN(cond, bar) do { unsigned _sp = 0; while (cond) { __builtin_amdgcn_s_sleep(1); \
    if ((++_sp & 255u) == 0u) { if (xb_ld(&(bar)[XB_TMO])) break; if (_sp > XB_SPIN_CAP) { atomicAdd(&(bar)[XB_TMO], 1u); break; } } } } while (0)

struct XcdBarrier {
    unsigned* bar; unsigned x;
    volatile LAS unsigned* st;
};

__device__ __forceinline__ XcdBarrier xcd_barrier_post(unsigned* bar, volatile LAS unsigned* st) {
    XcdBarrier b; b.bar = bar; b.x = xb_xcc_id(); b.st = st;
    if (threadIdx.x == 0) (void)xb_add(&bar[XB_XCNT(b.x)], 1u);
    return b;
}
__device__ __forceinline__ void xcd_barrier_complete(unsigned* bar, unsigned x, unsigned& nloc, unsigned& nx) {
    const unsigned G = gridDim.x * gridDim.y * gridDim.z;
    unsigned sum, cnt, mine, sp = 0u;
    for (;;) {
        sum = 0u; cnt = 0u; mine = 0u;
#pragma unroll
        for (unsigned j = 0; j < 16; ++j) { const unsigned c = xb_ld(&bar[XB_XCNT(j)]); sum += c; cnt += (c > 0u) ? 1u : 0u; mine = (j == x) ? c : mine; }
        if (sum == G) break;
        __builtin_amdgcn_s_sleep(1);
        if ((++sp & 255u) == 0u) { if (xb_ld(&bar[XB_TMO])) break; if (sp > XB_SPIN_CAP) { atomicAdd(&bar[XB_TMO], 1u); break; } }
    }
    nloc = mine > 0u ? mine : 1u; nx = cnt > 0u ? cnt : 1u;
}

__device__ __forceinline__ void xcd_barrier(const XcdBarrier& b) {
    asm volatile("s_waitcnt vmcnt(0)" ::: "memory");
    __syncthreads();
    if (threadIdx.x == 0) {
        unsigned* bar = b.bar;
        __builtin_amdgcn_s_waitcnt(0);
        unsigned nloc = b.st[0], nx = b.st[1];
        if (nloc == 0u) { xcd_barrier_complete(bar, b.x, nloc, nx); b.st[0] = nloc; b.st[1] = nx; }
        const unsigned old = xb_add(&bar[XB_XSUB(b.x)], 1u);
        const unsigned gen = old / nloc;
        if (old + 1u == (gen + 1u) * nloc) {
            __builtin_amdgcn_fence(__ATOMIC_RELEASE, "agent");
            asm volatile("s_waitcnt vmcnt(0)" ::: "memory");
            const unsigned og = xb_add(&bar[XB_TOP], 1u);
            const unsigned tg = og / nx;
            if (og + 1u == (tg + 1u) * nx) xb_add(&bar[XB_TOPGEN], 1u);
            else XB_SPIN(xb_ld(&bar[XB_TOPGEN]) == tg, bar);
            __builtin_amdgcn_fence(__ATOMIC_ACQUIRE, "agent");
            xb_add(&bar[XB_XGEN(b.x)], 1u);
            asm volatile("s_waitcnt vmcnt(0)" ::: "memory");
        } else {
            XB_SPIN(xb_ld(&bar[XB_XGEN(b.x)]) == gen, bar);
            __builtin_amdgcn_fence(__ATOMIC_ACQUIRE, "agent");
            asm volatile("s_waitcnt vmcnt(0)" ::: "memory");
        }
    }
    __syncthreads();
}
#define GAS __attribute__((address_space(1)))
typedef unsigned short bf16;
typedef unsigned u32x4 __attribute__((ext_vector_type(4)));
typedef unsigned u32x2 __attribute__((ext_vector_type(2)));
typedef float f32x4 __attribute__((ext_vector_type(4)));
typedef float f32x16 __attribute__((ext_vector_type(16)));
typedef short bf16x8 __attribute__((ext_vector_type(8)));
typedef int i32x4 __attribute__((ext_vector_type(4)));
#define LDS_WAIT() asm volatile("s_waitcnt lgkmcnt(0)" ::: "memory")

constexpr int NWAVES = 8;
constexpr int NB = 16, SEQ = 2048, M = NB * SEQ, DM = 1024, DEPTH = 4, DIN = 3428, NIN = 3584, DFF = 4096;
constexpr int TOPK = 256;
constexpr float EPS = 1e-6f;
constexpr float LOG2E = 1.4426950408889634f;
constexpr float C2A = 0.125f * LOG2E;
constexpr float C2B = 0.10206207261596575f * LOG2E;
#ifndef MK_ONE_LAUNCH
#define MK_ONE_LAUNCH 1
#endif
constexpr int PH_PER_LAYER = 9, N_PHASES = DEPTH * PH_PER_LAYER + 1;

constexpr size_t MiB = 1u << 20;
constexpr size_t WS_CTL = 0, CTL_ZERO_BYTES = 64 * 1024;
constexpr int CW_BAR = 1024;
constexpr size_t WS_CS = 1 * MiB;
constexpr size_t WS_SSQQ = 5 * MiB, WS_SSQKV = 5 * MiB + 512 * 1024;
constexpr size_t WS_IW = 6 * MiB;
constexpr size_t WS_W = 8 * MiB;
constexpr size_t W_IN_OFF = 0, W_UQ_OFF = (size_t)NIN * 1024, W_UK_OFF = W_UQ_OFF + 768 * 256, W_UV_OFF = W_UK_OFF + 512 * 128, W_AB_OFF = W_UV_OFF + 512 * 128,
                 W_OUT_OFF = W_AB_OFF + 2048 * 512, W_FF1_OFF = W_OUT_OFF + 1024 * 1024, W_FF2_OFF = W_FF1_OFF + 4096 * 1024, W_END_OFF = W_FF2_OFF + 4096 * 1024;
static_assert(W_END_OFF * 2 <= 28 * MiB, "weight copies");
constexpr size_t WS_H = 36 * MiB;
constexpr size_t WS_YA = 100 * MiB, WS_YB = 132 * MiB;
constexpr size_t WS_IQ = 164 * MiB, WS_CQ = 180 * MiB, WS_CKV = 196 * MiB, WS_AK = 204 * MiB, WS_AVT = 208 * MiB, WS_IK = 212 * MiB, WS_KR = 216 * MiB;
constexpr size_t WS_MASK = 220 * MiB;
constexpr size_t WS_GATES = 228 * MiB;
constexpr size_t WS_QB = 356 * MiB, WS_KN = 404 * MiB, WS_VT = 436 * MiB, WS_END = 468 * MiB;
constexpr size_t WS_MERGED = 356 * MiB;
constexpr size_t WS_HID = 100 * MiB;
static_assert(WS_YB == WS_YA + (size_t)M * 512 * 2 && WS_HID + (size_t)M * DFF * 2 <= WS_MERGED && WS_MERGED + (size_t)M * DM * 2 <= WS_VT, "d_ws map");

constexpr int RING_BYTES = 131072;
constexpr int MISC_OFF = 143360;
constexpr int LDS_BYTES = 147456;

struct Frame {
    LAS unsigned char* lds;
    int tid, lane, wave, G, bx;
    const float* x; const int* pos; const float* rel_bias; float* out;
    unsigned char* ws;
};

namespace pg8 {
__device__ __forceinline__ u32x4 pack8(const f32x4 a, const f32x4 b) { u32x4 w; w.x = cvt_pk_bf16(a[0], a[1]); w.y = cvt_pk_bf16(a[2], a[3]); w.z = cvt_pk_bf16(b[0], b[1]); w.w = cvt_pk_bf16(b[2], b[3]); return w; }
__device__ __forceinline__ float ssq8(const f32x4 a, const f32x4 b) { return (a[0] * a[0] + a[1] * a[1]) + (a[2] * a[2] + a[3] * a[3]) + (b[0] * b[0] + b[1] * b[1]) + (b[2] * b[2] + b[3] * b[3]); }
__device__ __forceinline__ void unpack8(const u32x4 w, f32x4& a, f32x4& b) {
    a[0] = __uint_as_float(w.x << 16); a[1] = __uint_as_float(w.x & 0xffff0000u); a[2] = __uint_as_float(w.y << 16); a[3] = __uint_as_float(w.y & 0xffff0000u);
    b[0] = __uint_as_float(w.z << 16); b[1] = __uint_as_float(w.z & 0xffff0000u); b[2] = __uint_as_float(w.w << 16); b[3] = __uint_as_float(w.w & 0xffff0000u); }

struct EpiIn {
    static constexpr bool PERM = true, AFTER_DRAIN = false;
    bf16_t *AQ, *IQ, *CQ, *CKV, *AK, *AVT, *IK, *KR, *GATES; float *IW, *SSQQ, *SSQKV; const float *CS, *bgate;
    __device__ __forceinline__ void operator()(const f32x4 (&acc)[2][2][4][2], const Unit& u, int wr, int wc, int fr, int fq) const {
        asm volatile("" : "+v"(fr), "+v"(fq));
        const int pn = u.pn; const int row0 = u.pm * BM + wr * 64 + fr; const int cw = wc * 32 + 8 * fq;
        if (pn < 4) {
            bf16_t* base; int ld; float sc;
            if (pn < 2) { base = AQ + pn * 256; ld = 512; sc = C2A; } else if (pn == 2) { base = IQ; ld = 256; sc = 1.f; } else { base = CQ; ld = 256; sc = 1.f; }
#pragma unroll
            for (int ai = 0; ai < 2; ++ai)
#pragma unroll
                for (int m = 0; m < 4; ++m) { const int row = row0 + ai * HALF + m * 16; float ss = 0.f;
#pragma unroll
                    for (int bj = 0; bj < 2; ++bj) { const f32x4 v0 = acc[ai][bj][m][0] * sc, v1 = acc[ai][bj][m][1] * sc;
                        *(u32x4*)(base + (size_t)row * ld + bj * HALF + cw) = pack8(v0, v1); ss += ssq8(v0, v1); }
                    if (pn == 3) { ss += __shfl_xor(ss, 16); ss += __shfl_xor(ss, 32); if (fq == 0) SSQQ[(size_t)row * 4 + wc] = ss; } }
        } else if (pn == 4) {
#pragma unroll
            for (int ai = 0; ai < 2; ++ai)
#pragma unroll
                for (int m = 0; m < 4; ++m) { const int row = row0 + ai * HALF + m * 16;
                    { const f32x4 v0 = acc[ai][0][m][0], v1 = acc[ai][0][m][1]; *(u32x4*)(CKV + (size_t)row * 128 + cw) = pack8(v0, v1);
                      float ss = ssq8(v0, v1); ss += __shfl_xor(ss, 16); ss += __shfl_xor(ss, 32); if (fq == 0) SSQKV[(size_t)row * 4 + wc] = ss; }
                    { const f32x4 v0 = acc[ai][1][m][0], v1 = acc[ai][1][m][1]; const u32x4 w = pack8(v0, v1);
                      if (wc < 2) *(u32x4*)(AK + (size_t)row * 64 + cw) = w;
                      else { bf16_t* vt = AVT + ((size_t)(row >> 11) * 64 + (cw - 64)) * SEQ + (row & (SEQ - 1));
                             vt[0 * SEQ] = (bf16_t)(w.x & 0xffffu); vt[1 * SEQ] = (bf16_t)(w.x >> 16); vt[2 * SEQ] = (bf16_t)(w.y & 0xffffu); vt[3 * SEQ] = (bf16_t)(w.y >> 16);
                             vt[4 * SEQ] = (bf16_t)(w.z & 0xffffu); vt[5 * SEQ] = (bf16_t)(w.z >> 16); vt[6 * SEQ] = (bf16_t)(w.w & 0xffffu); vt[7 * SEQ] = (bf16_t)(w.w >> 16); }
#if defined(DBG_THROTTLE)
                      asm volatile("s_waitcnt vmcnt(8)" ::: "memory");
#endif
                    } }
        } else if (pn == 5) {
#pragma unroll
            for (int ai = 0; ai < 2; ++ai)
#pragma unroll
                for (int m = 0; m < 4; ++m) { const int row = row0 + ai * HALF + m * 16; const f32x4 v0 = acc[ai][0][m][0], v1 = acc[ai][0][m][1];
                    if (wc < 2) *(u32x4*)(IK + (size_t)row * 64 + cw) = pack8(v0, v1);
                    else if (wc == 2) { const f32x4 c4 = *(const f32x4*)(CS + (size_t)row * 32 + 4 * fq), s4 = *(const f32x4*)(CS + (size_t)row * 32 + 16 + 4 * fq);
                        f32x4 o0, o1; o0[0] = v0[0] * c4[0] - v0[1] * s4[0]; o0[1] = v0[0] * s4[0] + v0[1] * c4[0]; o0[2] = v0[2] * c4[1] - v0[3] * s4[1]; o0[3] = v0[2] * s4[1] + v0[3] * c4[1];
                        o1[0] = v1[0] * c4[2] - v1[1] * s4[2]; o1[1] = v1[0] * s4[2] + v1[1] * c4[2]; o1[2] = v1[2] * c4[3] - v1[3] * s4[3]; o1[3] = v1[2] * s4[3] + v1[3] * c4[3];
                        *(u32x4*)(KR + (size_t)row * 32 + 8 * fq) = pack8(o0, o1); }
                    else if (fq == 0) *(f32x4*)(IW + (size_t)row * 4) = v0; }
        } else {
            const int cg0 = (pn - 6) * 256 + cw;
            f32x4 bv[2][2];
#pragma unroll
            for (int bj = 0; bj < 2; ++bj) { bv[bj][0] = *(const f32x4*)(bgate + cg0 + bj * HALF); bv[bj][1] = *(const f32x4*)(bgate + cg0 + bj * HALF + 4); }
#pragma unroll
            for (int ai = 0; ai < 2; ++ai)
#pragma unroll
                for (int m = 0; m < 4; ++m) { const int row = row0 + ai * HALF + m * 16;
#pragma unroll
                    for (int bj = 0; bj < 2; ++bj) { f32x4 v0 = acc[ai][bj][m][0] + bv[bj][0], v1 = acc[ai][bj][m][1] + bv[bj][1];
#pragma unroll
                        for (int e = 0; e < 4; ++e) { v0[e] = __builtin_amdgcn_rcpf(1.f + __builtin_amdgcn_exp2f(-LOG2E * v0[e])); v1[e] = __builtin_amdgcn_rcpf(1.f + __builtin_amdgcn_exp2f(-LOG2E * v1[e])); }
                        *(u32x4*)(GATES + (size_t)row * 2048 + cg0 + bj * HALF) = pack8(v0, v1); } }
        }
    }
};
struct EpiUQ {
    static constexpr bool PERM = true, AFTER_DRAIN = false;
    bf16_t* QB; const float *SSQQ, *CS;
    __device__ __forceinline__ void operator()(const f32x4 (&acc)[2][2][4][2], const Unit& u, int wr, int wc, int fr, int fq) const {
        asm volatile("" : "+v"(fr), "+v"(fq));
        const int row0 = u.pm * BM + wr * 64 + fr; const int cw = wc * 32 + 8 * fq;
#pragma unroll
        for (int ai = 0; ai < 2; ++ai)
#pragma unroll
            for (int m = 0; m < 4; ++m) { const int row = row0 + ai * HALF + m * 16; const f32x4 sq = *(const f32x4*)(SSQQ + (size_t)row * 4);
                const float rs = __builtin_amdgcn_rsqf(((sq[0] + sq[1]) + (sq[2] + sq[3])) * (1.f / 256.f) + EPS) * C2B;
#pragma unroll
                for (int bj = 0; bj < 2; ++bj) { const int col0 = u.pn * BM + bj * HALF + cw; const int cm = col0 % 96;
                    f32x4 v0 = acc[ai][bj][m][0] * rs, v1 = acc[ai][bj][m][1] * rs;
                    if (cm >= 64) { const int i0 = (cm - 64) >> 1; const f32x4 c4 = *(const f32x4*)(CS + (size_t)row * 32 + i0), s4 = *(const f32x4*)(CS + (size_t)row * 32 + 16 + i0);
                        f32x4 o0, o1; o0[0] = v0[0] * c4[0] - v0[1] * s4[0]; o0[1] = v0[0] * s4[0] + v0[1] * c4[0]; o0[2] = v0[2] * c4[1] - v0[3] * s4[1]; o0[3] = v0[2] * s4[1] + v0[3] * c4[1];
                        o1[0] = v1[0] * c4[2] - v1[1] * s4[2]; o1[1] = v1[0] * s4[2] + v1[1] * c4[2]; o1[2] = v1[2] * c4[3] - v1[3] * s4[3]; o1[3] = v1[2] * s4[3] + v1[3] * c4[3];
                        v0 = o0; v1 = o1; }
                    *(u32x4*)(QB + (size_t)row * 768 + col0) = pack8(v0, v1); } }
    }
};
struct EpiUK {
    static constexpr bool PERM = true, AFTER_DRAIN = false;
    bf16_t* KN; const float* SSQKV;
    __device__ __forceinline__ void operator()(const f32x4 (&acc)[2][2][4][2], const Unit& u, int wr, int wc, int fr, int fq) const {
        asm volatile("" : "+v"(fr), "+v"(fq));
        const int row0 = u.pm * BM + wr * 64 + fr; const int cw = wc * 32 + 8 * fq;
#pragma unroll
        for (int ai = 0; ai < 2; ++ai)
#pragma unroll
            for (int m = 0; m < 4; ++m) { const int row = row0 + ai * HALF + m * 16; const f32x4 sq = *(const f32x4*)(SSQKV + (size_t)row * 4);
                const float rs = __builtin_amdgcn_rsqf(((sq[0] + sq[1]) + (sq[2] + sq[3])) * (1.f / 128.f) + EPS);
#pragma unroll
                for (int bj = 0; bj < 2; ++bj) *(u32x4*)(KN + (size_t)row * 512 + u.pn * BM + bj * HALF + cw) = pack8(acc[ai][bj][m][0] * rs, acc[ai][bj][m][1] * rs); }
    }
};
struct EpiUV {
    static constexpr bool PERM = true, AFTER_DRAIN = false;
    bf16_t* VT; const float* SSQKV;
    __device__ __forceinline__ void operator()(const f32x4 (&acc)[2][2][4][2], const Unit& u, int wr, int wc, int fr, int fq) const {
        asm volatile("" : "+v"(fr), "+v"(fq));
        const int row0 = u.pm * BM + wr * 64 + fr; const int cw = wc * 32 + 8 * fq;
        f32x4 r0[2], r1[2];
#pragma unroll
        for (int bj = 0; bj < 2; ++bj) { const int c0 = u.pn * BM + bj * HALF + cw;
#pragma unroll
            for (int e = 0; e < 8; ++e) { const f32x4 sq = *(const f32x4*)(SSQKV + (size_t)(c0 + e) * 4); const float rs = __builtin_amdgcn_rsqf(((sq[0] + sq[1]) + (sq[2] + sq[3])) * (1.f / 128.f) + EPS);
                if (e < 4) r0[bj][e] = rs; else r1[bj][e - 4] = rs; } }
#pragma unroll
        for (int ai = 0; ai < 2; ++ai)
#pragma unroll
            for (int m = 0; m < 4; ++m) { const int row = row0 + ai * HALF + m * 16;
#pragma unroll
                for (int bj = 0; bj < 2; ++bj) *(u32x4*)(VT + (size_t)row * M + u.pn * BM + bj * HALF + cw) = pack8(acc[ai][bj][m][0] * r0[bj], acc[ai][bj][m][1] * r1[bj]); }
    }
};
#ifndef DBG_BR_A
#define DBG_BR_A 1
#define DBG_BR_B 1
#endif
struct EpiBranch {
    static constexpr bool PERM = true, AFTER_DRAIN = false;
    bf16_t* MERGED; const bf16_t* GATES;
    __device__ __forceinline__ void operator()(const f32x4 (&acc)[2][2][4][2], const Unit& u, int wr, int wc, int fr, int fq) const {
        asm volatile("" : "+v"(fr), "+v"(fq));
        const int br = u.pn >> 2, pn = u.pn & 3, pm = u.pm & 127;
        const int row0 = pm * BM + wr * 64 + fr; const int cw = wc * 32 + 8 * fq;
#pragma unroll
        for (int ai = 0; ai < 2; ++ai)
#pragma unroll
            for (int m = 0; m < 4; ++m) { const int row = row0 + ai * HALF + m * 16;
#pragma unroll
                for (int bj = 0; bj < 2; ++bj) { const int col0 = pn * BM + bj * HALF + cw;
                    f32x4 g0, g1; unpack8(*(const u32x4*)(GATES + (size_t)row * 2048 + br * 1024 + col0), g0, g1);
                    const float on_ = br ? (float)(DBG_BR_B) : (float)(DBG_BR_A);
                    f32x4 v0 = acc[ai][bj][m][0] * g0 * on_, v1 = acc[ai][bj][m][1] * g1 * on_;
                    bf16_t* dst = MERGED + (size_t)row * 1024 + col0;
                    if (br) { f32x4 p0, p1; unpack8(*(const u32x4*)dst, p0, p1); v0 += p0; v1 += p1; }
                    *(u32x4*)dst = pack8(v0, v1); } }
    }
};
struct EpiRes {
    static constexpr bool PERM = false, AFTER_DRAIN = false;
    const float* base; float* out; float scale;
    __device__ __forceinline__ void operator()(const f32x4 (&acc)[2][2][4][2], const Unit& u, int wr, int wc, int fr, int fq) const {
        asm volatile("" : "+v"(fr), "+v"(fq));
        const int row0 = u.pm * BM + wr * 64 + fr; const int c0 = u.pn * BM + wc * 32 + 4 * fq;
#pragma unroll
        for (int ai = 0; ai < 2; ++ai)
#pragma unroll
            for (int m = 0; m < 4; ++m) { const size_t off = (size_t)(row0 + ai * HALF + m * 16) * DM + c0;
#pragma unroll
                for (int bj = 0; bj < 2; ++bj)
#pragma unroll
                    for (int n = 0; n < 2; ++n) { const f32x4 bs = *(const f32x4*)(base + off + bj * HALF + n * 16); *(f32x4*)(out + off + bj * HALF + n * 16) = bs + acc[ai][bj][m][n] * scale; } }
    }
};
struct EpiFF1 {
    static constexpr bool PERM = true, AFTER_DRAIN = false;
    bf16_t* HID;
    __device__ __forceinline__ void operator()(const f32x4 (&acc)[2][2][4][2], const Unit& u, int wr, int wc, int fr, int fq) const {
        asm volatile("" : "+v"(fr), "+v"(fq));
        const int row0 = u.pm * BM + wr * 64 + fr; const int cw = wc * 32 + 8 * fq;
#pragma unroll
        for (int ai = 0; ai < 2; ++ai)
#pragma unroll
            for (int m = 0; m < 4; ++m) { const int row = row0 + ai * HALF + m * 16;
#pragma unroll
                for (int bj = 0; bj < 2; ++bj) { f32x4 v0 = acc[ai][bj][m][0], v1 = acc[ai][bj][m][1];
#pragma unroll
                    for (int e = 0; e < 4; ++e) { const float a = fmaxf(v0[e], 0.f), b = fmaxf(v1[e], 0.f); v0[e] = a * a; v1[e] = b * b; }
                    *(u32x4*)(HID + (size_t)row * DFF + u.pn * BM + bj * HALF + cw) = pack8(v0, v1); } }
    }
};
struct BranchOrder {
    StaticOrder so; int brsel;
    __device__ void init(int G, int c, int brsel_ = -1) { so.init(M, DM, G, c); brsel = brsel_; }
    __device__ bool next(int i, Unit& u) const { Unit b; if (brsel >= 0) { if (!so.next(i, b)) return false; u.pm = b.pm + 128 * brsel; u.pn = b.pn + 4 * brsel; return true; }
        if (!so.next(i >> 1, b)) return false; const int br = i & 1; u.pm = b.pm + 128 * br; u.pn = b.pn + 4 * br; return true; }
    __device__ __forceinline__ void a_ready(const Unit&) const {}
    __device__ __forceinline__ void done(const Unit&) const {}
};
}

__device__ __forceinline__ unsigned f2bf(float f) { unsigned u = __builtin_bit_cast(unsigned, f); return (u + 0x7fffu + ((u >> 16) & 1u)) >> 16; }
__device__ __forceinline__ unsigned pk2(float lo, float hi) { return f2bf(lo) | (f2bf(hi) << 16); }
__device__ __forceinline__ float wave_sum(float v) {
#pragma unroll
    for (int o = 1; o < 64; o <<= 1) v += __shfl_xor(v, o);
    return v;
}
template <int KIND> __device__ __forceinline__ int src_col(int n) {
    if (KIND == 1) {
        if (n < 512) return n;
        if (n < 768) return 640 + (n - 512);
        if (n < 1024) return 964 + (n - 768);
        if (n < 1152) return 1220 + (n - 1024);
        if (n < 1216) return 512 + (n - 1152);
        if (n < 1280) return 576 + (n - 1216);
        if (n < 1344) return 896 + (n - 1280);
        if (n < 1376) { const int j = n - 1344; return 1348 + 16 * (j & 1) + (j >> 1); }
        if (n < 1380) return 960 + (n - 1376);
        if (n < 1536) return -1;
        return 1380 + (n - 1536);
    } else if (KIND == 2) {
        const int h = n / 96, c = n % 96; if (c < 64) return h * 96 + c; const int j = c - 64; return h * 96 + 64 + 16 * (j & 1) + (j >> 1);
    } else if (KIND == 3) {
        return (n >> 6) * 128 + (n & 63);
    } else if (KIND == 4) {
        return (n >> 6) * 128 + 64 + (n & 63);
    }
    return n;
}
template <int KIND> __device__ __forceinline__ void prep_item(const float* W, int K, int Nsrc, bf16* WT, LAS float* scr, int item, int nblk, int lane, const float* gain) {
    const int kb = item / nblk, nb = item % nblk, k0 = 64 * kb, n0 = 32 * nb;
    const int sc = src_col<KIND>(n0 + (lane & 31));
#pragma unroll 8
    for (int i = 0; i < 32; ++i) { const int kk = 2 * i + (lane >> 5); float v = (sc >= 0) ? W[(size_t)(k0 + kk) * Nsrc + sc] : 0.f; if (gain) v *= gain[k0 + kk]; scr[kk * 33 + (lane & 31)] = v; }
    LDS_WAIT(); asm volatile("" ::: "memory");
    const int c = lane & 7;
#pragma unroll
    for (int j = 0; j < 4; ++j) { const int n = (lane >> 3) + 8 * j; const LAS float* s = scr + (8 * c) * 33 + n;
        u32x4 o; o.x = pk2(s[0 * 33], s[1 * 33]); o.y = pk2(s[2 * 33], s[3 * 33]); o.z = pk2(s[4 * 33], s[5 * 33]); o.w = pk2(s[6 * 33], s[7 * 33]);
        *(GAS u32x4*)(WT + (size_t)(n0 + n) * K + k0 + 8 * c) = o; }
    LDS_WAIT(); asm volatile("" ::: "memory");
}
__device__ __forceinline__ void prep_weights(Frame& F, int l, const float* w_in, const float* gq, const float* gkv, const float* w_uq, const float* w_ukv, const float* w_a, const float* w_b,
                                             const float* w_out, const float* w_ff1, const float* w_ff2) {
    LAS float* scr = (LAS float*)(F.lds + F.wave * 16384);
    bf16* WB = (bf16*)(F.ws + WS_W);
    const int gw = F.bx * NWAVES + F.wave, NGW = F.G * NWAVES;
    constexpr int I_IN = 16 * (NIN / 32), I_UQ = 4 * 24, I_UK = 2 * 16, I_UV = 2 * 16, I_A = 8 * 32, I_B = 8 * 32, I_O = 16 * 32, I_1 = 16 * 128, I_2 = 64 * 32;
    constexpr int NITEMS = I_IN + I_UQ + I_UK + I_UV + I_A + I_B + I_O + I_1 + I_2;
    for (int it = gw; it < NITEMS; it += NGW) {
        int r = it;
        if (r < I_IN) { prep_item<1>(w_in + (size_t)l * DM * DIN, DM, DIN, WB + W_IN_OFF, scr, r, NIN / 32, F.lane, nullptr); continue; } r -= I_IN;
        if (r < I_UQ) { prep_item<2>(w_uq + (size_t)l * 256 * 768, 256, 768, WB + W_UQ_OFF, scr, r, 24, F.lane, gq + l * 256); continue; } r -= I_UQ;
        if (r < I_UK) { prep_item<3>(w_ukv + (size_t)l * 128 * 1024, 128, 1024, WB + W_UK_OFF, scr, r, 16, F.lane, gkv + l * 128); continue; } r -= I_UK;
        if (r < I_UV) { prep_item<4>(w_ukv + (size_t)l * 128 * 1024, 128, 1024, WB + W_UV_OFF, scr, r, 16, F.lane, gkv + l * 128); continue; } r -= I_UV;
        if (r < I_A) { prep_item<0>(w_a + (size_t)l * 512 * 1024, 512, 1024, WB + W_AB_OFF, scr, r, 32, F.lane, nullptr); continue; } r -= I_A;
        if (r < I_B) { prep_item<0>(w_b + (size_t)l * 512 * 1024, 512, 1024, WB + W_AB_OFF + 1024 * 512, scr, r, 32, F.lane, nullptr); continue; } r -= I_B;
        if (r < I_O) { prep_item<0>(w_out + (size_t)l * 1024 * 1024, 1024, 1024, WB + W_OUT_OFF, scr, r, 32, F.lane, nullptr); continue; } r -= I_O;
        if (r < I_1) { prep_item<0>(w_ff1 + (size_t)l * 1024 * 4096, 1024, 4096, WB + W_FF1_OFF, scr, r, 128, F.lane, nullptr); continue; } r -= I_1;
        prep_item<0>(w_ff2 + (size_t)l * 4096 * 1024, 4096, 1024, WB + W_FF2_OFF, scr, r, 32, F.lane, nullptr);
    }
}
__device__ __forceinline__ void rope_table(Frame& F) {
    float* CS = (float*)(F.ws + WS_CS);
    for (int e = F.bx * (NWAVES * 64) + F.tid; e < M * 16; e += F.G * NWAVES * 64) { const int m = e >> 4, i = e & 15;
        const float invf = powf(10000.f, -(float)(2 * i) * (1.f / 32.f)); const float ang = (float)F.pos[m] * invf;
        float s, c; sincosf(ang, &s, &c); CS[(size_t)m * 32 + i] = c; CS[(size_t)m * 32 + 16 + i] = s; }
}
template <bool OUT_F32> __device__ __forceinline__ void norm_rows(Frame& F, const float* src, const float* g, bf16* dstb, float* dstf, float oscale = 1.f) {
    const int gw = F.bx * NWAVES + F.wave, NGW = F.G * NWAVES;
    f32x4 gv[4];
#pragma unroll
    for (int j = 0; j < 4; ++j) gv[j] = *((const f32x4*)g + F.lane + 64 * j);
    for (int m = gw; m < M; m += NGW) {
        const GAS f32x4* xr = (const GAS f32x4*)(src + (size_t)m * DM) + F.lane;
        f32x4 v[4]; float s = 0.f;
#pragma unroll
        for (int j = 0; j < 4; ++j) { v[j] = xr[64 * j]; s += (v[j].x * v[j].x + v[j].y * v[j].y) + (v[j].z * v[j].z + v[j].w * v[j].w); }
        const float rstd = oscale / sqrtf(wave_sum(s) * (1.f / DM) + EPS);
        if (OUT_F32) { GAS f32x4* o = (GAS f32x4*)(dstf + (size_t)m * DM) + F.lane;
#pragma unroll
            for (int j = 0; j < 4; ++j) o[64 * j] = v[j] * rstd * gv[j];
        } else { GAS unsigned long long* o8 = (GAS unsigned long long*)(dstb + (size_t)m * DM) + F.lane;
#pragma unroll
            for (int j = 0; j < 4; ++j) { const f32x4 y = v[j] * rstd * gv[j]; o8[64 * j] = (unsigned long long)pk2(y.x, y.y) | ((unsigned long long)pk2(y.z, y.w) << 32); } }
    }
}

constexpr int SC_PITCH = SEQ + 4;
constexpr int IDX_MB_OFF = 16 * SC_PITCH * 4;
static_assert(IDX_MB_OFF + 16 * 32 * 8 <= MISC_OFF, "indexer LDS");
__device__ __forceinline__ unsigned fkey(float f) { unsigned u = __float_as_uint(f); if ((u << 1) == 0u) u = 0u; return (u & 0x80000000u) ? ~u : (u | 0x80000000u); }
__device__ __forceinline__ void select_topk(const unsigned (&k)[32], unsigned long long& myword, int lane) {
    unsigned prefix = 0u; bool exact = false;
    for (int bit = 31; bit >= 0; --bit) {
        const unsigned cand = prefix | (1u << bit);
        int cnt = 0;
#pragma unroll
        for (int j = 0; j < 32; ++j) cnt += __popcll(__ballot(k[j] >= cand));
        if (cnt >= TOPK) prefix = cand;
        if (cnt == TOPK) { exact = true; break; }
    }
    if (exact) {
#pragma unroll
        for (int j = 0; j < 32; ++j) { const unsigned long long mk = __ballot(k[j] >= prefix); if (lane == j) myword = mk; }
    } else {
        int need = TOPK;
#pragma unroll
        for (int j = 0; j < 32; ++j) need -= __popcll(__ballot(k[j] > prefix));
#pragma unroll
        for (int j = 0; j < 32; ++j) { const unsigned long long gt = __ballot(k[j] > prefix), eq = __ballot(k[j] == prefix); const int c = __popcll(eq); unsigned long long take;
            if (c <= need) { take = eq; need -= c; }
            else { const int below = __builtin_amdgcn_mbcnt_hi((unsigned)(eq >> 32), __builtin_amdgcn_mbcnt_lo((unsigned)eq, 0u)); take = __ballot((k[j] == prefix) && (below < need)); need = 0; }
            if (lane == j) myword = gt | take; }
    }
}
__device__ __forceinline__ void idx_phase(Frame& F) {
    const bf16* IQ = (const bf16*)(F.ws + WS_IQ); const bf16* IK = (const bf16*)(F.ws + WS_IK); const float* IW = (const float*)(F.ws + WS_IW);
    unsigned long long* MASK = (unsigned long long*)(F.ws + WS_MASK);
    LAS float* sc = (LAS float*)F.lds; LAS unsigned long long* mb = (LAS unsigned long long*)(F.lds + IDX_MB_OFF);
    const int lane = F.lane, n = lane & 15, kg = lane >> 4, w = F.wave;
    for (int uidx = F.bx; uidx < NB * 128; uidx += F.G) {
        const int c = uidx & 255, i = uidx >> 8, b = c >> 4, s = c & 15;
        const int jb = (i >> 1) * 32 + ((i & 1) ? 31 - s : s);
        const int q0 = jb * 16, ntile = jb + 1; const size_t rowb = (size_t)b * SEQ;
        bf16x8 qf[4][2];
#pragma unroll
        for (int h = 0; h < 4; ++h)
#pragma unroll
            for (int ks = 0; ks < 2; ++ks) qf[h][ks] = *(const bf16x8*)(IQ + (rowb + q0 + n) * 256 + h * 64 + ks * 32 + kg * 8);
        const f32x4 w4 = *(const f32x4*)(IW + (rowb + q0 + n) * 4);
        for (int tt = w; tt < ntile; tt += NWAVES) {
            const bf16* kp = IK + (rowb + tt * 16 + n) * 64 + kg * 8;
            const bf16x8 k0 = *(const bf16x8*)kp, k1 = *(const bf16x8*)(kp + 32);
            f32x4 s4 = (f32x4){0.f, 0.f, 0.f, 0.f};
#pragma unroll
            for (int h = 0; h < 4; ++h) { f32x4 a = (f32x4){0.f, 0.f, 0.f, 0.f};
                a = __builtin_amdgcn_mfma_f32_16x16x32_bf16(k0, qf[h][0], a, 0, 0, 0); a = __builtin_amdgcn_mfma_f32_16x16x32_bf16(k1, qf[h][1], a, 0, 0, 0);
#pragma unroll
                for (int e = 0; e < 4; ++e) s4[e] += w4[h] * fmaxf(a[e], 0.f); }
            *(LAS f32x4*)(sc + n * SC_PITCH + tt * 16 + 4 * kg) = s4;
        }
        __syncthreads();
#pragma unroll 1
        for (int rr = 0; rr < 2; ++rr) {
            const int r = 2 * w + rr, t = q0 + r;
            unsigned k[32];
#pragma unroll
            for (int j = 0; j < 32; ++j) { const int sidx = j * 64 + lane; float v = 0.f; if (j * 64 <= t) v = sc[r * SC_PITCH + sidx]; k[j] = (sidx <= t) ? fkey(v) : 0u; }
            unsigned long long myword = 0ull;
            if (t + 1 <= TOPK) {
#pragma unroll
                for (int j = 0; j < 32; ++j) { const unsigned long long mk = __ballot(k[j] != 0u); if (lane == j) myword = mk; }
            } else select_topk(k, myword, lane);
            if (lane < 32) mb[r * 32 + lane] = myword;
        }
        __syncthreads();
        { const int j = F.tid >> 4, q = F.tid & 15; MASK[((size_t)b * 32 + j) * SEQ + q0 + q] = mb[q * 32 + j]; }
        __syncthreads();
    }
}

constexpr int KP_A = 144, KP_B = 208, VP = 136;
constexpr int KBUF_SZ = 64 * KP_B, VBUF_SZ = 64 * VP, KBUF = 0, VBUF = 2 * KBUF_SZ, LUT_OFF = VBUF + 2 * VBUF_SZ;
constexpr float NEGV = -1e30f;
__device__ __forceinline__ void softmax_pv(f32x16 (&o)[2], float& mrun, float& lrun, f32x16& s0, f32x16& s1, const LAS char* vt, int r32, int hi) {
    float mx = fmaxf(s0[0], s1[0]);
#pragma unroll
    for (int r = 1; r < 16; ++r) mx = fmaxf(mx, fmaxf(s0[r], s1[r]));
    mx = fmaxf(mx, __shfl_xor(mx, 32));
    const float mnew = fmaxf(mrun, mx);
    const float alpha = __builtin_amdgcn_exp2f(mrun - mnew);
    mrun = mnew;
    float ps = 0.f;
#pragma unroll
    for (int r = 0; r < 16; ++r) { s0[r] = __builtin_amdgcn_exp2f(s0[r] - mnew); s1[r] = __builtin_amdgcn_exp2f(s1[r] - mnew); ps += s0[r] + s1[r]; }
    lrun = lrun * alpha + ps;
    if (__any(alpha != 1.0f)) {
#pragma unroll
        for (int r = 0; r < 16; ++r) { o[0][r] *= alpha; o[1][r] *= alpha; }
    }
    bf16x8 pf[4];
#pragma unroll
    for (int ks = 0; ks < 4; ++ks) { u32x4 w;
        if (ks < 2) { const int b = 8 * ks; w.x = pg8::cvt_pk_bf16(s0[b], s0[b + 1]); w.y = pg8::cvt_pk_bf16(s0[b + 2], s0[b + 3]); w.z = pg8::cvt_pk_bf16(s0[b + 4], s0[b + 5]); w.w = pg8::cvt_pk_bf16(s0[b + 6], s0[b + 7]); }
        else { const int b = 8 * (ks - 2); w.x = pg8::cvt_pk_bf16(s1[b], s1[b + 1]); w.y = pg8::cvt_pk_bf16(s1[b + 2], s1[b + 3]); w.z = pg8::cvt_pk_bf16(s1[b + 4], s1[b + 5]); w.w = pg8::cvt_pk_bf16(s1[b + 6], s1[b + 7]); }
        pf[ks] = __builtin_bit_cast(bf16x8, w); }
#pragma unroll
    for (int d0 = 0; d0 < 2; ++d0)
#pragma unroll
        for (int ks = 0; ks < 4; ++ks) { const LAS char* p = vt + (32 * d0 + r32) * VP + 32 * ks + 8 * hi;
            const u32x2 lo = *(const LAS u32x2*)p, hh = *(const LAS u32x2*)(p + 16);
            const u32x4 vw = (u32x4){lo.x, lo.y, hh.x, hh.y};
            o[d0] = __builtin_amdgcn_mfma_f32_32x32x16_bf16(__builtin_bit_cast(bf16x8, vw), pf[ks], o[d0], 0, 0, 0); }
}
__device__ __forceinline__ void store_o(bf16* op, const f32x16 (&o)[2], float inv) {
#pragma unroll
    for (int d0 = 0; d0 < 2; ++d0)
#pragma unroll
        for (int g = 0; g < 4; ++g) { u32x2 w; w.x = pg8::cvt_pk_bf16(o[d0][4 * g] * inv, o[d0][4 * g + 1] * inv); w.y = pg8::cvt_pk_bf16(o[d0][4 * g + 2] * inv, o[d0][4 * g + 3] * inv);
            *(u32x2*)(op + 32 * d0 + 8 * g) = w; }
}
__device__ __forceinline__ void dsa_unit(Frame& F, int b, int jq) {
    const int lane = F.lane, r32 = lane & 31, hi = lane >> 5, w = F.wave, tid = F.tid;
    LAS char* lds = (LAS char*)F.lds;
    bf16* AQ = (bf16*)(F.ws + WS_YA); const bf16* AK = (const bf16*)(F.ws + WS_AK); const bf16* AVT = (const bf16*)(F.ws + WS_AVT);
    const unsigned long long* MASK = (const unsigned long long*)(F.ws + WS_MASK);
    const size_t rowb = (size_t)b * SEQ; const int q0 = jq * 32;
    bf16x8 qf[4];
    { const bf16* qp = AQ + (rowb + q0 + r32) * 512 + w * 64 + hi * 8;
#pragma unroll
      for (int d0 = 0; d0 < 4; ++d0) qf[d0] = *(const bf16x8*)(qp + d0 * 16); }
    const int posq = F.pos[rowb + q0 + r32];
    int qmin = posq;
#pragma unroll
    for (int o_ = 1; o_ < 64; o_ <<= 1) qmin = min(qmin, __shfl_xor(qmin, o_));
    const int NT = (jq + 2) >> 1;
    const LAS float* lut = (const LAS float*)(lds + LUT_OFF) + w * 129;
    const float bfar = lut[128];
    f32x16 o[2]; float mrun = NEGV, lrun = 0.f;
#pragma unroll
    for (int r = 0; r < 16; ++r) { o[0][r] = 0.f; o[1][r] = 0.f; }
    const int srow = tid >> 3, sch = tid & 7;
    const bf16* kgp = AK + (rowb + srow) * 64 + sch * 8;
    const bf16* vgp = AVT + ((size_t)b * 64 + srow) * SEQ + sch * 8;
    u32x4 kreg = *(const u32x4*)kgp, vreg = *(const u32x4*)vgp;
    for (int t = 0; t < NT; ++t) {
        LAS char* kb = lds + KBUF + (t & 1) * KBUF_SZ; LAS char* vb = lds + VBUF + (t & 1) * VBUF_SZ;
        *(LAS u32x4*)(kb + srow * KP_A + sch * 16) = kreg;
        *(LAS u32x2*)(vb + srow * VP + sch * 16) = (u32x2){vreg.x, vreg.y}; *(LAS u32x2*)(vb + srow * VP + sch * 16 + 8) = (u32x2){vreg.z, vreg.w};
        __syncthreads();
        if (t + 1 < NT) { kreg = *(const u32x4*)(kgp + (size_t)(t + 1) * 64 * 64); vreg = *(const u32x4*)(vgp + (t + 1) * 64); }
        const unsigned long long mw = MASK[((size_t)b * 32 + t) * SEQ + q0 + r32];
        int kmax = F.pos[rowb + t * 64 + lane];
#pragma unroll
        for (int o_ = 1; o_ < 64; o_ <<= 1) kmax = max(kmax, __shfl_xor(kmax, o_));
        const bool far = (qmin - kmax >= 128);
        f32x16 s0, s1; { const float ci = far ? bfar : 0.f;
#pragma unroll
            for (int r = 0; r < 16; ++r) { s0[r] = ci; s1[r] = ci; } }
#pragma unroll
        for (int d0 = 0; d0 < 4; ++d0) { const bf16x8 k0 = *(const LAS bf16x8*)(kb + r32 * KP_A + d0 * 32 + hi * 16), k1 = *(const LAS bf16x8*)(kb + (32 + r32) * KP_A + d0 * 32 + hi * 16);
            s0 = __builtin_amdgcn_mfma_f32_32x32x16_bf16(k0, qf[d0], s0, 0, 0, 0); s1 = __builtin_amdgcn_mfma_f32_32x32x16_bf16(k1, qf[d0], s1, 0, 0, 0); }
        if (!far) {
            const int* pk = F.pos + rowb + t * 64 + 4 * hi;
#pragma unroll
            for (int g = 0; g < 4; ++g) { const i32x4 p0 = *(const i32x4*)(pk + 8 * g), p1 = *(const i32x4*)(pk + 32 + 8 * g);
#pragma unroll
                for (int e = 0; e < 4; ++e) { s0[4 * g + e] += lut[min(max(posq - p0[e], 0), 128)]; s1[4 * g + e] += lut[min(max(posq - p1[e], 0), 128)]; } }
        }
        { const unsigned wl = (unsigned)mw >> (4 * hi), wh = (unsigned)(mw >> 32) >> (4 * hi);
#pragma unroll
          for (int r = 0; r < 16; ++r) { const int c = (r & 3) + 8 * (r >> 2); if (!((wl >> c) & 1u)) s0[r] = NEGV; if (!((wh >> c) & 1u)) s1[r] = NEGV; } }
        softmax_pv(o, mrun, lrun, s0, s1, vb, r32, hi);
    }
    lrun += __shfl_xor(lrun, 32);
    store_o(AQ + (rowb + q0 + r32) * 512 + w * 64 + 4 * hi, o, 1.f / lrun);
    __syncthreads();
}
__device__ __forceinline__ void mla_unit(Frame& F, int b, int h, int qb) {
    const int lane = F.lane, r32 = lane & 31, hi = lane >> 5, w = F.wave, tid = F.tid;
    LAS char* lds = (LAS char*)F.lds;
    const bf16* QB = (const bf16*)(F.ws + WS_QB); const bf16* KN = (const bf16*)(F.ws + WS_KN); const bf16* KR = (const bf16*)(F.ws + WS_KR); const bf16* VT = (const bf16*)(F.ws + WS_VT);
    bf16* YB = (bf16*)(F.ws + WS_YB);
    const size_t rowb = (size_t)b * SEQ; const int q0w = qb * 256 + w * 32;
    bf16x8 qf[6];
    { const bf16* qp = QB + (rowb + q0w + r32) * 768 + h * 96 + hi * 8;
#pragma unroll
      for (int d0 = 0; d0 < 6; ++d0) qf[d0] = *(const bf16x8*)(qp + d0 * 16); }
    const int NT = 4 * (qb + 1);
    f32x16 o[2]; float mrun = NEGV, lrun = 0.f;
#pragma unroll
    for (int r = 0; r < 16; ++r) { o[0][r] = 0.f; o[1][r] = 0.f; }
    const int srow = tid >> 3, sch = tid & 7, rrow = (tid >> 2) & 63, rch = tid & 3;
    const bf16* kgp = KN + (rowb + srow) * 512 + h * 64 + sch * 8;
    const bf16* rgp = KR + (rowb + rrow) * 32 + rch * 8;
    const bf16* vgp = VT + (size_t)(h * 64 + srow) * M + rowb + sch * 8;
    u32x4 kreg = *(const u32x4*)kgp, vreg = *(const u32x4*)vgp, rreg = (u32x4){0u, 0u, 0u, 0u};
    if (tid < 256) rreg = *(const u32x4*)rgp;
    for (int t = 0; t < NT; ++t) {
        LAS char* kb = lds + KBUF + (t & 1) * KBUF_SZ; LAS char* vb = lds + VBUF + (t & 1) * VBUF_SZ;
        *(LAS u32x4*)(kb + srow * KP_B + sch * 16) = kreg;
        if (tid < 256) *(LAS u32x4*)(kb + rrow * KP_B + 128 + rch * 16) = rreg;
        *(LAS u32x2*)(vb + srow * VP + sch * 16) = (u32x2){vreg.x, vreg.y}; *(LAS u32x2*)(vb + srow * VP + sch * 16 + 8) = (u32x2){vreg.z, vreg.w};
        __syncthreads();
        if (t + 1 < NT) { kreg = *(const u32x4*)(kgp + (size_t)(t + 1) * 64 * 512); vreg = *(const u32x4*)(vgp + (t + 1) * 64); if (tid < 256) rreg = *(const u32x4*)(rgp + (size_t)(t + 1) * 64 * 32); }
        if (t * 64 <= q0w + 31) {
            f32x16 s0, s1;
#pragma unroll
            for (int r = 0; r < 16; ++r) { s0[r] = 0.f; s1[r] = 0.f; }
#pragma unroll
            for (int d0 = 0; d0 < 6; ++d0) { const bf16x8 k0 = *(const LAS bf16x8*)(kb + r32 * KP_B + d0 * 32 + hi * 16), k1 = *(const LAS bf16x8*)(kb + (32 + r32) * KP_B + d0 * 32 + hi * 16);
                s0 = __builtin_amdgcn_mfma_f32_32x32x16_bf16(k0, qf[d0], s0, 0, 0, 0); s1 = __builtin_amdgcn_mfma_f32_32x32x16_bf16(k1, qf[d0], s1, 0, 0, 0); }
            if (t * 64 + 63 > q0w) {
                const int qi = q0w + r32, kv0 = t * 64 + 4 * hi;
#pragma unroll
                for (int r = 0; r < 16; ++r) { const int kv = kv0 + (r & 3) + 8 * (r >> 2); if (kv > qi) s0[r] = NEGV; if (kv + 32 > qi) s1[r] = NEGV; }
            }
            softmax_pv(o, mrun, lrun, s0, s1, vb, r32, hi);
        }
    }
    lrun += __shfl_xor(lrun, 32);
    store_o(YB + (rowb + q0w + r32) * 512 + h * 64 + 4 * hi, o, 1.f / lrun);
    __syncthreads();
}
__device__ __forceinline__ void attn_phase(Frame& F) {
    { LAS float* lut = (LAS float*)(F.lds + LUT_OFF);
      for (int e = F.tid; e < 8 * 129; e += NWAVES * 64) { const int h = e / 129, n = e % 129; int bk;
          if (n < 16) bk = n; else { const float z = logf((float)n * (1.f / 16.f)) / 2.0794415416798357f * 16.f; bk = 16 + (int)z; if (bk > 31) bk = 31; }
          lut[e] = F.rel_bias[bk * 8 + h] * LOG2E; }
      __syncthreads(); }
#ifndef ATT_DSA_ON
#define ATT_DSA_ON 1
#endif
#ifndef ATT_MLA_ON
#define ATT_MLA_ON 1
#endif
    if (ATT_DSA_ON)
    for (int uidx = F.bx; uidx < NB * 64; uidx += F.G) {
        const int c = uidx & 255, i = uidx >> 8, b = c >> 4, s = c & 15;
        const int jq = (i >> 1) * 32 + ((i & 1) ? 31 - s : s);
        dsa_unit(F, b, jq);
    }
    if (ATT_MLA_ON)
    for (int uidx = F.bx; uidx < NB * 8 * 8; uidx += F.G) {
        const int c = uidx & 255, i = uidx >> 8, bh = c >> 1, sub = c & 1;
        const int qb = sub ? ((i == 0) ? 1 : (i == 1) ? 6 : (i == 2) ? 2 : 5) : ((i == 0) ? 0 : (i == 1) ? 7 : (i == 2) ? 3 : 4);
        mla_unit(F, bh >> 3, bh & 7, qb);
    }
}
#if defined(DBG_CHECK)
#ifndef DBG_PROBE_OFF
#define DBG_PROBE_OFF 100
#define DBG_PROBE_PH 2
#endif
#ifndef DBG_FILL_LO
#define DBG_FILL_LO (1 * MiB)
#define DBG_FILL_HI (468 * MiB)
#endif
constexpr size_t WS_DBG_AQ_UNUSED = 0;
constexpr int DBG_W_DSA = 16, DBG_W_MASK = 17, DBG_W_MLA = 18, DBG_W_DIR = 19, DBG_W_QB = 20, DBG_W_KV = 21;
__device__ __forceinline__ float bf2f(bf16 v) { return __uint_as_float((unsigned)v << 16); }
__device__ __forceinline__ int dbg_bucket(int n) { if (n < 0) n = 0; if (n < 16) return n; const double z = log((double)n / 16.0) / log(8.0) * 16.0; int b = 16 + (int)z; return b > 31 ? 31 : b; }
__device__ __forceinline__ float dbg_block_max(LAS float* red, float v, int tid) {
    for (int o = 1; o < 64; o <<= 1) v = fmaxf(v, __shfl_xor(v, o));
    __syncthreads(); if ((tid & 63) == 0) red[tid >> 6] = v; __syncthreads();
    float r = red[0]; for (int i = 1; i < NWAVES; ++i) r = fmaxf(r, red[i]); __syncthreads(); return r;
}
__device__ __forceinline__ float dbg_block_sum(LAS float* red, float v, int tid) {
    for (int o = 1; o < 64; o <<= 1) v += __shfl_xor(v, o);
    __syncthreads(); if ((tid & 63) == 0) red[tid >> 6] = v; __syncthreads();
    float r = 0.f; for (int i = 0; i < NWAVES; ++i) r += red[i]; __syncthreads(); return r;
}
__device__ __forceinline__ int dbg_sample_t(int k) { return (k == 0) ? 0 : (k == 1) ? 255 : (k == 2) ? 256 : (k == 3) ? 257 : (k == 4) ? 2047 : (k == 5) ? 300 : 100 + 173 * k; }
__device__ __forceinline__ void dbg_copy_aq(unsigned char* ws, float* outbuf, int bx, int G, int tid) {
    const u32x4* src = (const u32x4*)(ws + WS_YA); u32x4* dst = (u32x4*)outbuf;
    for (size_t i = (size_t)bx * 512 + tid; i < (size_t)M * 512 * 2 / 16; i += (size_t)G * 512) dst[i] = src[i];
}
__device__ __forceinline__ void dbg_check_attn(unsigned char* ws, const float* outbuf, const int* pos, const float* rel_bias, LAS unsigned char* lds, int bx, int G, int tid) {
    unsigned* ctl = (unsigned*)(ws + WS_CTL);
    const bf16* AQc = (const bf16*)outbuf; const bf16* YA = (const bf16*)(ws + WS_YA); const bf16* YB = (const bf16*)(ws + WS_YB);
    const bf16* AK = (const bf16*)(ws + WS_AK); const bf16* AVT = (const bf16*)(ws + WS_AVT); const bf16* IQ = (const bf16*)(ws + WS_IQ); const bf16* IK = (const bf16*)(ws + WS_IK);
    const float* IW = (const float*)(ws + WS_IW); const unsigned long long* MASK = (const unsigned long long*)(ws + WS_MASK);
    const bf16* QB = (const bf16*)(ws + WS_QB); const bf16* KN = (const bf16*)(ws + WS_KN); const bf16* KR = (const bf16*)(ws + WS_KR); const bf16* VT = (const bf16*)(ws + WS_VT);
    LAS float* sc = (LAS float*)lds; LAS float* lg = sc + 2048; LAS float* sel = lg + 2048; LAS float* red = sel + 2048; LAS float* yacc = red + 16;
    for (int unit = bx; unit < NB * 12; unit += G) {
        const int b = unit / 12, t = dbg_sample_t(unit % 12); const size_t rowb = (size_t)b * SEQ;
        for (int s = tid; s < SEQ; s += 512) { float v = 0.f;
            if (s <= t) { for (int h = 0; h < 4; ++h) { float d = 0.f; for (int e = 0; e < 64; ++e) d += bf2f(IQ[(rowb + t) * 256 + h * 64 + e]) * bf2f(IK[(rowb + s) * 64 + e]); v += IW[(rowb + t) * 4 + h] * fmaxf(d, 0.f); } }
            sc[s] = v; }
        __syncthreads();
        int mism = 0;
        for (int s = tid; s < SEQ; s += 512) { float pick = 0.f;
            if (s <= t) { int cnt = 0; const float me = sc[s]; for (int s2 = 0; s2 <= t; ++s2) { const float o = sc[s2]; cnt += (o > me || (o == me && s2 < s)) ? 1 : 0; } pick = (t + 1 <= TOPK || cnt < TOPK) ? 1.f : 0.f; }
            sel[s] = pick;
            const int fast = (int)((MASK[((size_t)b * 32 + (s >> 6)) * SEQ + t] >> (s & 63)) & 1ull);
            mism += (fast != (int)pick) ? 1 : 0; }
        { const float tot = dbg_block_sum(red, (float)mism, tid); if (tid == 0 && tot > 0.f) atomicAdd(ctl + DBG_W_MASK, (unsigned)tot); }
        for (int h = 0; h < 8; ++h) {
            float lmax = -3e38f;
            for (int s = tid; s < SEQ; s += 512) { float v = -3e38f;
                if (s <= t && sel[s] != 0.f) { float d = 0.f; for (int e = 0; e < 64; ++e) d += bf2f(AQc[(rowb + t) * 512 + h * 64 + e]) * bf2f(AK[(rowb + s) * 64 + e]);
                    v = d + LOG2E * rel_bias[dbg_bucket(pos[rowb + t] - pos[rowb + s]) * 8 + h]; }
                lg[s] = v; lmax = fmaxf(lmax, v); }
            const float mx = dbg_block_max(red, lmax, tid);
            float ps = 0.f;
            for (int s = tid; s < SEQ; s += 512) { const float p = (lg[s] > -1e38f) ? exp2f(lg[s] - mx) : 0.f; lg[s] = p; ps += p; }
            const float tot = dbg_block_sum(red, ps, tid);
            { const int d = tid & 63, part = tid >> 6; float a = 0.f; for (int s = part; s <= t; s += 8) a += lg[s] * bf2f(AVT[((size_t)b * 64 + d) * SEQ + s]); yacc[part * 64 + d] = a; }
            __syncthreads();
            float err = 0.f, mag = 0.f;
            if (tid < 64) { float y = 0.f; for (int p = 0; p < 8; ++p) y += yacc[p * 64 + tid]; y /= tot; const float f = bf2f(YA[(rowb + t) * 512 + h * 64 + tid]); err = fabsf(f - y); mag = fabsf(y); }
            const float emax = dbg_block_max(red, err, tid), mmax = dbg_block_max(red, mag, tid);
            if (tid == 0) atomicMax(ctl + DBG_W_DSA, __float_as_uint(emax / (mmax + 1e-20f)));
            __syncthreads();
        }
        for (int h = 0; h < 8; ++h) {
            float lmax = -3e38f;
            for (int s = tid; s < SEQ; s += 512) { float v = -3e38f;
                if (s <= t) { float d = 0.f; for (int e = 0; e < 64; ++e) d += bf2f(QB[(rowb + t) * 768 + h * 96 + e]) * bf2f(KN[(rowb + s) * 512 + h * 64 + e]);
                    for (int e = 0; e < 32; ++e) d += bf2f(QB[(rowb + t) * 768 + h * 96 + 64 + e]) * bf2f(KR[(rowb + s) * 32 + e]); v = d; }
                lg[s] = v; lmax = fmaxf(lmax, v); }
            const float mx = dbg_block_max(red, lmax, tid);
            float ps = 0.f;
            for (int s = tid; s < SEQ; s += 512) { const float p = (lg[s] > -1e38f) ? exp2f(lg[s] - mx) : 0.f; lg[s] = p; ps += p; }
            const float tot = dbg_block_sum(red, ps, tid);
            { const int d = tid & 63, part = tid >> 6; float a = 0.f; for (int s = part; s <= t; s += 8) a += lg[s] * bf2f(VT[(size_t)(h * 64 + d) * M + rowb + s]); yacc[part * 64 + d] = a; }
            __syncthreads();
            float err = 0.f, mag = 0.f;
            if (tid < 64) { float y = 0.f; for (int p = 0; p < 8; ++p) y += yacc[p * 64 + tid]; y /= tot; const float f = bf2f(YB[(rowb + t) * 512 + h * 64 + tid]); err = fabsf(f - y); mag = fabsf(y); }
            const float emax = dbg_block_max(red, err, tid), mmax = dbg_block_max(red, mag, tid);
            if (tid == 0) atomicMax(ctl + DBG_W_MLA, __float_as_uint(emax / (mmax + 1e-20f)));
            __syncthreads();
        }
    }
}

__device__ __forceinline__ void dbg_upd(float& e, float& g, float fast, float ref) { e = fmaxf(e, fabsf(fast - ref)); g = fmaxf(g, fabsf(ref)); }
__device__ __forceinline__ void dbg_check_proj(unsigned char* ws, const int* pos, const float* w_in, const float* b_gate, const float* gq, const float* gkv, const float* w_uq, const float* w_ukv,
                                               LAS unsigned char* lds, int bx, int G, int tid) {
    unsigned* ctl = (unsigned*)(ws + WS_CTL);
    const bf16* H = (const bf16*)(ws + WS_H); const bf16* AQ = (const bf16*)(ws + WS_YA); const bf16* AK = (const bf16*)(ws + WS_AK); const bf16* AVT = (const bf16*)(ws + WS_AVT);
    const bf16* IQ = (const bf16*)(ws + WS_IQ); const bf16* IK = (const bf16*)(ws + WS_IK); const float* IW = (const float*)(ws + WS_IW); const bf16* GATES = (const bf16*)(ws + WS_GATES);
    const bf16* QB = (const bf16*)(ws + WS_QB); const bf16* KN = (const bf16*)(ws + WS_KN); const bf16* KR = (const bf16*)(ws + WS_KR); const bf16* VT = (const bf16*)(ws + WS_VT);
    LAS float* z = (LAS float*)lds;
    LAS float* hrow = z + 3456;
    LAS float* qb = hrow + 1024;
    LAS float* kvb = qb + 768;
    LAS float* red = kvb + 1024;
    for (int unit = bx; unit < 256; unit += G) {
        const int b = unit >> 4, t = (unit & 15) * 131 + 7; const size_t m = (size_t)b * SEQ + t;
        for (int k = tid; k < DM; k += 512) hrow[k] = bf2f(H[m * DM + k]);
        __syncthreads();
        for (int c = tid; c < DIN; c += 512) { float a = 0.f; for (int k = 0; k < DM; ++k) a += hrow[k] * w_in[(size_t)k * DIN + c]; z[c] = a; }
        __syncthreads();
        float e1 = 0.f, g1 = 0.f;
        for (int c = tid; c < 512; c += 512) dbg_upd(e1, g1, bf2f(AQ[m * 512 + c]), z[c] * C2A);
        float e1b = 0.f, g1b = 0.f;
        for (int c = tid; c < 64; c += 512) { dbg_upd(e1b, g1b, bf2f(AK[m * 64 + c]), z[512 + c]); dbg_upd(e1b, g1b, bf2f(AVT[((size_t)b * 64 + c) * SEQ + t]), z[576 + c]); dbg_upd(e1b, g1b, bf2f(IK[m * 64 + c]), z[896 + c]); }
        for (int c = tid; c < 256; c += 512) dbg_upd(e1b, g1b, bf2f(IQ[m * 256 + c]), z[640 + c]);
        for (int c = tid; c < 4; c += 512) dbg_upd(e1b, g1b, IW[m * 4 + c], z[960 + c]);
        float e1c = 0.f, g1c = 0.f;
        for (int c = tid; c < 2048; c += 512) dbg_upd(e1c, g1c, bf2f(GATES[m * 2048 + c]), 1.f / (1.f + expf(-(z[1380 + c] + b_gate[c]))));
        { const float ea = dbg_block_max(red, e1, tid), ga = dbg_block_max(red, g1, tid), eb = dbg_block_max(red, e1b, tid), gb = dbg_block_max(red, g1b, tid), ec = dbg_block_max(red, e1c, tid), gc = dbg_block_max(red, g1c, tid);
          if (tid == 0) atomicMax(ctl + DBG_W_DIR, __float_as_uint(fmaxf(fmaxf(ea / (ga + 1e-20f), eb / (gb + 1e-20f)), ec / (gc + 1e-20f)))); }
        float sq = 0.f; for (int k = tid; k < 256; k += 512) sq += z[964 + k] * z[964 + k];
        const float rq = 1.f / sqrtf(dbg_block_sum(red, sq, tid) / 256.f + EPS);
        float sk = 0.f; for (int k = tid; k < 128; k += 512) sk += z[1220 + k] * z[1220 + k];
        const float rk = 1.f / sqrtf(dbg_block_sum(red, sk, tid) / 128.f + EPS);
        for (int n = tid; n < 768; n += 512) { float a = 0.f; for (int k = 0; k < 256; ++k) a += z[964 + k] * rq * gq[k] * w_uq[(size_t)k * 768 + n]; qb[n] = a; }
        for (int n = tid; n < 1024; n += 512) { float a = 0.f; for (int k = 0; k < 128; ++k) a += z[1220 + k] * rk * gkv[k] * w_ukv[(size_t)k * 1024 + n]; kvb[n] = a; }
        __syncthreads();
        float e2 = 0.f, g2 = 0.f, e3 = 0.f, g3 = 0.f;
        const double p = (double)pos[m];
        for (int n = tid; n < 768; n += 512) { const int h = n / 96, c = n % 96; float ref;
            if (c < 64) ref = qb[n];
            else { const int j = c - 64, i = j >> 1; const double ang = p * pow(10000.0, -(double)(2 * i) / 32.0); const float cs = (float)cos(ang), sn = (float)sin(ang);
                   const float x1 = qb[h * 96 + 64 + i], x2 = qb[h * 96 + 80 + i]; ref = (j & 1) ? (x1 * sn + x2 * cs) : (x1 * cs - x2 * sn); }
            dbg_upd(e2, g2, bf2f(QB[m * 768 + n]), ref * C2B); }
        for (int n = tid; n < 512; n += 512) { const int h = n >> 6, d = n & 63;
            dbg_upd(e3, g3, bf2f(KN[m * 512 + n]), kvb[h * 128 + d]); dbg_upd(e3, g3, bf2f(VT[(size_t)n * M + m]), kvb[h * 128 + 64 + d]); }
        float e3b = 0.f, g3b = 0.f;
        for (int j = tid; j < 32; j += 512) { const int i = j >> 1; const double ang = p * pow(10000.0, -(double)(2 * i) / 32.0); const float cs = (float)cos(ang), sn = (float)sin(ang);
            const float x1 = z[1348 + i], x2 = z[1364 + i]; const float ref = (j & 1) ? (x1 * sn + x2 * cs) : (x1 * cs - x2 * sn); dbg_upd(e3b, g3b, bf2f(KR[m * 32 + j]), ref); }
        { const float ea = dbg_block_max(red, e2, tid), ga = dbg_block_max(red, g2, tid), eb = dbg_block_max(red, e3, tid), gb = dbg_block_max(red, g3, tid), ec = dbg_block_max(red, e3b, tid), gc = dbg_block_max(red, g3b, tid);
          if (tid == 0) { atomicMax(ctl + DBG_W_QB, __float_as_uint(ea / (ga + 1e-20f))); atomicMax(ctl + DBG_W_KV, __float_as_uint(fmaxf(eb / (gb + 1e-20f), ec / (gc + 1e-20f)))); } }
        __syncthreads();
    }
}

constexpr int DBG_W_CK = 32;
__device__ __forceinline__ void dbg_checksum(unsigned char* ws, float* outbuf, int phase, int rep, int bx, int G, int tid) {
    size_t lo = 0, hi = 0; const unsigned* base = (const unsigned*)ws;
    if (phase == 0) { lo = 1 * MiB; hi = 100 * MiB; }
    else if (phase == 1) { lo = 5 * MiB; hi = 7 * MiB; }
    else if (phase == 2) { lo = 356 * MiB; hi = 468 * MiB; }
    else if (phase == 3) { lo = 100 * MiB; hi = 164 * MiB; }
    else if (phase == 4) { lo = 356 * MiB; hi = 420 * MiB; }
    else { base = (const unsigned*)outbuf; lo = 0; hi = 128 * MiB; }
    unsigned long long acc = 0ull;
    for (size_t i = lo / 4 + (size_t)bx * 512 + tid; i < hi / 4; i += (size_t)G * 512) acc += (unsigned long long)base[i] * (unsigned long long)((i & 1023u) + 1u);
    if (phase == 1) for (size_t i = (100 * MiB) / 4 + (size_t)bx * 512 + tid; i < (356 * MiB) / 4; i += (size_t)G * 512) acc += (unsigned long long)base[i] * (unsigned long long)((i & 1023u) + 1u);
    if (phase == 2) for (size_t i = (220 * MiB) / 4 + (size_t)bx * 512 + tid; i < (228 * MiB) / 4; i += (size_t)G * 512) acc += (unsigned long long)base[i] * (unsigned long long)((i & 1023u) + 1u);
    for (int o = 1; o < 64; o <<= 1) acc += __shfl_xor(acc, o);
    if ((tid & 63) == 0) atomicAdd((unsigned long long*)(ws + WS_CTL) + (DBG_W_CK / 2 + 2 * phase + rep), acc);
}
__device__ __forceinline__ float dbg_output_scale(unsigned char* ws) {
    const unsigned* ctl = (const unsigned*)(ws + WS_CTL);
    float e[6]; for (int i = 0; i < 6; ++i) e[i] = __uint_as_float(__hip_atomic_load(ctl + 16 + i, __ATOMIC_RELAXED, __HIP_MEMORY_SCOPE_AGENT));
    const unsigned mm = __hip_atomic_load(ctl + DBG_W_MASK, __ATOMIC_RELAXED, __HIP_MEMORY_SCOPE_AGENT);
#define DBG_BK(x) ((x) < 0.04f ? 0 : ((x) < 0.2f ? 1 : 2))
#if DBG_CHECK == 3
    { const unsigned long long* ck = (const unsigned long long*)(ws + WS_CTL) + DBG_W_CK / 2; int k = 0;
      for (int p = 0; p < 6; ++p) { const unsigned long long a = __hip_atomic_load(ck + 2 * p, __ATOMIC_RELAXED, __HIP_MEMORY_SCOPE_AGENT), b = __hip_atomic_load(ck + 2 * p + 1, __ATOMIC_RELAXED, __HIP_MEMORY_SCOPE_AGENT); if (a != b) k += (1 << p); }
      (void)e; (void)mm; return 1.f + (float)k; }
    const int c1 = 0, c2 = 0, c3 = 0;
#elif DBG_CHECK == 1
    const int c1 = DBG_BK(e[0]), c2 = mm <= 20u ? 0 : (mm <= 2000u ? 1 : 2), c3 = DBG_BK(e[2]);
#else
    const int c1 = DBG_BK(e[3]), c2 = DBG_BK(e[4]), c3 = DBG_BK(e[5]);
#endif
    return 1.f + (float)(c1 + 3 * c2 + 9 * c3);
}
#endif
struct Args { const void* in[17]; float* out; unsigned char* ws; int ph_lo, ph_hi; };
__global__ void __launch_bounds__(NWAVES * 64, 2) trunk_fwd(Args args) {
    extern __shared__ __attribute__((aligned(16))) unsigned char lds[];
    Frame F;
    F.lds = (LAS unsigned char*)lds;
    F.tid = threadIdx.x; F.lane = F.tid & 63; F.wave = __builtin_amdgcn_readfirstlane(F.tid >> 6);
    F.G = gridDim.x; F.bx = blockIdx.x;
    F.x = (const float*)args.in[0]; F.pos = (const int*)args.in[1]; F.rel_bias = (const float*)args.in[15]; F.out = args.out; F.ws = args.ws;
    volatile LAS unsigned* MISC = (volatile LAS unsigned*)(F.lds + MISC_OFF);
    if (F.tid < 32) MISC[F.tid] = 0u;
#if defined(DBG_LDS_FILL)
    for (int i = F.tid; i < MISC_OFF / 4; i += NWAVES * 64) ((LAS unsigned*)F.lds)[i] = 0xffffffffu;
#endif
    __syncthreads();
    unsigned* ctl = (unsigned*)(F.ws + WS_CTL);
#if MK_ONE_LAUNCH
    XcdBarrier bar = xcd_barrier_post(ctl + CW_BAR, MISC + 8);
#define GRID_BAR() xcd_barrier(bar)
#else
#define GRID_BAR() do { } while (0)
#endif
    const float* g1 = (const float*)args.in[2]; const float* w_in = (const float*)args.in[3]; const float* b_gate = (const float*)args.in[4];
    const float* gq = (const float*)args.in[5]; const float* gkv = (const float*)args.in[6]; const float* w_uq = (const float*)args.in[7]; const float* w_ukv = (const float*)args.in[8];
    const float* w_a = (const float*)args.in[9]; const float* w_b = (const float*)args.in[10]; const float* w_out = (const float*)args.in[11]; const float* g2 = (const float*)args.in[12];
    const float* w_ff1 = (const float*)args.in[13]; const float* w_ff2 = (const float*)args.in[14]; const float* gf = (const float*)args.in[16];
#define PHASE_FRAME() \
    { int t_ = threadIdx.x; asm volatile("" : "+v"(t_)); F.tid = t_; F.lane = t_ & 63; F.wave = __builtin_amdgcn_readfirstlane(t_ >> 6); } \
    size_t z0_ = 0; asm volatile("" : "+s"(z0_)); unsigned char* ws = args.ws + z0_; F.ws = ws;     \
    bf16* WB = (bf16*)(ws + WS_W); bf16* H = (bf16*)(ws + WS_H); bf16* YA = (bf16*)(ws + WS_YA); \
    bf16* IQ = (bf16*)(ws + WS_IQ); bf16* CQ = (bf16*)(ws + WS_CQ); bf16* CKV = (bf16*)(ws + WS_CKV); bf16* AK = (bf16*)(ws + WS_AK); bf16* AVT = (bf16*)(ws + WS_AVT); \
    bf16* IK = (bf16*)(ws + WS_IK); bf16* KR = (bf16*)(ws + WS_KR); bf16* GATES = (bf16*)(ws + WS_GATES); bf16* QB = (bf16*)(ws + WS_QB); bf16* KN = (bf16*)(ws + WS_KN); \
    bf16* VT = (bf16*)(ws + WS_VT); bf16* MERGED = (bf16*)(ws + WS_MERGED); bf16* HID = (bf16*)(ws + WS_HID); \
    float* CS = (float*)(ws + WS_CS); float* SSQQ = (float*)(ws + WS_SSQQ); float* SSQKV = (float*)(ws + WS_SSQKV); float* IW = (float*)(ws + WS_IW); \
    (void)WB; (void)H; (void)YA; (void)IQ; (void)CQ; (void)CKV; (void)AK; (void)AVT; (void)IK; (void)KR; (void)GATES; (void)QB; (void)KN; (void)VT; (void)MERGED; (void)HID; (void)CS; (void)SSQQ; (void)SSQKV; (void)IW;
    const int lo = args.ph_lo, hi = args.ph_hi;
#ifndef DBG_ATT_SCALE
#define DBG_ATT_SCALE 1.0f
#endif
#ifndef PH_ENABLE
#define PH_ENABLE 0x3ff
#endif
#define PHON(k) (((PH_ENABLE) >> (k)) & 1)
#define IN(p) (lo <= (p) && (p) < hi)
#if defined(DBG_CHECK)
    if (lo == 1000) { dbg_check_attn(args.ws, F.out, F.pos, F.rel_bias, F.lds, F.bx, F.G, F.tid); return; }
    if (lo >= 2000 && lo < 2100) { dbg_checksum(args.ws, F.out, (lo - 2000) >> 1, (lo - 2000) & 1, F.bx, F.G, F.tid); return; }
    if (lo == 3000) {
        u32x4* w4 = (u32x4*)(args.ws + DBG_FILL_LO); const u32x4 nn = (u32x4){0xffffffffu, 0xffffffffu, 0xffffffffu, 0xffffffffu};
        for (size_t i = (size_t)F.bx * 512 + F.tid; i < (DBG_FILL_HI - DBG_FILL_LO) / 16; i += (size_t)F.G * 512) w4[i] = nn;
        u32x4* o4 = (u32x4*)F.out; for (size_t i = (size_t)F.bx * 512 + F.tid; i < (size_t)M * DM * 4 / 16; i += (size_t)F.G * 512) o4[i] = nn;
        return; }
    if (lo == 4000) {
        const unsigned* src = (const unsigned*)(args.ws + (size_t)(DBG_PROBE_OFF) * MiB);
        for (size_t i = (size_t)F.bx * 512 + F.tid; i < (size_t)M * DM; i += (size_t)F.G * 512) { const unsigned w = src[i];
            float a = __uint_as_float(w << 16), b = __uint_as_float(w & 0xffff0000u); if (!(fabsf(a) < 1e30f)) a = 0.f; if (!(fabsf(b) < 1e30f)) b = 0.f; F.out[i] = a + 2.f * b; }
        return; }
    if (lo == 1001) { dbg_check_proj(args.ws, F.pos, w_in, b_gate, gq, gkv, w_uq, w_ukv, F.lds, F.bx, F.G, F.tid); return; }
#endif
#if defined(DBG_SPLIT_BR)
    if (lo >= 5000 && lo < 5008) { PHASE_FRAME();
        pg8::Gemm g{YA, WB + W_AB_OFF, 2 * M, 2048, 512}; pg8::BranchOrder S; S.init(F.G, F.bx, lo & 1); pg8::EpiBranch E{MERGED, GATES};
        pg8::gemm_phase<pg8::EpiBranch, pg8::BranchOrder, true, true>(F.lds, g, S, E);
        return; }
#endif
    for (int l = 0; l < DEPTH; ++l) {
        const int p0 = l * PH_PER_LAYER;
        const float* xcur = (l == 0) ? F.x : F.out;
        if (PHON(0) && IN(p0 + 0)) { PHASE_FRAME();
            if (l == 0) rope_table(F);
            prep_weights(F, l, w_in, gq, gkv, w_uq, w_ukv, w_a, w_b, w_out, w_ff1, w_ff2);
            norm_rows<false>(F, xcur, g1 + l * DM, H, nullptr);
            GRID_BAR();
        }
        if (PHON(1) && IN(p0 + 1)) { PHASE_FRAME();
            pg8::Gemm g{H, WB + W_IN_OFF, M, NIN, DM}; pg8::StaticOrder S; S.init(M, NIN, F.G, F.bx);
            pg8::EpiIn E{YA, IQ, CQ, CKV, AK, AVT, IK, KR, GATES, IW, SSQQ, SSQKV, CS, b_gate + l * 2048};
            pg8::gemm_phase<pg8::EpiIn, pg8::StaticOrder, true, true>(F.lds, g, S, E);
            GRID_BAR();
        }
        if (PHON(2) && IN(p0 + 2)) { PHASE_FRAME();
#ifndef SUB_ENABLE
#define SUB_ENABLE 0xf
#endif
            if ((SUB_ENABLE) & 1) { pg8::Gemm g{CQ, WB + W_UQ_OFF, M, 768, 256}; pg8::StaticOrder S; S.init(M, 768, F.G, F.bx); pg8::EpiUQ E{QB, SSQQ, CS};
              pg8::gemm_phase<pg8::EpiUQ, pg8::StaticOrder, true, true>(F.lds, g, S, E); }
            if ((SUB_ENABLE) & 2) { pg8::Gemm g{CKV, WB + W_UK_OFF, M, 512, 128}; pg8::StaticOrder S; S.init(M, 512, F.G, F.bx); pg8::EpiUK E{KN, SSQKV};
              pg8::gemm_phase<pg8::EpiUK, pg8::StaticOrder, true, true>(F.lds, g, S, E); }
            if ((SUB_ENABLE) & 4) { pg8::Gemm g{WB + W_UV_OFF, CKV, 512, M, 128}; pg8::StaticOrder S; S.init(512, M, F.G, F.bx); pg8::EpiUV E{VT, SSQKV};
              pg8::gemm_phase<pg8::EpiUV, pg8::StaticOrder, true, true>(F.lds, g, S, E); }
            if ((SUB_ENABLE) & 8) idx_phase(F);
#if defined(DBG_CHECK)
            if (l == 0) dbg_copy_aq(F.ws, F.out, F.bx, F.G, F.tid);
#endif
            GRID_BAR();
        }
        if (PHON(3) && IN(p0 + 3)) { PHASE_FRAME(); attn_phase(F); GRID_BAR(); }
        if (PHON(4) && IN(p0 + 4)) { PHASE_FRAME();
            pg8::Gemm g{YA, WB + W_AB_OFF, 2 * M, 2048, 512}; pg8::BranchOrder S; S.init(F.G, F.bx); pg8::EpiBranch E{MERGED, GATES};
            pg8::gemm_phase<pg8::EpiBranch, pg8::BranchOrder, true, true>(F.lds, g, S, E);
            GRID_BAR();
        }
        if (PHON(5) && IN(p0 + 5)) { PHASE_FRAME();
            pg8::Gemm g{MERGED, WB + W_OUT_OFF, M, DM, DM}; pg8::StaticOrder S; S.init(M, DM, F.G, F.bx); pg8::EpiRes E{xcur, F.out, DBG_ATT_SCALE};
            pg8::gemm_phase<pg8::EpiRes, pg8::StaticOrder, true, true>(F.lds, g, S, E);
            GRID_BAR();
        }
        if (PHON(6) && IN(p0 + 6)) { PHASE_FRAME(); norm_rows<false>(F, F.out, g2 + l * DM, H, nullptr); GRID_BAR(); }
        if (PHON(7) && IN(p0 + 7)) { PHASE_FRAME();
            pg8::Gemm g{H, WB + W_FF1_OFF, M, DFF, DM}; pg8::StaticOrder S; S.init(M, DFF, F.G, F.bx); pg8::EpiFF1 E{HID};
            pg8::gemm_phase<pg8::EpiFF1, pg8::StaticOrder, true, true>(F.lds, g, S, E);
            GRID_BAR();
        }
        if (PHON(8) && IN(p0 + 8)) { PHASE_FRAME();
            pg8::Gemm g{HID, WB + W_FF2_OFF, M, DM, DFF}; pg8::StaticOrder S; S.init(M, DM, F.G, F.bx); pg8::EpiRes E{F.out, F.out, 1.0f};
            pg8::gemm_phase<pg8::EpiRes, pg8::StaticOrder, true, true>(F.lds, g, S, E);
            GRID_BAR();
        }
    }
    if (PHON(9) && IN(DEPTH * PH_PER_LAYER)) { PHASE_FRAME(); float osc = 1.f;
#if defined(DBG_CHECK)
        osc = dbg_output_scale(F.ws);
#endif
        norm_rows<true>(F, F.out, gf, nullptr, F.out, osc); }
#undef IN
}

extern "C" void kernel_launch(void* const* d_in, const int* in_sizes, int n_in, void* d_out, int out_size, void* d_ws, size_t ws_size, hipStream_t stream) {
    static int grid = 0;
    if (grid == 0) {
        if (n_in != 17 || in_sizes[0] != M * DM || out_size != M * DM || ws_size < WS_END) { fprintf(stderr, "kernel_launch: unexpected shapes (n_in %d, in0 %d, out %d, ws %zu); nothing launched\n", n_in, n_in > 0 ? in_sizes[0] : -1, out_size, ws_size); grid = -1; return; }
        int dev = 0, cus = 0, per_cu = 0;
        if (hipGetDevice(&dev) != hipSuccess || hipDeviceGetAttribute(&cus, hipDeviceAttributeMultiprocessorCount, dev) != hipSuccess) { grid = -1; return; }
        if (hipFuncSetAttribute((const void*)trunk_fwd, hipFuncAttributeMaxDynamicSharedMemorySize, LDS_BYTES) != hipSuccess) { fprintf(stderr, "kernel_launch: hipFuncSetAttribute failed\n"); grid = -1; return; }
        if (hipOccupancyMaxActiveBlocksPerMultiprocessor(&per_cu, (const void*)trunk_fwd, NWAVES * 64, LDS_BYTES) != hipSuccess || per_cu < 1)
            fprintf(stderr, "kernel_launch: note: occupancy query reports %d workgroups per CU\n", per_cu);
        (void)hipGetLastError();
        grid = cus;
    }
    if (grid < 0) return;
    if (hipMemsetAsync((char*)d_ws + WS_CTL, 0, CTL_ZERO_BYTES, stream) != hipSuccess) return;
    Args a{};
    for (int i = 0; i < 17; ++i) a.in[i] = d_in[i];
    a.out = (float*)d_out; a.ws = (unsigned char*)d_ws;
#if MK_ONE_LAUNCH
    a.ph_lo = 0; a.ph_hi = N_PHASES;
    hipLaunchKernelGGL(trunk_fwd, dim3(grid), dim3(NWAVES * 64), LDS_BYTES, stream, a);
#elif defined(DBG_CHECK) && DBG_CHECK == 3
#define DBG_L(a_, b_) do { a.ph_lo = (a_); a.ph_hi = (b_); hipLaunchKernelGGL(trunk_fwd, dim3(grid), dim3(NWAVES * 64), LDS_BYTES, stream, a); } while (0)
    DBG_L(0, 1); DBG_L(2000, 2001); DBG_L(0, 1); DBG_L(2001, 2002);
    DBG_L(1, 2); DBG_L(2002, 2003); DBG_L(1, 2); DBG_L(2003, 2004);
    DBG_L(2, 3); DBG_L(2004, 2005); DBG_L(2, 3); DBG_L(2005, 2006);
    DBG_L(3, 4); DBG_L(2006, 2007); DBG_L(1, 2); DBG_L(3, 4); DBG_L(2007, 2008);
    DBG_L(4, 5); DBG_L(2008, 2009); DBG_L(2, 3); DBG_L(4, 5); DBG_L(2009, 2010);
    DBG_L(5, 6); DBG_L(2010, 2011); DBG_L(5, 6); DBG_L(2011, 2012);
    for (int p = 6; p < N_PHASES; ++p) DBG_L(p, p + 1);
#elif defined(DBG_CHECK) && DBG_CHECK == 5
    a.ph_lo = 3000; a.ph_hi = 3001; hipLaunchKernelGGL(trunk_fwd, dim3(grid), dim3(NWAVES * 64), LDS_BYTES, stream, a);
    for (int p = 0; p < (DBG_PROBE_PH); ++p) { a.ph_lo = p; a.ph_hi = p + 1; hipLaunchKernelGGL(trunk_fwd, dim3(grid), dim3(NWAVES * 64), LDS_BYTES, stream, a); }
    if ((DBG_PROBE_OFF) >= 0) { a.ph_lo = 4000; a.ph_hi = 4001; hipLaunchKernelGGL(trunk_fwd, dim3(grid), dim3(NWAVES * 64), LDS_BYTES, stream, a); }
#elif defined(DBG_CHECK) && DBG_CHECK == 4
    a.ph_lo = 3000; a.ph_hi = 3001; hipLaunchKernelGGL(trunk_fwd, dim3(grid), dim3(NWAVES * 64), LDS_BYTES, stream, a);
    for (int p = 0; p < N_PHASES; ++p) { a.ph_lo = p; a.ph_hi = p + 1; hipLaunchKernelGGL(trunk_fwd, dim3(grid), dim3(NWAVES * 64), LDS_BYTES, stream, a); }
#else
    for (int p = 0; p < N_PHASES; ++p) {
#if defined(DBG_SPLIT_BR)
        if (p < DEPTH * PH_PER_LAYER && p % PH_PER_LAYER == 4) { for (int br = 0; br < 2; ++br) { a.ph_lo = 5000 + 2 * (p / PH_PER_LAYER) + br; a.ph_hi = a.ph_lo + 1; hipLaunchKernelGGL(trunk_fwd, dim3(grid), dim3(NWAVES * 64), LDS_BYTES, stream, a); } continue; }
#endif
        a.ph_lo = p; a.ph_hi = p + 1; hipLaunchKernelGGL(trunk_fwd, dim3(grid), dim3(NWAVES * 64), LDS_BYTES, stream, a);
#if defined(DBG_CHECK)
        if (p == 3) { a.ph_lo = 1000; a.ph_hi = 1001; hipLaunchKernelGGL(trunk_fwd, dim3(grid), dim3(NWAVES * 64), LDS_BYTES, stream, a); }
        if (p == 2) { a.ph_lo = 1001; a.ph_hi = 1002; hipLaunchKernelGGL(trunk_fwd, dim3(grid), dim3(NWAVES * 64), LDS_BYTES, stream, a); }
#endif
    }
#endif
}
```

```cpp
#include <hip/hip_runtime.h>
#include <cstdio>
#include <cstdint>
namespace pg8 {
#define PG8_LAS __attribute__((address_space(3)))
typedef unsigned short bf16_t;
typedef short bf16x8 __attribute__((ext_vector_type(8)));
typedef float f32x4 __attribute__((ext_vector_type(4)));
typedef unsigned u32x4 __attribute__((ext_vector_type(4)));
constexpr int BM = 256, BK = 64, HALF = 128, HTB = HALF * BK * 2  , STAGE_BYTES = 8 * HTB, NXCD = 8, WGM = 8;

__host__ __device__ __forceinline__ int lds_byte(int r, int c) { const int st = (r >> 4) * 2 + (c >> 5), rr = r & 15, cc = c & 31, ob = rr * 64 + cc * 2; return st * 1024 + (ob ^ (((ob >> 9) & 1) << 5)); }
__host__ __device__ __forceinline__ void stage_rc(int b, int& R, int& C) { const int st = b / 1024, sb = b % 1024, swz = sb ^ (((sb >> 9) & 1) << 5); R = (st >> 1) * 16 + swz / 64; C = (st & 1) * 32 + (swz % 64) / 2; }
__host__ __device__ __forceinline__ int perm32(int rho) { const int n = rho >> 4, i = rho & 15; return 8 * (i >> 2) + 4 * n + (i & 3); }

struct Unit { int pm, pn; };
struct Gemm { const bf16_t* A; const bf16_t* Bt; int M, N, K; };

struct StaticOrder {
    int nM, nN, nwg, G, c;
    __host__ __device__ void init(int M, int N, int G_, int c_) { nM = M / BM; nN = N / BM; nwg = nM * nN; G = G_; c = c_; }
    __host__ __device__ bool next(int i, Unit& u) const {
        const long L = (long)i * G + c; if (L >= nwg) return false;
        int wgid = (int)L; { const int q = nwg / NXCD, r = nwg % NXCD, xcd = wgid % NXCD, off = wgid / NXCD; wgid = (xcd < r ? xcd * (q + 1) : r * (q + 1) + (xcd - r) * q) + off; }
        const int nig = WGM * nN, gid = wgid / nig, fm = gid * WGM, gsz = (nM - fm) < WGM ? (nM - fm) : WGM;
        u.pm = fm + ((wgid % nig) % gsz); u.pn = (wgid % nig) / gsz; return true;
    }
    __device__ __forceinline__ void a_ready(const Unit&) const {}
    __device__ __forceinline__ void done(const Unit&) const {}
};

typedef float f32x2c_t __attribute__((ext_vector_type(2))); typedef __bf16 bf16x2c_t __attribute__((ext_vector_type(2)));
__device__ __forceinline__ unsigned cvt_pk_bf16(float lo, float hi) { const f32x2c_t v = {lo, hi}; const bf16x2c_t b = __builtin_convertvector(v, bf16x2c_t); return __builtin_bit_cast(unsigned, b); }
typedef float f32x2 __attribute__((ext_vector_type(2)));
template <class Epi, class Sched, bool ALIGN_EPI = false, bool SP2 = false>
__device__ __forceinline__ void gemm_phase(PG8_LAS unsigned char* lds, const Gemm g, const Sched& S, const Epi& E) {
    int tid_ = threadIdx.x; asm volatile("" : "+v"(tid_));
    const int tid = tid_, wid = __builtin_amdgcn_readfirstlane(tid >> 6), lane = tid & 63, wr = wid >> 2, wc = wid & 3, fr = lane & 15, fq = lane >> 4;
    int Kx_ = g.K; asm volatile("" : "+s"(Kx_)); const int K = Kx_, nt = K / BK;
    unsigned voffA[2], voffB[2];
#pragma unroll
    for (int i = 0; i < 2; ++i) { int R, C; stage_rc(tid * 16 + i * 8192, R, C); const int Rb = Epi::PERM ? ((R & ~31) + perm32(R & 31)) : R;
        voffA[i] = (unsigned)(R * K + C) * 2u; voffB[i] = (unsigned)(Rb * K + C) * 2u; }
    const size_t kstep = (size_t)(BK * 2);
    const size_t hstep = (size_t)HALF * K * 2;
    const size_t tstep = 2 * hstep;
    const unsigned ldsw = (unsigned)wid * 1024u;
    const int aoff = lds_byte(wr * 64 + fr, fq * 8), boff = lds_byte(wc * 32 + fr, fq * 8);
#define PG8_SA(b, h) (((b) * 2 + (h)) * HTB)
#define PG8_SB(b, h) ((4 + (b) * 2 + (h)) * HTB)
#define PG8_STAGE(bufoff, gbase, voff) do { _Pragma("unroll") for (int _i = 0; _i < 2; ++_i) \
        __builtin_amdgcn_global_load_lds((const unsigned*)((const char*)(gbase) + (voff)[_i]), (PG8_LAS unsigned*)(lds + (bufoff) + ldsw + _i * 8192), 16, 0, 0); } while (0)
#define PG8_LDA(dst, b, h) do { _Pragma("unroll") for (int m = 0; m < 4; ++m) _Pragma("unroll") for (int k = 0; k < 2; ++k) dst[m][k] = *(const PG8_LAS bf16x8*)(lds + PG8_SA(b, h) + aoff + m * 2048 + k * 1024); } while (0)
#define PG8_LDB(dst, b, h) do { _Pragma("unroll") for (int n = 0; n < 2; ++n) _Pragma("unroll") for (int k = 0; k < 2; ++k) dst[n][k] = *(const PG8_LAS bf16x8*)(lds + PG8_SB(b, h) + boff + n * 2048 + k * 1024); } while (0)
#define PG8_MMA(ai, bj, At, Bt) do { __builtin_amdgcn_s_setprio(1); _Pragma("unroll") for (int m = 0; m < 4; ++m) _Pragma("unroll") for (int n = 0; n < 2; ++n) _Pragma("unroll") for (int k = 0; k < 2; ++k) \
        acc[ai][bj][m][n] = __builtin_amdgcn_mfma_f32_16x16x32_bf16(Bt[n][k], At[m][k], acc[ai][bj][m][n], 0, 0, 0); __builtin_amdgcn_s_setprio(0); } while (0)
#define PG8_WAIT_V(n) asm volatile("s_waitcnt vmcnt(" #n ")" ::: "memory")
#define PG8_WAIT_L(n) asm volatile("s_waitcnt lgkmcnt(" #n ")" ::: "memory")
#define PG8_BAR __builtin_amdgcn_s_barrier()
#define PG8_SCHED __builtin_amdgcn_sched_barrier(0)
    Unit cur, nxt; int ui = 0;
    if (!S.next(0, cur)) return;
    f32x4 acc[2][2][4][2];
#pragma unroll
    for (int a = 0; a < 2; ++a)
#pragma unroll
        for (int b = 0; b < 2; ++b)
#pragma unroll
            for (int m = 0; m < 4; ++m)
#pragma unroll
                for (int n = 0; n < 2; ++n) acc[a][b][m][n] = (f32x4){0.f, 0.f, 0.f, 0.f};
    bf16x8 At[4][2], B0[2][2], B1[2][2];
    const char* cA = (const char*)g.A + (size_t)cur.pm * tstep; const char* cB = (const char*)g.Bt + (size_t)cur.pn * tstep;
    S.a_ready(cur);
    if constexpr (SP2) {
        PG8_STAGE(PG8_SB(0, 0), cB, voffB); PG8_STAGE(PG8_SB(0, 1), cB + hstep, voffB); PG8_STAGE(PG8_SA(0, 0), cA, voffA); PG8_STAGE(PG8_SA(0, 1), cA + hstep, voffA);
        if (wr == 1) PG8_BAR;
        PG8_WAIT_V(2); PG8_BAR;
        PG8_STAGE(PG8_SB(1, 0), cB + kstep, voffB); PG8_STAGE(PG8_SA(1, 0), cA + kstep, voffA); PG8_STAGE(PG8_SB(1, 1), cB + hstep + kstep, voffB);
        PG8_WAIT_V(6); PG8_BAR;
    } else {
        PG8_STAGE(PG8_SB(0, 0), cB, voffB); PG8_STAGE(PG8_SA(0, 0), cA, voffA); PG8_STAGE(PG8_SB(0, 1), cB + hstep, voffB); PG8_STAGE(PG8_SA(0, 1), cA + hstep, voffA);
        if (wr == 1) PG8_BAR;
        PG8_WAIT_V(4); PG8_BAR;
        PG8_STAGE(PG8_SB(1, 0), cB + kstep, voffB); PG8_STAGE(PG8_SA(1, 0), cA + kstep, voffA); PG8_STAGE(PG8_SB(1, 1), cB + hstep + kstep, voffB);
        PG8_WAIT_V(6); PG8_BAR;
    }
    for (;;) {
        const bool has_next = S.next(ui + 1, nxt);
        const char* nA = has_next ? (const char*)g.A + (size_t)nxt.pm * tstep : cA; const char* nB = has_next ? (const char*)g.Bt + (size_t)nxt.pn * tstep : cB;
        for (int t = 0; t < nt; t += 2) {
            const bool last = (t == nt - 2);
            const char* a1 = cA + (size_t)(t + 1) * kstep;
            const char* a2 = last ? nA : cA + (size_t)(t + 2) * kstep; const char* b2 = last ? nB : cB + (size_t)(t + 2) * kstep;
            const char* a3 = a2 + kstep; const char* b3 = b2 + kstep;
            if (last && has_next) S.a_ready(nxt);
            if constexpr (SP2) {
            PG8_LDB(B0, 0, 0); PG8_LDB(B1, 0, 1); PG8_SCHED; PG8_LDA(At, 0, 0); PG8_STAGE(PG8_SA(1, 1), a1 + hstep, voffA);
            PG8_WAIT_V(8); PG8_WAIT_L(0); PG8_BAR; PG8_MMA(0, 0, At, B0); PG8_MMA(0, 1, At, B1); PG8_BAR; PG8_SCHED;
            PG8_LDA(At, 0, 1); PG8_STAGE(PG8_SB(0, 0), b2, voffB); PG8_STAGE(PG8_SB(0, 1), b2 + hstep, voffB); PG8_STAGE(PG8_SA(0, 0), a2, voffA);
            PG8_WAIT_V(8); PG8_WAIT_L(0); PG8_BAR; PG8_MMA(1, 0, At, B0); PG8_MMA(1, 1, At, B1); PG8_BAR; PG8_SCHED;
            PG8_LDB(B0, 1, 0); PG8_LDB(B1, 1, 1); PG8_SCHED; PG8_LDA(At, 1, 0); PG8_STAGE(PG8_SA(0, 1), a2 + hstep, voffA);
            PG8_WAIT_V(8); PG8_WAIT_L(0); PG8_BAR; PG8_MMA(0, 0, At, B0); PG8_MMA(0, 1, At, B1); PG8_BAR; PG8_SCHED;
            PG8_LDA(At, 1, 1); PG8_STAGE(PG8_SB(1, 0), b3, voffB); PG8_STAGE(PG8_SB(1, 1), b3 + hstep, voffB); PG8_STAGE(PG8_SA(1, 0), a3, voffA);
            PG8_WAIT_V(8); PG8_WAIT_L(0); PG8_BAR; PG8_MMA(1, 0, At, B0); PG8_MMA(1, 1, At, B1); PG8_BAR; PG8_SCHED;
            } else {
            PG8_LDB(B0, 0, 0); PG8_SCHED; PG8_LDA(At, 0, 0); PG8_STAGE(PG8_SA(1, 1), a1 + hstep, voffA);
            PG8_WAIT_L(8); PG8_BAR; PG8_WAIT_L(0); PG8_MMA(0, 0, At, B0); PG8_BAR; PG8_SCHED;
            PG8_LDB(B1, 0, 1); PG8_STAGE(PG8_SB(0, 0), b2, voffB);
            PG8_BAR; PG8_WAIT_L(0); PG8_MMA(0, 1, At, B1); PG8_BAR;
            PG8_LDA(At, 0, 1); PG8_STAGE(PG8_SA(0, 0), a2, voffA);
            PG8_BAR; PG8_WAIT_L(0); PG8_MMA(1, 0, At, B0); PG8_BAR; PG8_SCHED;
            PG8_STAGE(PG8_SB(0, 1), b2 + hstep, voffB);
            PG8_WAIT_V(6); PG8_BAR; PG8_MMA(1, 1, At, B1); PG8_BAR;
            PG8_LDB(B0, 1, 0); PG8_SCHED; PG8_LDA(At, 1, 0); PG8_STAGE(PG8_SA(0, 1), a2 + hstep, voffA);
            PG8_WAIT_L(8); PG8_BAR; PG8_WAIT_L(0); PG8_MMA(0, 0, At, B0); PG8_BAR; PG8_SCHED;
            PG8_LDB(B1, 1, 1); PG8_STAGE(PG8_SB(1, 0), b3, voffB);
            PG8_BAR; PG8_WAIT_L(0); PG8_MMA(0, 1, At, B1); PG8_BAR;
            PG8_LDA(At, 1, 1); PG8_STAGE(PG8_SA(1, 0), a3, voffA);
            PG8_BAR; PG8_WAIT_L(0); PG8_MMA(1, 0, At, B0); PG8_BAR; PG8_SCHED;
            PG8_STAGE(PG8_SB(1, 1), b3 + hstep, voffB);
            PG8_WAIT_V(6); PG8_BAR; PG8_MMA(1, 1, At, B1); PG8_BAR;
            }
        }
        if constexpr (ALIGN_EPI) { if (wr == 0) PG8_BAR; }
        if constexpr (!Epi::AFTER_DRAIN) { E(acc, cur, wr, wc, fr, fq); S.done(cur); }
        if (!has_next) break;
#pragma unroll
        for (int a = 0; a < 2; ++a)
#pragma unroll
            for (int b = 0; b < 2; ++b)
#pragma unroll
                for (int m = 0; m < 4; ++m)
#pragma unroll
                    for (int n = 0; n < 2; ++n) acc[a][b][m][n] = (f32x4){0.f, 0.f, 0.f, 0.f};
        cur = nxt; cA = nA; cB = nB; ++ui;
        if constexpr (ALIGN_EPI) { if (wr == 1) PG8_BAR; }
    }
    PG8_WAIT_V(0);
    if constexpr (!ALIGN_EPI) { if (wr == 0) PG8_BAR; }
    PG8_BAR;
    if constexpr (Epi::AFTER_DRAIN) { E.fused(acc, cur, wr, wc, fr, fq, lds, wid, lane); S.done(cur); }
#undef PG8_SA
#undef PG8_SB
#undef PG8_STAGE
#undef PG8_LDA
#undef PG8_LDB
#undef PG8_MMA
#undef PG8_WAIT_V
#undef PG8_WAIT_L
#undef PG8_BAR
#undef PG8_SCHED
}
}
#define LAS __attribute__((address_space(3)))
#define XB_TMO      128
#define XB_XCNT(j)  (256  + 64 * (j))
#define XB_XSUB(j)  (1280 + 64 * (j))
#define XB_XGEN(j)  (2304 + 64 * (j))
#define XB_TOP      3328
#define XB_TOPGEN   3392
#define XCD_BAR_WORDS 3456
#define XB_SPIN_CAP (1u << 18)

__device__ __forceinline__ unsigned xb_ld(unsigned* p)              { return __hip_atomic_load(p, __ATOMIC_RELAXED, __HIP_MEMORY_SCOPE_AGENT); }
__device__ __forceinline__ unsigned xb_add(unsigned* p, unsigned v) { return __hip_atomic_fetch_add(p, v, __ATOMIC_RELAXED, __HIP_MEMORY_SCOPE_AGENT); }
__device__ __forceinline__ unsigned xb_xcc_id() { return (unsigned)__builtin_amdgcn_s_getreg((3 << 11) | 20) & 0xFu; }
#define XB_SPIN(cond, bar) do { unsigned _sp = 0; while (cond) { __builtin_amdgcn_s_sleep(1); \
    if ((++_sp & 255u) == 0u) { if (xb_ld(&(bar)[XB_TMO])) break; if (_sp > XB_SPIN_CAP) { atomicAdd(&(bar)[XB_TMO], 1u); break; } } } } while (0)

struct XcdBarrier {
    unsigned* bar; unsigned x;
    volatile LAS unsigned* st;
};

__device__ __forceinline__ XcdBarrier xcd_barrier_post(unsigned* bar, volatile LAS unsigned* st) {
    XcdBarrier b; b.bar = bar; b.x = xb_xcc_id(); b.st = st;
    if (threadIdx.x == 0) (void)xb_add(&bar[XB_XCNT(b.x)], 1u);
    return b;
}
__device__ __forceinline__ void xcd_barrier_complete(unsigned* bar, unsigned x, unsigned& nloc, unsigned& nx) {
    const unsigned G = gridDim.x * gridDim.y * gridDim.z;
    unsigned sum, cnt, mine, sp = 0u;
    for (;;) {
        sum = 0u; cnt = 0u; mine = 0u;
#pragma unroll
        for (unsigned j = 0; j < 16; ++j) { const unsigned c = xb_ld(&bar[XB_XCNT(j)]); sum += c; cnt += (c > 0u) ? 1u : 0u; mine = (j == x) ? c : mine; }
        if (sum == G) break;
        __builtin_amdgcn_s_sleep(1);
        if ((++sp & 255u) == 0u) { if (xb_ld(&bar[XB_TMO])) break; if (sp > XB_SPIN_CAP) { atomicAdd(&bar[XB_TMO], 1u); break; } }
    }
    nloc = mine > 0u ? mine : 1u; nx = cnt > 0u ? cnt : 1u;
}

__device__ __forceinline__ void xcd_barrier(const XcdBarrier& b) {
    asm volatile("s_waitcnt vmcnt(0)" ::: "memory");
    __syncthreads();
    if (threadIdx.x == 0) {
        unsigned* bar = b.bar;
        __builtin_amdgcn_s_waitcnt(0);
        unsigned nloc = b.st[0], nx = b.st[1];
        if (nloc == 0u) { xcd_barrier_complete(bar, b.x, nloc, nx); b.st[0] = nloc; b.st[1] = nx; }
        const unsigned old = xb_add(&bar[XB_XSUB(b.x)], 1u);
        const unsigned gen = old / nloc;
        if (old + 1u == (gen + 1u) * nloc) {
            __builtin_amdgcn_fence(__ATOMIC_RELEASE, "agent");
            asm volatile("s_waitcnt vmcnt(0)" ::: "memory");
            const unsigned og = xb_add(&bar[XB_TOP], 1u);
            const unsigned tg = og / nx;
            if (og + 1u == (tg + 1u) * nx) xb_add(&bar[XB_TOPGEN], 1u);
            else XB_SPIN(xb_ld(&bar[XB_TOPGEN]) == tg, bar);
            __builtin_amdgcn_fence(__ATOMIC_ACQUIRE, "agent");
            xb_add(&bar[XB_XGEN(b.x)], 1u);
            asm volatile("s_waitcnt vmcnt(0)" ::: "memory");
        } else {
            XB_SPIN(xb_ld(&bar[XB_XGEN(b.x)]) == gen, bar);
            __builtin_amdgcn_fence(__ATOMIC_ACQUIRE, "agent");
            asm volatile("s_waitcnt vmcnt(0)" ::: "memory");
        }
    }
    __syncthreads();
}
#define GAS __attribute__((address_space(1)))
typedef unsigned short bf16;
typedef unsigned u32x4 __attribute__((ext_vector_type(4)));
typedef unsigned u32x2 __attribute__((ext_vector_type(2)));
typedef float f32x4 __attribute__((ext_vector_type(4)));
typedef float f32x16 __attribute__((ext_vector_type(16)));
typedef short bf16x8 __attribute__((ext_vector_type(8)));
typedef int i32x4 __attribute__((ext_vector_type(4)));
#define LDS_WAIT() asm volatile("s_waitcnt lgkmcnt(0)" ::: "memory")

constexpr int NWAVES = 8;
constexpr int NB = 16, SEQ = 2048, M = NB * SEQ, DM = 1024, DEPTH = 4, DIN = 3428, NIN = 3584, DFF = 4096;
constexpr int TOPK = 256;
constexpr float EPS = 1e-6f;
constexpr float LOG2E = 1.4426950408889634f;
constexpr float C2A = 0.125f * LOG2E;
constexpr float C2B = 0.10206207261596575f * LOG2E;
#ifndef MK_ONE_LAUNCH
#define MK_ONE_LAUNCH 1
#endif
constexpr int PH_PER_LAYER = 9, N_PHASES = DEPTH * PH_PER_LAYER + 1;

constexpr size_t MiB = 1u << 20;
constexpr size_t WS_CTL = 0, CTL_ZERO_BYTES = 64 * 1024;
constexpr int CW_BAR = 1024;
constexpr size_t WS_CS = 1 * MiB;
constexpr size_t WS_SSQQ = 5 * MiB, WS_SSQKV = 5 * MiB + 512 * 1024;
constexpr size_t WS_IW = 6 * MiB;
constexpr size_t WS_PTAB = 7 * MiB;
constexpr size_t WS_W = 8 * MiB;
constexpr size_t W_IN_OFF = 0, W_UQ_OFF = (size_t)NIN * 1024, W_UK_OFF = W_UQ_OFF + 768 * 256, W_UV_OFF = W_UK_OFF + 512 * 128, W_AB_OFF = W_UV_OFF + 512 * 128,
                 W_OUT_OFF = W_AB_OFF + 2048 * 512, W_FF1_OFF = W_OUT_OFF + 1024 * 1024, W_FF2_OFF = W_FF1_OFF + 4096 * 1024, W_END_OFF = W_FF2_OFF + 4096 * 1024;
static_assert(W_END_OFF * 2 <= 28 * MiB, "weight copies");
constexpr size_t WS_H = 36 * MiB;
constexpr size_t WS_YA = 100 * MiB, WS_YB = 132 * MiB;
constexpr size_t WS_IQ = 164 * MiB, WS_CQ = 180 * MiB, WS_CKV = 196 * MiB, WS_AK = 204 * MiB, WS_AVT = 208 * MiB, WS_IK = 212 * MiB, WS_KR = 216 * MiB;
constexpr size_t WS_RSS = 468 * MiB;
constexpr size_t WS_MASK = 220 * MiB;
constexpr size_t WS_GATES = 228 * MiB;
constexpr size_t WS_QB = 356 * MiB, WS_KN = 404 * MiB, WS_VT = 436 * MiB, WS_END = 470 * MiB;
constexpr size_t WS_MERGED = 356 * MiB;
constexpr size_t WS_HID = 100 * MiB;
static_assert(WS_YB == WS_YA + (size_t)M * 512 * 2 && WS_HID + (size_t)M * DFF * 2 <= WS_MERGED && WS_MERGED + (size_t)M * DM * 2 <= WS_VT, "d_ws map");

constexpr int RING_BYTES = 131072;
constexpr int MISC_OFF = 143360;
constexpr int LDS_BYTES = 147456;

struct Frame {
    LAS unsigned char* lds;
    int tid, lane, wave, G, bx;
    const float* x; const int* pos; const float* rel_bias; float* out;
    unsigned char* ws;
};

namespace pg8 {
typedef unsigned u32x2v __attribute__((ext_vector_type(2)));
__device__ __forceinline__ u32x4 pack8(const f32x4 a, const f32x4 b) { u32x4 w; w.x = cvt_pk_bf16(a[0], a[1]); w.y = cvt_pk_bf16(a[2], a[3]); w.z = cvt_pk_bf16(b[0], b[1]); w.w = cvt_pk_bf16(b[2], b[3]); return w; }
__device__ __forceinline__ float ssq8(const f32x4 a, const f32x4 b) { return (a[0] * a[0] + a[1] * a[1]) + (a[2] * a[2] + a[3] * a[3]) + (b[0] * b[0] + b[1] * b[1]) + (b[2] * b[2] + b[3] * b[3]); }
__device__ __forceinline__ void unpack8(const u32x4 w, f32x4& a, f32x4& b) {
    a[0] = __uint_as_float(w.x << 16); a[1] = __uint_as_float(w.x & 0xffff0000u); a[2] = __uint_as_float(w.y << 16); a[3] = __uint_as_float(w.y & 0xffff0000u);
    b[0] = __uint_as_float(w.z << 16); b[1] = __uint_as_float(w.z & 0xffff0000u); b[2] = __uint_as_float(w.w << 16); b[3] = __uint_as_float(w.w & 0xffff0000u); }

__device__ __forceinline__ float row_rstd(const unsigned long long* RS, int row) {
    const unsigned long long v = RS[row];
    const float t = (float)v * (1.f / 4294967296.f);
    return __builtin_amdgcn_rsqf(t * (1.f / 1024.f) + EPS);
}
struct EpiIn {
    static constexpr bool PERM = true, AFTER_DRAIN = false;
    bf16_t *AQ, *IQ, *CQ, *CKV, *AK, *AVT, *IK, *KR, *GATES; float *IW, *SSQQ, *SSQKV; const float *CS, *bgate; const unsigned long long* RSS;
    __device__ __forceinline__ void operator()(const f32x4 (&acc)[2][2][4][2], const Unit& u, int wr, int wc, int fr, int fq) const {
        asm volatile("" : "+v"(fr), "+v"(fq));
        const int pn = u.pn; const int row0 = u.pm * BM + wr * 64 + fr; const int cw = wc * 32 + 8 * fq;
        float rsv[2][4];
#pragma unroll
        for (int ai = 0; ai < 2; ++ai)
#pragma unroll
            for (int m = 0; m < 4; ++m) rsv[ai][m] = row_rstd(RSS, row0 + ai * HALF + m * 16);
        if (pn < 4) {
            bf16_t* base; int ld; float sc;
            if (pn < 2) { base = AQ + pn * 256; ld = 512; sc = C2A; } else if (pn == 2) { base = IQ; ld = 256; sc = 1.f; } else { base = CQ; ld = 256; sc = 1.f; }
#pragma unroll
            for (int ai = 0; ai < 2; ++ai)
#pragma unroll
                for (int m = 0; m < 4; ++m) { const int row = row0 + ai * HALF + m * 16; float ss = 0.f; const float rs = rsv[ai][m] * sc;
#pragma unroll
                    for (int bj = 0; bj < 2; ++bj) { const f32x4 v0 = acc[ai][bj][m][0] * rs, v1 = acc[ai][bj][m][1] * rs;
                        *(u32x4*)(base + (size_t)row * ld + bj * HALF + cw) = pack8(v0, v1); ss += ssq8(v0, v1); }
                    if (pn == 3) { ss += __shfl_xor(ss, 16); ss += __shfl_xor(ss, 32); if (fq == 0) SSQQ[(size_t)row * 4 + wc] = ss; } }
        } else if (pn == 4) {
#pragma unroll
            for (int ai = 0; ai < 2; ++ai)
#pragma unroll
                for (int m = 0; m < 4; ++m) { const int row = row0 + ai * HALF + m * 16; const float rs = rsv[ai][m];
                    { const f32x4 v0 = acc[ai][0][m][0] * rs, v1 = acc[ai][0][m][1] * rs; *(u32x4*)(CKV + (size_t)row * 128 + cw) = pack8(v0, v1);
                      float ss = ssq8(v0, v1); ss += __shfl_xor(ss, 16); ss += __shfl_xor(ss, 32); if (fq == 0) SSQKV[(size_t)row * 4 + wc] = ss; }
                    { const f32x4 v0 = acc[ai][1][m][0] * rs, v1 = acc[ai][1][m][1] * rs; const u32x4 w = pack8(v0, v1);
                      if (wc < 2) *(u32x4*)(AK + (size_t)row * 64 + cw) = w;
                      else { bf16_t* vt = AVT + ((size_t)(row >> 11) * 64 + (cw - 64)) * SEQ + (row & (SEQ - 1));
                             vt[0 * SEQ] = (bf16_t)(w.x & 0xffffu); vt[1 * SEQ] = (bf16_t)(w.x >> 16); vt[2 * SEQ] = (bf16_t)(w.y & 0xffffu); vt[3 * SEQ] = (bf16_t)(w.y >> 16);
                             vt[4 * SEQ] = (bf16_t)(w.z & 0xffffu); vt[5 * SEQ] = (bf16_t)(w.z >> 16); vt[6 * SEQ] = (bf16_t)(w.w & 0xffffu); vt[7 * SEQ] = (bf16_t)(w.w >> 16); }
#if defined(DBG_THROTTLE)
                      asm volatile("s_waitcnt vmcnt(8)" ::: "memory");
#endif
                    } }
        } else if (pn == 5) {
#pragma unroll
            for (int ai = 0; ai < 2; ++ai)
#pragma unroll
                for (int m = 0; m < 4; ++m) { const int row = row0 + ai * HALF + m * 16; const float rs = rsv[ai][m]; const f32x4 v0 = acc[ai][0][m][0] * rs, v1 = acc[ai][0][m][1] * rs;
                    if (wc < 2) *(u32x4*)(IK + (size_t)row * 64 + cw) = pack8(v0, v1);
                    else if (wc == 2) { const f32x4 c4 = *(const f32x4*)(CS + (size_t)row * 32 + 4 * fq), s4 = *(const f32x4*)(CS + (size_t)row * 32 + 16 + 4 * fq);
                        f32x4 o0, o1; o0[0] = v0[0] * c4[0] - v0[1] * s4[0]; o0[1] = v0[0] * s4[0] + v0[1] * c4[0]; o0[2] = v0[2] * c4[1] - v0[3] * s4[1]; o0[3] = v0[2] * s4[1] + v0[3] * c4[1];
                        o1[0] = v1[0] * c4[2] - v1[1] * s4[2]; o1[1] = v1[0] * s4[2] + v1[1] * c4[2]; o1[2] = v1[2] * c4[3] - v1[3] * s4[3]; o1[3] = v1[2] * s4[3] + v1[3] * c4[3];
                        *(u32x4*)(KR + (size_t)row * 32 + 8 * fq) = pack8(o0, o1); }
                    else if (fq == 0) *(f32x4*)(IW + (size_t)row * 4) = v0; }
        } else {
            const int cg0 = (pn - 6) * 256 + cw;
            f32x4 bv[2][2];
#pragma unroll
            for (int bj = 0; bj < 2; ++bj) { bv[bj][0] = *(const f32x4*)(bgate + cg0 + bj * HALF); bv[bj][1] = *(const f32x4*)(bgate + cg0 + bj * HALF + 4); }
#pragma unroll
            for (int ai = 0; ai < 2; ++ai)
#pragma unroll
                for (int m = 0; m < 4; ++m) { const int row = row0 + ai * HALF + m * 16; const float rs = rsv[ai][m];
#pragma unroll
                    for (int bj = 0; bj < 2; ++bj) { f32x4 v0 = acc[ai][bj][m][0] * rs + bv[bj][0], v1 = acc[ai][bj][m][1] * rs + bv[bj][1];
#pragma unroll
                        for (int e = 0; e < 4; ++e) { v0[e] = __builtin_amdgcn_rcpf(1.f + __builtin_amdgcn_exp2f(-LOG2E * v0[e])); v1[e] = __builtin_amdgcn_rcpf(1.f + __builtin_amdgcn_exp2f(-LOG2E * v1[e])); }
                        *(u32x4*)(GATES + (size_t)row * 2048 + cg0 + bj * HALF) = pack8(v0, v1); } }
        }
    }
};
struct EpiUQ {
    static constexpr bool PERM = true, AFTER_DRAIN = false;
    bf16_t* QB; const float *SSQQ, *CS;
    __device__ __forceinline__ void operator()(const f32x4 (&acc)[2][2][4][2], const Unit& u, int wr, int wc, int fr, int fq) const {
        asm volatile("" : "+v"(fr), "+v"(fq));
        const int row0 = u.pm * BM + wr * 64 + fr; const int cw = wc * 32 + 8 * fq;
#pragma unroll
        for (int ai = 0; ai < 2; ++ai)
#pragma unroll
            for (int m = 0; m < 4; ++m) { const int row = row0 + ai * HALF + m * 16; const f32x4 sq = *(const f32x4*)(SSQQ + (size_t)row * 4);
                const float rs = __builtin_amdgcn_rsqf(((sq[0] + sq[1]) + (sq[2] + sq[3])) * (1.f / 256.f) + EPS) * C2B;
#pragma unroll
                for (int bj = 0; bj < 2; ++bj) { const int col0 = u.pn * BM + bj * HALF + cw; const int cm = col0 % 96;
                    f32x4 v0 = acc[ai][bj][m][0] * rs, v1 = acc[ai][bj][m][1] * rs;
                    if (cm >= 64) { const int i0 = (cm - 64) >> 1; const f32x4 c4 = *(const f32x4*)(CS + (size_t)row * 32 + i0), s4 = *(const f32x4*)(CS + (size_t)row * 32 + 16 + i0);
                        f32x4 o0, o1; o0[0] = v0[0] * c4[0] - v0[1] * s4[0]; o0[1] = v0[0] * s4[0] + v0[1] * c4[0]; o0[2] = v0[2] * c4[1] - v0[3] * s4[1]; o0[3] = v0[2] * s4[1] + v0[3] * c4[1];
                        o1[0] = v1[0] * c4[2] - v1[1] * s4[2]; o1[1] = v1[0] * s4[2] + v1[1] * c4[2]; o1[2] = v1[2] * c4[3] - v1[3] * s4[3]; o1[3] = v1[2] * s4[3] + v1[3] * c4[3];
                        v0 = o0; v1 = o1; }
                    *(u32x4*)(QB + (size_t)row * 768 + col0) = pack8(v0, v1); } }
    }
};
struct EpiUK {
    static constexpr bool PERM = true, AFTER_DRAIN = false;
    bf16_t* KN; const float* SSQKV;
    __device__ __forceinline__ void operator()(const f32x4 (&acc)[2][2][4][2], const Unit& u, int wr, int wc, int fr, int fq) const {
        asm volatile("" : "+v"(fr), "+v"(fq));
        const int row0 = u.pm * BM + wr * 64 + fr; const int cw = wc * 32 + 8 * fq;
#pragma unroll
        for (int ai = 0; ai < 2; ++ai)
#pragma unroll
            for (int m = 0; m < 4; ++m) { const int row = row0 + ai * HALF + m * 16; const f32x4 sq = *(const f32x4*)(SSQKV + (size_t)row * 4);
                const float rs = __builtin_amdgcn_rsqf(((sq[0] + sq[1]) + (sq[2] + sq[3])) * (1.f / 128.f) + EPS);
#pragma unroll
                for (int bj = 0; bj < 2; ++bj) *(u32x4*)(KN + (size_t)row * 512 + u.pn * BM + bj * HALF + cw) = pack8(acc[ai][bj][m][0] * rs, acc[ai][bj][m][1] * rs); }
    }
};
struct EpiUV {
    static constexpr bool PERM = true, AFTER_DRAIN = false;
    bf16_t* VT; const float* SSQKV;
    __device__ __forceinline__ void operator()(const f32x4 (&acc)[2][2][4][2], const Unit& u, int wr, int wc, int fr, int fq) const {
        asm volatile("" : "+v"(fr), "+v"(fq));
        const int row0 = u.pm * BM + wr * 64 + fr; const int cw = wc * 32 + 8 * fq;
        f32x4 r0[2], r1[2];
#pragma unroll
        for (int bj = 0; bj < 2; ++bj) { const int c0 = u.pn * BM + bj * HALF + cw;
#pragma unroll
            for (int e = 0; e < 8; ++e) { const f32x4 sq = *(const f32x4*)(SSQKV + (size_t)(c0 + e) * 4); const float rs = __builtin_amdgcn_rsqf(((sq[0] + sq[1]) + (sq[2] + sq[3])) * (1.f / 128.f) + EPS);
                if (e < 4) r0[bj][e] = rs; else r1[bj][e - 4] = rs; } }
#pragma unroll
        for (int ai = 0; ai < 2; ++ai)
#pragma unroll
            for (int m = 0; m < 4; ++m) { const int row = row0 + ai * HALF + m * 16;
#pragma unroll
                for (int bj = 0; bj < 2; ++bj) *(u32x4*)(VT + (size_t)row * M + u.pn * BM + bj * HALF + cw) = pack8(acc[ai][bj][m][0] * r0[bj], acc[ai][bj][m][1] * r1[bj]); }
    }
};
#ifndef DBG_BR_A
#define DBG_BR_A 1
#define DBG_BR_B 1
#endif
struct EpiBranch {
    static constexpr bool PERM = true, AFTER_DRAIN = false;
    bf16_t* MERGED; const bf16_t* GATES;
    __device__ __forceinline__ void operator()(const f32x4 (&acc)[2][2][4][2], const Unit& u, int wr, int wc, int fr, int fq) const {
        asm volatile("" : "+v"(fr), "+v"(fq));
        const int br = u.pn >> 2, pn = u.pn & 3, pm = u.pm & 127;
        const int row0 = pm * BM + wr * 64 + fr; const int cw = wc * 32 + 8 * fq;
#pragma unroll
        for (int ai = 0; ai < 2; ++ai)
#pragma unroll
            for (int m = 0; m < 4; ++m) { const int row = row0 + ai * HALF + m * 16;
#pragma unroll
                for (int bj = 0; bj < 2; ++bj) { const int col0 = pn * BM + bj * HALF + cw;
                    f32x4 g0, g1; unpack8(*(const u32x4*)(GATES + (size_t)row * 2048 + br * 1024 + col0), g0, g1);
                    const float on_ = br ? (float)(DBG_BR_B) : (float)(DBG_BR_A);
                    f32x4 v0 = acc[ai][bj][m][0] * g0 * on_, v1 = acc[ai][bj][m][1] * g1 * on_;
                    bf16_t* dst = MERGED + (size_t)row * 1024 + col0;
                    if (br) { f32x4 p0, p1; unpack8(*(const u32x4*)dst, p0, p1); v0 += p0; v1 += p1; }
                    *(u32x4*)dst = pack8(v0, v1); } }
    }
};
struct EpiRes {
    static constexpr bool PERM = false, AFTER_DRAIN = false;
    const float* base; float* out; float scale; bf16_t* XB; unsigned long long* RSS;
    __device__ __forceinline__ void operator()(const f32x4 (&acc)[2][2][4][2], const Unit& u, int wr, int wc, int fr, int fq) const {
        asm volatile("" : "+v"(fr), "+v"(fq));
        const int row0 = u.pm * BM + wr * 64 + fr; const int c0 = u.pn * BM + wc * 32 + 4 * fq;
#pragma unroll
        for (int ai = 0; ai < 2; ++ai)
#pragma unroll
            for (int m = 0; m < 4; ++m) { const int row = row0 + ai * HALF + m * 16; const size_t off = (size_t)row * DM + c0; float ss = 0.f;
#pragma unroll
                for (int bj = 0; bj < 2; ++bj)
#pragma unroll
                    for (int n = 0; n < 2; ++n) { const f32x4 bs = *(const f32x4*)(base + off + bj * HALF + n * 16); const f32x4 o = bs + acc[ai][bj][m][n] * scale;
                        *(f32x4*)(out + off + bj * HALF + n * 16) = o; ss += (o[0] * o[0] + o[1] * o[1]) + (o[2] * o[2] + o[3] * o[3]);
                        u32x2v w; w.x = cvt_pk_bf16(o[0], o[1]); w.y = cvt_pk_bf16(o[2], o[3]); *(u32x2v*)(XB + off + bj * HALF + n * 16) = w; }
                ss += __shfl_xor(ss, 16); ss += __shfl_xor(ss, 32);
                if (fq == 0) (void)__hip_atomic_fetch_add(RSS + row, (unsigned long long)(ss * 4294967296.f), __ATOMIC_RELAXED, __HIP_MEMORY_SCOPE_AGENT); }
    }
};
struct EpiFF1 {
    static constexpr bool PERM = true, AFTER_DRAIN = false;
    bf16_t* HID; const unsigned long long* RSS;
    __device__ __forceinline__ void operator()(const f32x4 (&acc)[2][2][4][2], const Unit& u, int wr, int wc, int fr, int fq) const {
        asm volatile("" : "+v"(fr), "+v"(fq));
        const int row0 = u.pm * BM + wr * 64 + fr; const int cw = wc * 32 + 8 * fq;
        float rsv[2][4];
#pragma unroll
        for (int ai = 0; ai < 2; ++ai)
#pragma unroll
            for (int m = 0; m < 4; ++m) rsv[ai][m] = row_rstd(RSS, row0 + ai * HALF + m * 16);
#pragma unroll
        for (int ai = 0; ai < 2; ++ai)
#pragma unroll
            for (int m = 0; m < 4; ++m) { const int row = row0 + ai * HALF + m * 16; const float rs = rsv[ai][m];
#pragma unroll
                for (int bj = 0; bj < 2; ++bj) { f32x4 v0 = acc[ai][bj][m][0] * rs, v1 = acc[ai][bj][m][1] * rs;
#pragma unroll
                    for (int e = 0; e < 4; ++e) { const float a = fmaxf(v0[e], 0.f), b = fmaxf(v1[e], 0.f); v0[e] = a * a; v1[e] = b * b; }
                    *(u32x4*)(HID + (size_t)row * DFF + u.pn * BM + bj * HALF + cw) = pack8(v0, v1); } }
    }
};
struct BranchOrder {
    StaticOrder so; int brsel;
    __device__ void init(int G, int c, int brsel_ = -1) { so.init(M, DM, G, c); brsel = brsel_; }
    __device__ bool next(int i, Unit& u) const { Unit b; if (brsel >= 0) { if (!so.next(i, b)) return false; u.pm = b.pm + 128 * brsel; u.pn = b.pn + 4 * brsel; return true; }
        if (!so.next(i >> 1, b)) return false; const int br = i & 1; u.pm = b.pm + 128 * br; u.pn = b.pn + 4 * br; return true; }
    __device__ __forceinline__ void a_ready(const Unit&) const {}
    __device__ __forceinline__ void done(const Unit&) const {}
};
}

__device__ __forceinline__ unsigned f2bf(float f) { unsigned u = __builtin_bit_cast(unsigned, f); return (u + 0x7fffu + ((u >> 16) & 1u)) >> 16; }
__device__ __forceinline__ unsigned pk2(float lo, float hi) { return f2bf(lo) | (f2bf(hi) << 16); }
__device__ __forceinline__ float wave_sum(float v) {
#pragma unroll
    for (int o = 1; o < 64; o <<= 1) v += __shfl_xor(v, o);
    return v;
}
template <int KIND> __device__ __forceinline__ int src_col(int n) {
    if (KIND == 1) {
        if (n < 512) return n;
        if (n < 768) return 640 + (n - 512);
        if (n < 1024) return 964 + (n - 768);
        if (n < 1152) return 1220 + (n - 1024);
        if (n < 1216) return 512 + (n - 1152);
        if (n < 1280) return 576 + (n - 1216);
        if (n < 1344) return 896 + (n - 1280);
        if (n < 1376) { const int j = n - 1344; return 1348 + 16 * (j & 1) + (j >> 1); }
        if (n < 1380) return 960 + (n - 1376);
        if (n < 1536) return -1;
        return 1380 + (n - 1536);
    } else if (KIND == 2) {
        const int h = n / 96, c = n % 96; if (c < 64) return h * 96 + c; const int j = c - 64; return h * 96 + 64 + 16 * (j & 1) + (j >> 1);
    } else if (KIND == 3) {
        return (n >> 6) * 128 + (n & 63);
    } else if (KIND == 4) {
        return (n >> 6) * 128 + 64 + (n & 63);
    }
    return n;
}
template <int KIND> __device__ __forceinline__ void prep_item(const float* W, int K, int Nsrc, bf16* WT, LAS float* scr, int item, int nblk, int lane, const float* gain) {
    const int kb = item / nblk, nb = item % nblk, k0 = 64 * kb, n0 = 32 * nb;
    const int sc = src_col<KIND>(n0 + (lane & 31));
#pragma unroll 8
    for (int i = 0; i < 32; ++i) { const int kk = 2 * i + (lane >> 5); float v = (sc >= 0) ? W[(size_t)(k0 + kk) * Nsrc + sc] : 0.f; if (gain) v *= gain[k0 + kk]; scr[kk * 33 + (lane & 31)] = v; }
    LDS_WAIT(); asm volatile("" ::: "memory");
    const int c = lane & 7;
#pragma unroll
    for (int j = 0; j < 4; ++j) { const int n = (lane >> 3) + 8 * j; const LAS float* s = scr + (8 * c) * 33 + n;
        u32x4 o; o.x = pk2(s[0 * 33], s[1 * 33]); o.y = pk2(s[2 * 33], s[3 * 33]); o.z = pk2(s[4 * 33], s[5 * 33]); o.w = pk2(s[6 * 33], s[7 * 33]);
        *(GAS u32x4*)(WT + (size_t)(n0 + n) * K + k0 + 8 * c) = o; }
    LDS_WAIT(); asm volatile("" ::: "memory");
}
template <int GROUP> __device__ __forceinline__ void prep_weights(Frame& F, int l, int lds_off, const float* g1, const float* g2, const float* w_in, const float* gq, const float* gkv, const float* w_uq, const float* w_ukv,
                                                                  const float* w_a, const float* w_b, const float* w_out, const float* w_ff1, const float* w_ff2) {
    LAS float* scr = (LAS float*)(F.lds + lds_off + F.wave * 8704);
    bf16* WB = (bf16*)(F.ws + WS_W);
    const int gw = F.bx * NWAVES + F.wave, NGW = F.G * NWAVES;
    constexpr int I_IN = 16 * (NIN / 32), I_UQ = 4 * 24, I_UK = 2 * 16, I_UV = 2 * 16, I_A = 8 * 32, I_B = 8 * 32, I_O = 16 * 32, I_1 = 16 * 128, I_2 = 64 * 32;
    if (GROUP == 0) {
        for (int it = gw; it < I_IN + I_UQ + I_UK + I_UV; it += NGW) {
            int r = it;
            if (r < I_IN) { prep_item<1>(w_in + (size_t)l * DM * DIN, DM, DIN, WB + W_IN_OFF, scr, r, NIN / 32, F.lane, g1 + l * DM); continue; } r -= I_IN;
            if (r < I_UQ) { prep_item<2>(w_uq + (size_t)l * 256 * 768, 256, 768, WB + W_UQ_OFF, scr, r, 24, F.lane, gq + l * 256); continue; } r -= I_UQ;
            if (r < I_UK) { prep_item<3>(w_ukv + (size_t)l * 128 * 1024, 128, 1024, WB + W_UK_OFF, scr, r, 16, F.lane, gkv + l * 128); continue; } r -= I_UK;
            prep_item<4>(w_ukv + (size_t)l * 128 * 1024, 128, 1024, WB + W_UV_OFF, scr, r, 16, F.lane, gkv + l * 128);
        }
    } else {
        for (int it = gw; it < I_A + I_B + I_O + I_1 + I_2; it += NGW) {
            int r = it;
            if (r < I_A) { prep_item<0>(w_a + (size_t)l * 512 * 1024, 512, 1024, WB + W_AB_OFF, scr, r, 32, F.lane, nullptr); continue; } r -= I_A;
            if (r < I_B) { prep_item<0>(w_b + (size_t)l * 512 * 1024, 512, 1024, WB + W_AB_OFF + 1024 * 512, scr, r, 32, F.lane, nullptr); continue; } r -= I_B;
            if (r < I_O) { prep_item<0>(w_out + (size_t)l * 1024 * 1024, 1024, 1024, WB + W_OUT_OFF, scr, r, 32, F.lane, nullptr); continue; } r -= I_O;
            if (r < I_1) { prep_item<0>(w_ff1 + (size_t)l * 1024 * 4096, 1024, 4096, WB + W_FF1_OFF, scr, r, 128, F.lane, g2 + l * DM); continue; } r -= I_1;
            prep_item<0>(w_ff2 + (size_t)l * 4096 * 1024, 4096, 1024, WB + W_FF2_OFF, scr, r, 32, F.lane, nullptr);
        }
    }
}
__device__ __forceinline__ void init_rows(Frame& F) {
    bf16* XB = (bf16*)(F.ws + WS_H); unsigned long long* RSB = (unsigned long long*)(F.ws + WS_RSS) + M;
    const int gw = F.bx * NWAVES + F.wave, NGW = F.G * NWAVES;
    for (int m = gw; m < M; m += NGW) {
        const GAS f32x4* xr = (const GAS f32x4*)(F.x + (size_t)m * DM) + F.lane;
        f32x4 v[4]; float s = 0.f;
#pragma unroll
        for (int j = 0; j < 4; ++j) { v[j] = xr[64 * j]; s += (v[j].x * v[j].x + v[j].y * v[j].y) + (v[j].z * v[j].z + v[j].w * v[j].w); }
        s = wave_sum(s);
        GAS unsigned long long* o8 = (GAS unsigned long long*)(XB + (size_t)m * DM) + F.lane;
#pragma unroll
        for (int j = 0; j < 4; ++j) o8[64 * j] = (unsigned long long)pk2(v[j].x, v[j].y) | ((unsigned long long)pk2(v[j].z, v[j].w) << 32);
        if (F.lane == 0) RSB[m] = (unsigned long long)(s * 4294967296.f);
    }
}
__device__ __forceinline__ void rope_table(Frame& F) {
    float* CS = (float*)(F.ws + WS_CS);
    for (int e = F.bx * (NWAVES * 64) + F.tid; e < M * 16; e += F.G * NWAVES * 64) { const int m = e >> 4, i = e & 15;
        const float invf = powf(10000.f, -(float)(2 * i) * (1.f / 32.f)); const float ang = (float)F.pos[m] * invf;
        float s, c; sincosf(ang, &s, &c); CS[(size_t)m * 32 + i] = c; CS[(size_t)m * 32 + 16 + i] = s; }
}
__device__ __forceinline__ void pos_tables(Frame& F) {
    int* KMAX = (int*)(F.ws + WS_PTAB); int* QMIN = KMAX + NB * 32;
    for (int e = F.bx * (NWAVES * 64) + F.tid; e < NB * 32 + NB * 64; e += F.G * NWAVES * 64) {
        if (e < NB * 32) { const int* p = F.pos + (size_t)(e >> 5) * SEQ + (e & 31) * 64; int m = p[0]; for (int i = 1; i < 64; ++i) m = max(m, p[i]); KMAX[e] = m; }
        else { const int q = e - NB * 32; const int* p = F.pos + (size_t)(q >> 6) * SEQ + (q & 63) * 32; int m = p[0]; for (int i = 1; i < 32; ++i) m = min(m, p[i]); QMIN[q] = m; }
    }
}
template <bool OUT_F32> __device__ __forceinline__ void norm_rows(Frame& F, const float* src, const float* g, bf16* dstb, float* dstf, float oscale = 1.f) {
    const int gw = F.bx * NWAVES + F.wave, NGW = F.G * NWAVES;
    f32x4 gv[4];
#pragma unroll
    for (int j = 0; j < 4; ++j) gv[j] = *((const f32x4*)g + F.lane + 64 * j);
    for (int m = gw; m < M; m += NGW) {
        const GAS f32x4* xr = (const GAS f32x4*)(src + (size_t)m * DM) + F.lane;
        f32x4 v[4]; float s = 0.f;
#pragma unroll
        for (int j = 0; j < 4; ++j) { v[j] = xr[64 * j]; s += (v[j].x * v[j].x + v[j].y * v[j].y) + (v[j].z * v[j].z + v[j].w * v[j].w); }
        const float rstd = oscale / sqrtf(wave_sum(s) * (1.f / DM) + EPS);
        if (OUT_F32) { GAS f32x4* o = (GAS f32x4*)(dstf + (size_t)m * DM) + F.lane;
#pragma unroll
            for (int j = 0; j < 4; ++j) o[64 * j] = v[j] * rstd * gv[j];
        } else { GAS unsigned long long* o8 = (GAS unsigned long long*)(dstb + (size_t)m * DM) + F.lane;
#pragma unroll
            for (int j = 0; j < 4; ++j) { const f32x4 y = v[j] * rstd * gv[j]; o8[64 * j] = (unsigned long long)pk2(y.x, y.y) | ((unsigned long long)pk2(y.z, y.w) << 32); } }
    }
}

constexpr int SC_PITCH = SEQ + 4;
constexpr int IDX_MB_OFF = 16 * SC_PITCH * 4;
static_assert(IDX_MB_OFF + 16 * 32 * 8 <= MISC_OFF, "indexer LDS");
__device__ __forceinline__ unsigned fkey(float f) { unsigned u = __float_as_uint(f); if ((u << 1) == 0u) u = 0u; return (u & 0x80000000u) ? ~u : (u | 0x80000000u); }
__device__ __forceinline__ unsigned wave_sum_u32(unsigned v) {
    v += (unsigned)__builtin_amdgcn_update_dpp(0, (int)v, 0x111, 0xf, 0xf, true);
    v += (unsigned)__builtin_amdgcn_update_dpp(0, (int)v, 0x112, 0xf, 0xf, true);
    v += (unsigned)__builtin_amdgcn_update_dpp(0, (int)v, 0x114, 0xf, 0xf, true);
    v += (unsigned)__builtin_amdgcn_update_dpp(0, (int)v, 0x118, 0xf, 0xf, true);
    v += (unsigned)__builtin_amdgcn_update_dpp(0, (int)v, 0x142, 0xa, 0xf, false);
    v += (unsigned)__builtin_amdgcn_update_dpp(0, (int)v, 0x143, 0xc, 0xf, false);
    return (unsigned)__builtin_amdgcn_readlane((int)v, 63);
}
template <int S> __device__ __forceinline__ void tr32_stage(unsigned (&a)[32]) {
    constexpr unsigned m = (S == 16) ? 0x0000FFFFu : (S == 8) ? 0x00FF00FFu : (S == 4) ? 0x0F0F0F0Fu : (S == 2) ? 0x33333333u : 0x55555555u;
#pragma unroll
    for (int k = 0; k < 32; ++k) if (!(k & S)) { const unsigned lo = a[k], hi = a[k + S]; a[k] = (lo & m) | ((hi << S) & ~m); a[k + S] = ((lo >> S) & m) | (hi & ~m); }
}
__device__ __forceinline__ void tr32(unsigned (&a)[32]) { tr32_stage<16>(a); tr32_stage<8>(a); tr32_stage<4>(a); tr32_stage<2>(a); tr32_stage<1>(a); }
__device__ __forceinline__ void emit_words(unsigned G, unsigned C, int cnt, int rem, unsigned long long& myword, int lane) {
    if (cnt <= rem) { const unsigned Fw = G | C;
#pragma unroll
        for (int j = 0; j < 32; ++j) { const unsigned long long mk = __ballot((Fw >> j) & 1u); if (lane == j) myword = mk; }
    } else {
        int need = rem;
#pragma unroll
        for (int j = 0; j < 32; ++j) { const unsigned long long gt = __ballot((G >> j) & 1u), eq = __ballot((C >> j) & 1u); const int c = __popcll(eq); unsigned long long take;
            if (c <= need) { take = eq; need -= c; }
            else { const int below = __builtin_amdgcn_mbcnt_hi((unsigned)(eq >> 32), __builtin_amdgcn_mbcnt_lo((unsigned)eq, 0u)); take = __ballot(((C >> j) & 1u) && (below < need)); need = 0; }
            if (lane == j) myword = gt | take; }
    }
}
__device__ __forceinline__ void select_bits(unsigned (&ka)[32], unsigned long long& worda, int lane) {
    unsigned Ca = 0u;
#pragma unroll
    for (int j = 0; j < 32; ++j) Ca |= (ka[j] != 0u) ? (1u << j) : 0u;
    tr32(ka);
    unsigned Ga = 0u;
    int ra = TOPK;
    int ca = (int)wave_sum_u32((unsigned)__popc(Ca));
    bool da = (ca <= ra);
#pragma unroll
    for (int b = 31; b >= 0; --b) {
        if (da) break;
        const unsigned pa = ka[b];
        const unsigned oa = Ca & pa;
        const int na = (int)wave_sum_u32((unsigned)__popc(oa));
        const bool up = (na >= ra);
        Ca = up ? oa : (Ca & ~pa); Ga = up ? Ga : (Ga | oa); ca = up ? na : ca - na; ra = up ? ra : ra - na; da = (ca == ra);
    }
    emit_words(Ga, Ca, ca, ra, worda, lane);
}
__device__ __forceinline__ void idx_phase(Frame& F) {
    const bf16* IQ = (const bf16*)(F.ws + WS_IQ); const bf16* IK = (const bf16*)(F.ws + WS_IK); const float* IW = (const float*)(F.ws + WS_IW);
    unsigned long long* MASK = (unsigned long long*)(F.ws + WS_MASK);
    LAS float* sc = (LAS float*)F.lds; LAS unsigned long long* mb = (LAS unsigned long long*)(F.lds + IDX_MB_OFF);
    const int lane = F.lane, n = lane & 15, kg = lane >> 4, w = F.wave;
    for (int uidx = F.bx; uidx < NB * 128; uidx += F.G) {
        const int c = uidx & 255, i = uidx >> 8, b = c >> 4, s = c & 15;
        const int jb = (i >> 1) * 32 + ((i & 1) ? 31 - s : s);
        const int q0 = jb * 16, ntile = jb + 1; const size_t rowb = (size_t)b * SEQ;
        bf16x8 qf[4][2];
#pragma unroll
        for (int h = 0; h < 4; ++h)
#pragma unroll
            for (int ks = 0; ks < 2; ++ks) qf[h][ks] = *(const bf16x8*)(IQ + (rowb + q0 + n) * 256 + h * 64 + ks * 32 + kg * 8);
        const f32x4 w4 = *(const f32x4*)(IW + (rowb + q0 + n) * 4);
#ifndef IDX_REP_SCORE
#define IDX_REP_SCORE 1
#define IDX_REP_SELECT 1
#endif
        for (int rep_ = 0; rep_ < IDX_REP_SCORE; ++rep_)
        for (int t0 = w; t0 < ntile; t0 += 8 * NWAVES) {
            bf16x8 kf[8][2];
#pragma unroll
            for (int u = 0; u < 8; ++u) { const int tt = t0 + u * NWAVES; if (tt < ntile) { const bf16* kp = IK + (rowb + tt * 16 + n) * 64 + kg * 8; kf[u][0] = *(const bf16x8*)kp; kf[u][1] = *(const bf16x8*)(kp + 32); } }
#pragma unroll
            for (int u = 0; u < 8; ++u) { const int tt = t0 + u * NWAVES;
                if (tt < ntile) { f32x4 s4 = (f32x4){0.f, 0.f, 0.f, 0.f};
#pragma unroll
                    for (int h = 0; h < 4; ++h) { f32x4 a = (f32x4){0.f, 0.f, 0.f, 0.f};
                        a = __builtin_amdgcn_mfma_f32_16x16x32_bf16(kf[u][0], qf[h][0], a, 0, 0, 0); a = __builtin_amdgcn_mfma_f32_16x16x32_bf16(kf[u][1], qf[h][1], a, 0, 0, 0);
#pragma unroll
                        for (int e = 0; e < 4; ++e) s4[e] += w4[h] * fmaxf(a[e], 0.f); }
                    *(LAS f32x4*)(sc + n * SC_PITCH + tt * 16 + 4 * kg) = s4; } }
        }
        __syncthreads();
        for (int rep_ = 0; rep_ < IDX_REP_SELECT; ++rep_)
#pragma unroll 1
        for (int rr = 0; rr < 2; ++rr) {
            const int r = 2 * w + rr, t = q0 + r;
            unsigned ka[32];
#pragma unroll
            for (int j = 0; j < 32; ++j) { const int sidx = j * 64 + lane; const float va = sc[r * SC_PITCH + sidx]; ka[j] = (sidx <= t) ? fkey(va) : 0u; }
            unsigned long long worda = 0ull;
            if (t + 1 <= TOPK) {
#pragma unroll
                for (int j = 0; j < 32; ++j) { const unsigned long long ma = __ballot(ka[j] != 0u); if (lane == j) worda = ma; }
            } else select_bits(ka, worda, lane);
            if (lane < 32) mb[r * 32 + lane] = worda;
        }
        __syncthreads();
        { const int j = F.tid >> 4, q = F.tid & 15; MASK[((size_t)b * 32 + j) * SEQ + q0 + q] = mb[q * 32 + j]; }
        __syncthreads();
    }
}

constexpr int KP_A = 144, KP_B = 208, VP = 136;
constexpr int KBUF_SZ = 64 * KP_B, VBUF_SZ = 64 * VP, KBUF = 0, VBUF = 2 * KBUF_SZ, LUT_OFF = VBUF + 2 * VBUF_SZ;
constexpr float ATT_THR = 8.f;
struct AttnSt { f32x16 o[2]; f32x16 cinit; float lrun; };
__device__ __forceinline__ void attn_reference(AttnSt& st, f32x16& s0, f32x16& s1, bool first) {
    float mx = fmaxf(s0[0], s1[0]);
#pragma unroll
    for (int r = 1; r < 16; ++r) mx = fmaxf(mx, fmaxf(s0[r], s1[r]));
    mx = fmaxf(mx, __shfl_xor(mx, 32));
    if (first || __any(mx > ATT_THR)) {
        const float dl = first ? mx : fmaxf(mx, 0.f);
#pragma unroll
        for (int r = 0; r < 16; ++r) { s0[r] -= dl; s1[r] -= dl; st.cinit[r] -= dl; }
        if (!first) { const float a = __builtin_amdgcn_exp2f(-dl); st.lrun *= a;
#pragma unroll
            for (int r = 0; r < 16; ++r) { st.o[0][r] *= a; st.o[1][r] *= a; } }
    }
}
__device__ __forceinline__ void attn_exp(f32x16& s0, f32x16& s1) {
#pragma unroll
    for (int r = 0; r < 16; ++r) { s0[r] = __builtin_amdgcn_exp2f(s0[r]); s1[r] = __builtin_amdgcn_exp2f(s1[r]); }
}
__device__ __forceinline__ void attn_pv(AttnSt& st, const f32x16& s0, const f32x16& s1, const LAS char* vt, int r32, int hi) {
    float ps = 0.f;
#pragma unroll
    for (int r = 0; r < 16; ++r) ps += s0[r] + s1[r];
    st.lrun += ps;
    bf16x8 pf[4];
#pragma unroll
    for (int ks = 0; ks < 4; ++ks) { u32x4 w;
        if (ks < 2) { const int b = 8 * ks; w.x = pg8::cvt_pk_bf16(s0[b], s0[b + 1]); w.y = pg8::cvt_pk_bf16(s0[b + 2], s0[b + 3]); w.z = pg8::cvt_pk_bf16(s0[b + 4], s0[b + 5]); w.w = pg8::cvt_pk_bf16(s0[b + 6], s0[b + 7]); }
        else { const int b = 8 * (ks - 2); w.x = pg8::cvt_pk_bf16(s1[b], s1[b + 1]); w.y = pg8::cvt_pk_bf16(s1[b + 2], s1[b + 3]); w.z = pg8::cvt_pk_bf16(s1[b + 4], s1[b + 5]); w.w = pg8::cvt_pk_bf16(s1[b + 6], s1[b + 7]); }
        pf[ks] = __builtin_bit_cast(bf16x8, w); }
#pragma unroll
    for (int d0 = 0; d0 < 2; ++d0)
#pragma unroll
        for (int ks = 0; ks < 4; ++ks) { const LAS char* p = vt + (32 * d0 + r32) * VP + 32 * ks + 8 * hi;
            const u32x2 lo = *(const LAS u32x2*)p, hh = *(const LAS u32x2*)(p + 16);
            const u32x4 vw = (u32x4){lo.x, lo.y, hh.x, hh.y};
            st.o[d0] = __builtin_amdgcn_mfma_f32_32x32x16_bf16(__builtin_bit_cast(bf16x8, vw), pf[ks], st.o[d0], 0, 0, 0); }
}
__device__ __forceinline__ void store_o(bf16* op, const f32x16 (&o)[2], float inv) {
#pragma unroll
    for (int d0 = 0; d0 < 2; ++d0)
#pragma unroll
        for (int g = 0; g < 4; ++g) { u32x2 w; w.x = pg8::cvt_pk_bf16(o[d0][4 * g] * inv, o[d0][4 * g + 1] * inv); w.y = pg8::cvt_pk_bf16(o[d0][4 * g + 2] * inv, o[d0][4 * g + 3] * inv);
            *(u32x2*)(op + 32 * d0 + 8 * g) = w; }
}
__device__ __forceinline__ void dsa_unit(Frame& F, int b, int jq) {
    const int lane = F.lane, r32 = lane & 31, hi = lane >> 5, w = F.wave, tid = F.tid;
    LAS char* lds = (LAS char*)F.lds;
    bf16* AQ = (bf16*)(F.ws + WS_YA); const bf16* AK = (const bf16*)(F.ws + WS_AK); const bf16* AVT = (const bf16*)(F.ws + WS_AVT);
    const unsigned long long* MASK = (const unsigned long long*)(F.ws + WS_MASK);
    const size_t rowb = (size_t)b * SEQ; const int q0 = jq * 32;
    bf16x8 qf[4];
    { const bf16* qp = AQ + (rowb + q0 + r32) * 512 + w * 64 + hi * 8;
#pragma unroll
      for (int d0 = 0; d0 < 4; ++d0) qf[d0] = *(const bf16x8*)(qp + d0 * 16); }
    const int posq = F.pos[rowb + q0 + r32];
    const int* KMAX = (const int*)(F.ws + WS_PTAB);
    const int qmin = __builtin_amdgcn_readfirstlane(KMAX[NB * 32 + b * 64 + jq]);
    const int NT = (jq + 2) >> 1;
    const LAS float* lut = (const LAS float*)(lds + LUT_OFF) + w * 129;
    AttnSt st; st.lrun = 0.f;
#pragma unroll
    for (int r = 0; r < 16; ++r) { st.o[0][r] = 0.f; st.o[1][r] = 0.f; st.cinit[r] = 0.f; }
    const int srow = tid >> 3, sch = tid & 7;
    const bf16* kgp = AK + (rowb + srow) * 64 + sch * 8;
    const bf16* vgp = AVT + ((size_t)b * 64 + srow) * SEQ + sch * 8;
    const unsigned long long* mwp = MASK + (size_t)b * 32 * SEQ + q0 + r32;
    const int kmaxv = KMAX[b * 32 + (lane & 31)];
    u32x4 kA = *(const u32x4*)kgp, vA = *(const u32x4*)vgp, kB = kA, vB = vA; unsigned long long mA = mwp[0], mB = mA;
    if (NT > 1) { kB = *(const u32x4*)(kgp + (size_t)64 * 64); vB = *(const u32x4*)(vgp + 64); mB = mwp[SEQ]; }
#define DSA_TILE(t_, KR_, VR_, MR_) do { const int tt_ = (t_); \
        LAS char* kb = lds + KBUF + (tt_ & 1) * KBUF_SZ; LAS char* vb = lds + VBUF + (tt_ & 1) * VBUF_SZ; \
        *(LAS u32x4*)(kb + srow * KP_A + sch * 16) = KR_; \
        *(LAS u32x2*)(vb + srow * VP + sch * 16) = (u32x2){VR_.x, VR_.y}; *(LAS u32x2*)(vb + srow * VP + sch * 16 + 8) = (u32x2){VR_.z, VR_.w}; \
        const unsigned long long mw = MR_; \
        __syncthreads(); \
        if (tt_ + 2 < NT) { KR_ = *(const u32x4*)(kgp + (size_t)(tt_ + 2) * 64 * 64); VR_ = *(const u32x4*)(vgp + (tt_ + 2) * 64); MR_ = mwp[(size_t)(tt_ + 2) * SEQ]; } \
        const bool far = (qmin - __builtin_amdgcn_readlane(kmaxv, tt_) >= 128); \
        f32x16 s0, s1; \
        _Pragma("unroll") for (int d0 = 0; d0 < 4; ++d0) { const bf16x8 k0 = *(const LAS bf16x8*)(kb + r32 * KP_A + d0 * 32 + hi * 16), k1 = *(const LAS bf16x8*)(kb + (32 + r32) * KP_A + d0 * 32 + hi * 16); \
            if (d0 == 0) { s0 = __builtin_amdgcn_mfma_f32_32x32x16_bf16(k0, qf[0], st.cinit, 0, 0, 0); s1 = __builtin_amdgcn_mfma_f32_32x32x16_bf16(k1, qf[0], st.cinit, 0, 0, 0); } \
            else { s0 = __builtin_amdgcn_mfma_f32_32x32x16_bf16(k0, qf[d0], s0, 0, 0, 0); s1 = __builtin_amdgcn_mfma_f32_32x32x16_bf16(k1, qf[d0], s1, 0, 0, 0); } } \
        if (!far) { const int* pk = F.pos + rowb + tt_ * 64 + 4 * hi; float bv0[16], bv1[16]; \
            _Pragma("unroll") for (int g = 0; g < 4; ++g) { const i32x4 p0 = *(const i32x4*)(pk + 8 * g), p1 = *(const i32x4*)(pk + 32 + 8 * g); \
                _Pragma("unroll") for (int e = 0; e < 4; ++e) { bv0[4 * g + e] = lut[min(max(posq - p0[e], 0), 128)]; bv1[4 * g + e] = lut[min(max(posq - p1[e], 0), 128)]; } } \
            _Pragma("unroll") for (int r = 0; r < 16; ++r) { s0[r] += bv0[r]; s1[r] += bv1[r]; } } \
        attn_reference(st, s0, s1, tt_ == 0); \
        attn_exp(s0, s1); \
        { const unsigned wl = (unsigned)mw >> (4 * hi), wh = (unsigned)(mw >> 32) >> (4 * hi); \
          _Pragma("unroll") for (int r = 0; r < 16; ++r) { const int c = (r & 3) + 8 * (r >> 2); \
              s0[r] = __uint_as_float(__float_as_uint(s0[r]) & (unsigned)((int)(wl << (31 - c)) >> 31)); s1[r] = __uint_as_float(__float_as_uint(s1[r]) & (unsigned)((int)(wh << (31 - c)) >> 31)); } } \
        attn_pv(st, s0, s1, vb, r32, hi); } while (0)
    for (int t = 0; t < NT; t += 2) {
        DSA_TILE(t, kA, vA, mA);
        if (t + 1 < NT) DSA_TILE(t + 1, kB, vB, mB);
    }
#undef DSA_TILE
    st.lrun += __shfl_xor(st.lrun, 32);
    store_o(AQ + (rowb + q0 + r32) * 512 + w * 64 + 4 * hi, st.o, 1.f / st.lrun);
    __syncthreads();
}
__device__ __forceinline__ void mla_unit(Frame& F, int b, int h, int qb) {
    const int lane = F.lane, r32 = lane & 31, hi = lane >> 5, w = F.wave, tid = F.tid;
    LAS char* lds = (LAS char*)F.lds;
    const bf16* QB = (const bf16*)(F.ws + WS_QB); const bf16* KN = (const bf16*)(F.ws + WS_KN); const bf16* KR = (const bf16*)(F.ws + WS_KR); const bf16* VT = (const bf16*)(F.ws + WS_VT);
    bf16* YB = (bf16*)(F.ws + WS_YB);
    const size_t rowb = (size_t)b * SEQ; const int q0w = qb * 256 + w * 32;
    bf16x8 qf[6];
    { const bf16* qp = QB + (rowb + q0w + r32) * 768 + h * 96 + hi * 8;
#pragma unroll
      for (int d0 = 0; d0 < 6; ++d0) qf[d0] = *(const bf16x8*)(qp + d0 * 16); }
    const int NT = 4 * (qb + 1);
    AttnSt st; st.lrun = 0.f;
#pragma unroll
    for (int r = 0; r < 16; ++r) { st.o[0][r] = 0.f; st.o[1][r] = 0.f; st.cinit[r] = 0.f; }
    const int srow = tid >> 3, sch = tid & 7, rrow = (tid >> 2) & 63, rch = tid & 3;
    const bf16* kgp = KN + (rowb + srow) * 512 + h * 64 + sch * 8;
    const bf16* rgp = KR + (rowb + rrow) * 32 + rch * 8;
    const bf16* vgp = VT + (size_t)(h * 64 + srow) * M + rowb + sch * 8;
    u32x4 kA = *(const u32x4*)kgp, vA = *(const u32x4*)vgp, rA = (u32x4){0u, 0u, 0u, 0u};
    if (tid < 256) rA = *(const u32x4*)rgp;
    u32x4 kB = *(const u32x4*)(kgp + (size_t)64 * 512), vB = *(const u32x4*)(vgp + 64), rB = (u32x4){0u, 0u, 0u, 0u};
    if (tid < 256) rB = *(const u32x4*)(rgp + (size_t)64 * 32);
#define MLA_TILE(t_, KR_, VR_, RR_) do { const int tt_ = (t_); \
        LAS char* kb = lds + KBUF + (tt_ & 1) * KBUF_SZ; LAS char* vb = lds + VBUF + (tt_ & 1) * VBUF_SZ; \
        *(LAS u32x4*)(kb + srow * KP_B + sch * 16) = KR_; \
        if (tid < 256) *(LAS u32x4*)(kb + rrow * KP_B + 128 + rch * 16) = RR_; \
        *(LAS u32x2*)(vb + srow * VP + sch * 16) = (u32x2){VR_.x, VR_.y}; *(LAS u32x2*)(vb + srow * VP + sch * 16 + 8) = (u32x2){VR_.z, VR_.w}; \
        __syncthreads(); \
        if (tt_ + 2 < NT) { KR_ = *(const u32x4*)(kgp + (size_t)(tt_ + 2) * 64 * 512); VR_ = *(const u32x4*)(vgp + (tt_ + 2) * 64); if (tid < 256) RR_ = *(const u32x4*)(rgp + (size_t)(tt_ + 2) * 64 * 32); } \
        if (tt_ * 64 <= q0w + 31) { \
            f32x16 s0, s1; \
            _Pragma("unroll") for (int d0 = 0; d0 < 6; ++d0) { const bf16x8 k0 = *(const LAS bf16x8*)(kb + r32 * KP_B + d0 * 32 + hi * 16), k1 = *(const LAS bf16x8*)(kb + (32 + r32) * KP_B + d0 * 32 + hi * 16); \
                if (d0 == 0) { s0 = __builtin_amdgcn_mfma_f32_32x32x16_bf16(k0, qf[0], st.cinit, 0, 0, 0); s1 = __builtin_amdgcn_mfma_f32_32x32x16_bf16(k1, qf[0], st.cinit, 0, 0, 0); } \
                else { s0 = __builtin_amdgcn_mfma_f32_32x32x16_bf16(k0, qf[d0], s0, 0, 0, 0); s1 = __builtin_amdgcn_mfma_f32_32x32x16_bf16(k1, qf[d0], s1, 0, 0, 0); } } \
            attn_reference(st, s0, s1, tt_ == 0); \
            attn_exp(s0, s1); \
            if (tt_ * 64 + 63 > q0w) { const int qi = q0w + r32, kv0 = tt_ * 64 + 4 * hi; \
                _Pragma("unroll") for (int r = 0; r < 16; ++r) { const int kv = kv0 + (r & 3) + 8 * (r >> 2); if (kv > qi) s0[r] = 0.f; if (kv + 32 > qi) s1[r] = 0.f; } } \
            attn_pv(st, s0, s1, vb, r32, hi); } } while (0)
    for (int t = 0; t < NT; t += 2) {
        MLA_TILE(t, kA, vA, rA);
        MLA_TILE(t + 1, kB, vB, rB);
    }
#undef MLA_TILE
    st.lrun += __shfl_xor(st.lrun, 32);
    store_o(YB + (rowb + q0w + r32) * 512 + h * 64 + 4 * hi, st.o, 1.f / st.lrun);
    __syncthreads();
}
__device__ __forceinline__ void attn_phase(Frame& F) {
    { LAS float* lut = (LAS float*)(F.lds + LUT_OFF);
      for (int e = F.tid; e < 8 * 129; e += NWAVES * 64) { const int h = e / 129, n = e % 129; int bk;
          if (n < 16) bk = n; else { const float z = logf((float)n * (1.f / 16.f)) / 2.0794415416798357f * 16.f; bk = 16 + (int)z; if (bk > 31) bk = 31; }
          lut[e] = (F.rel_bias[bk * 8 + h] - F.rel_bias[31 * 8 + h]) * LOG2E; }
      __syncthreads(); }
#ifndef ATT_DSA_ON
#define ATT_DSA_ON 1
#endif
#ifndef ATT_MLA_ON
#define ATT_MLA_ON 1
#endif
    if (ATT_DSA_ON)
    for (int uidx = F.bx; uidx < NB * 64; uidx += F.G) {
        const int c = uidx & 255, i = uidx >> 8, b = c >> 4, s = c & 15;
        const int jq = (i >> 1) * 32 + ((i & 1) ? 31 - s : s);
        dsa_unit(F, b, jq);
    }
    if (ATT_MLA_ON)
    for (int uidx = F.bx; uidx < NB * 8 * 8; uidx += F.G) {
        const int c = uidx & 255, i = uidx >> 8, bh = c >> 1, sub = c & 1;
        const int qb = sub ? ((i == 0) ? 1 : (i == 1) ? 6 : (i == 2) ? 2 : 5) : ((i == 0) ? 0 : (i == 1) ? 7 : (i == 2) ? 3 : 4);
        mla_unit(F, bh >> 3, bh & 7, qb);
    }
}
#if defined(DBG_CHECK)
#ifndef DBG_PROBE_OFF
#define DBG_PROBE_OFF 100
#define DBG_PROBE_PH 2
#endif
#ifndef DBG_FILL_LO
#define DBG_FILL_LO (1 * MiB)
#define DBG_FILL_HI (468 * MiB)
#endif
constexpr size_t WS_DBG_AQ_UNUSED = 0;
constexpr int DBG_W_DSA = 16, DBG_W_MASK = 17, DBG_W_MLA = 18, DBG_W_DIR = 19, DBG_W_QB = 20, DBG_W_KV = 21;
__device__ __forceinline__ float bf2f(bf16 v) { return __uint_as_float((unsigned)v << 16); }
__device__ __forceinline__ int dbg_bucket(int n) { if (n < 0) n = 0; if (n < 16) return n; const double z = log((double)n / 16.0) / log(8.0) * 16.0; int b = 16 + (int)z; return b > 31 ? 31 : b; }
__device__ __forceinline__ float dbg_block_max(LAS float* red, float v, int tid) {
    for (int o = 1; o < 64; o <<= 1) v = fmaxf(v, __shfl_xor(v, o));
    __syncthreads(); if ((tid & 63) == 0) red[tid >> 6] = v; __syncthreads();
    float r = red[0]; for (int i = 1; i < NWAVES; ++i) r = fmaxf(r, red[i]); __syncthreads(); return r;
}
__device__ __forceinline__ float dbg_block_sum(LAS float* red, float v, int tid) {
    for (int o = 1; o < 64; o <<= 1) v += __shfl_xor(v, o);
    __syncthreads(); if ((tid & 63) == 0) red[tid >> 6] = v; __syncthreads();
    float r = 0.f; for (int i = 0; i < NWAVES; ++i) r += red[i]; __syncthreads(); return r;
}
__device__ __forceinline__ int dbg_sample_t(int k) { return (k == 0) ? 0 : (k == 1) ? 255 : (k == 2) ? 256 : (k == 3) ? 257 : (k == 4) ? 2047 : (k == 5) ? 300 : 100 + 173 * k; }
__device__ __forceinline__ void dbg_copy_aq(unsigned char* ws, float* outbuf, int bx, int G, int tid) {
    const u32x4* src = (const u32x4*)(ws + WS_YA); u32x4* dst = (u32x4*)outbuf;
    for (size_t i = (size_t)bx * 512 + tid; i < (size_t)M * 512 * 2 / 16; i += (size_t)G * 512) dst[i] = src[i];
}
__device__ __forceinline__ void dbg_check_attn(unsigned char* ws, const float* outbuf, const int* pos, const float* rel_bias, LAS unsigned char* lds, int bx, int G, int tid) {
    unsigned* ctl = (unsigned*)(ws + WS_CTL);
    const bf16* AQc = (const bf16*)outbuf; const bf16* YA = (const bf16*)(ws + WS_YA); const bf16* YB = (const bf16*)(ws + WS_YB);
    const bf16* AK = (const bf16*)(ws + WS_AK); const bf16* AVT = (const bf16*)(ws + WS_AVT); const bf16* IQ = (const bf16*)(ws + WS_IQ); const bf16* IK = (const bf16*)(ws + WS_IK);
    const float* IW = (const float*)(ws + WS_IW); const unsigned long long* MASK = (const unsigned long long*)(ws + WS_MASK);
    const bf16* QB = (const bf16*)(ws + WS_QB); const bf16* KN = (const bf16*)(ws + WS_KN); const bf16* KR = (const bf16*)(ws + WS_KR); const bf16* VT = (const bf16*)(ws + WS_VT);
    LAS float* sc = (LAS float*)lds; LAS float* lg = sc + 2048; LAS float* sel = lg + 2048; LAS float* red = sel + 2048; LAS float* yacc = red + 16;
    for (int unit = bx; unit < NB * 12; unit += G) {
        const int b = unit / 12, t = dbg_sample_t(unit % 12); const size_t rowb = (size_t)b * SEQ;
        for (int s = tid; s < SEQ; s += 512) { float v = 0.f;
            if (s <= t) { for (int h = 0; h < 4; ++h) { float d = 0.f; for (int e = 0; e < 64; ++e) d += bf2f(IQ[(rowb + t) * 256 + h * 64 + e]) * bf2f(IK[(rowb + s) * 64 + e]); v += IW[(rowb + t) * 4 + h] * fmaxf(d, 0.f); } }
            sc[s] = v; }
        __syncthreads();
        int mism = 0;
        for (int s = tid; s < SEQ; s += 512) { float pick = 0.f;
            if (s <= t) { int cnt = 0; const float me = sc[s]; for (int s2 = 0; s2 <= t; ++s2) { const float o = sc[s2]; cnt += (o > me || (o == me && s2 < s)) ? 1 : 0; } pick = (t + 1 <= TOPK || cnt < TOPK) ? 1.f : 0.f; }
            sel[s] = pick;
            const int fast = (int)((MASK[((size_t)b * 32 + (s >> 6)) * SEQ + t] >> (s & 63)) & 1ull);
            mism += (fast != (int)pick) ? 1 : 0; }
        { const float tot = dbg_block_sum(red, (float)mism, tid); if (tid == 0 && tot > 0.f) atomicAdd(ctl + DBG_W_MASK, (unsigned)tot); }
        for (int h = 0; h < 8; ++h) {
            float lmax = -3e38f;
            for (int s = tid; s < SEQ; s += 512) { float v = -3e38f;
                if (s <= t && sel[s] != 0.f) { float d = 0.f; for (int e = 0; e < 64; ++e) d += bf2f(AQc[(rowb + t) * 512 + h * 64 + e]) * bf2f(AK[(rowb + s) * 64 + e]);
                    v = d + LOG2E * rel_bias[dbg_bucket(pos[rowb + t] - pos[rowb + s]) * 8 + h]; }
                lg[s] = v; lmax = fmaxf(lmax, v); }
            const float mx = dbg_block_max(red, lmax, tid);
            float ps = 0.f;
            for (int s = tid; s < SEQ; s += 512) { const float p = (lg[s] > -1e38f) ? exp2f(lg[s] - mx) : 0.f; lg[s] = p; ps += p; }
            const float tot = dbg_block_sum(red, ps, tid);
            { const int d = tid & 63, part = tid >> 6; float a = 0.f; for (int s = part; s <= t; s += 8) a += lg[s] * bf2f(AVT[((size_t)b * 64 + d) * SEQ + s]); yacc[part * 64 + d] = a; }
            __syncthreads();
            float err = 0.f, mag = 0.f;
            if (tid < 64) { float y = 0.f; for (int p = 0; p < 8; ++p) y += yacc[p * 64 + tid]; y /= tot; const float f = bf2f(YA[(rowb + t) * 512 + h * 64 + tid]); err = fabsf(f - y); mag = fabsf(y); }
            const float emax = dbg_block_max(red, err, tid), mmax = dbg_block_max(red, mag, tid);
            if (tid == 0) atomicMax(ctl + DBG_W_DSA, __float_as_uint(emax / (mmax + 1e-20f)));
            __syncthreads();
        }
        for (int h = 0; h < 8; ++h) {
            float lmax = -3e38f;
            for (int s = tid; s < SEQ; s += 512) { float v = -3e38f;
                if (s <= t) { float d = 0.f; for (int e = 0; e < 64; ++e) d += bf2f(QB[(rowb + t) * 768 + h * 96 + e]) * bf2f(KN[(rowb + s) * 512 + h * 64 + e]);
                    for (int e = 0; e < 32; ++e) d += bf2f(QB[(rowb + t) * 768 + h * 96 + 64 + e]) * bf2f(KR[(rowb + s) * 32 + e]); v = d; }
                lg[s] = v; lmax = fmaxf(lmax, v); }
            const float mx = dbg_block_max(red, lmax, tid);
            float ps = 0.f;
            for (int s = tid; s < SEQ; s += 512) { const float p = (lg[s] > -1e38f) ? exp2f(lg[s] - mx) : 0.f; lg[s] = p; ps += p; }
            const float tot = dbg_block_sum(red, ps, tid);
            { const int d = tid & 63, part = tid >> 6; float a = 0.f; for (int s = part; s <= t; s += 8) a += lg[s] * bf2f(VT[(size_t)(h * 64 + d) * M + rowb + s]); yacc[part * 64 + d] = a; }
            __syncthreads();
            float err = 0.f, mag = 0.f;
            if (tid < 64) { float y = 0.f; for (int p = 0; p < 8; ++p) y += yacc[p * 64 + tid]; y /= tot; const float f = bf2f(YB[(rowb + t) * 512 + h * 64 + tid]); err = fabsf(f - y); mag = fabsf(y); }
            const float emax = dbg_block_max(red, err, tid), mmax = dbg_block_max(red, mag, tid);
            if (tid == 0) atomicMax(ctl + DBG_W_MLA, __float_as_uint(emax / (mmax + 1e-20f)));
            __syncthreads();
        }
    }
}

__device__ __forceinline__ void dbg_upd(float& e, float& g, float fast, float ref) { e = fmaxf(e, fabsf(fast - ref)); g = fmaxf(g, fabsf(ref)); }
__device__ __forceinline__ void dbg_check_proj(unsigned char* ws, const int* pos, const float* w_in, const float* b_gate, const float* gq, const float* gkv, const float* w_uq, const float* w_ukv,
                                               LAS unsigned char* lds, int bx, int G, int tid) {
    unsigned* ctl = (unsigned*)(ws + WS_CTL);
    const bf16* H = (const bf16*)(ws + WS_H); const bf16* AQ = (const bf16*)(ws + WS_YA); const bf16* AK = (const bf16*)(ws + WS_AK); const bf16* AVT = (const bf16*)(ws + WS_AVT);
    const bf16* IQ = (const bf16*)(ws + WS_IQ); const bf16* IK = (const bf16*)(ws + WS_IK); const float* IW = (const float*)(ws + WS_IW); const bf16* GATES = (const bf16*)(ws + WS_GATES);
    const bf16* QB = (const bf16*)(ws + WS_QB); const bf16* KN = (const bf16*)(ws + WS_KN); const bf16* KR = (const bf16*)(ws + WS_KR); const bf16* VT = (const bf16*)(ws + WS_VT);
    LAS float* z = (LAS float*)lds;
    LAS float* hrow = z + 3456;
    LAS float* qb = hrow + 1024;
    LAS float* kvb = qb + 768;
    LAS float* red = kvb + 1024;
    for (int unit = bx; unit < 256; unit += G) {
        const int b = unit >> 4, t = (unit & 15) * 131 + 7; const size_t m = (size_t)b * SEQ + t;
        for (int k = tid; k < DM; k += 512) hrow[k] = bf2f(H[m * DM + k]);
        __syncthreads();
        for (int c = tid; c < DIN; c += 512) { float a = 0.f; for (int k = 0; k < DM; ++k) a += hrow[k] * w_in[(size_t)k * DIN + c]; z[c] = a; }
        __syncthreads();
        float e1 = 0.f, g1 = 0.f;
        for (int c = tid; c < 512; c += 512) dbg_upd(e1, g1, bf2f(AQ[m * 512 + c]), z[c] * C2A);
        float e1b = 0.f, g1b = 0.f;
        for (int c = tid; c < 64; c += 512) { dbg_upd(e1b, g1b, bf2f(AK[m * 64 + c]), z[512 + c]); dbg_upd(e1b, g1b, bf2f(AVT[((size_t)b * 64 + c) * SEQ + t]), z[576 + c]); dbg_upd(e1b, g1b, bf2f(IK[m * 64 + c]), z[896 + c]); }
        for (int c = tid; c < 256; c += 512) dbg_upd(e1b, g1b, bf2f(IQ[m * 256 + c]), z[640 + c]);
        for (int c = tid; c < 4; c += 512) dbg_upd(e1b, g1b, IW[m * 4 + c], z[960 + c]);
        float e1c = 0.f, g1c = 0.f;
        for (int c = tid; c < 2048; c += 512) dbg_upd(e1c, g1c, bf2f(GATES[m * 2048 + c]), 1.f / (1.f + expf(-(z[1380 + c] + b_gate[c]))));
        { const float ea = dbg_block_max(red, e1, tid), ga = dbg_block_max(red, g1, tid), eb = dbg_block_max(red, e1b, tid), gb = dbg_block_max(red, g1b, tid), ec = dbg_block_max(red, e1c, tid), gc = dbg_block_max(red, g1c, tid);
          if (tid == 0) atomicMax(ctl + DBG_W_DIR, __float_as_uint(fmaxf(fmaxf(ea / (ga + 1e-20f), eb / (gb + 1e-20f)), ec / (gc + 1e-20f)))); }
        float sq = 0.f; for (int k = tid; k < 256; k += 512) sq += z[964 + k] * z[964 + k];
        const float rq = 1.f / sqrtf(dbg_block_sum(red, sq, tid) / 256.f + EPS);
        float sk = 0.f; for (int k = tid; k < 128; k += 512) sk += z[1220 + k] * z[1220 + k];
        const float rk = 1.f / sqrtf(dbg_block_sum(red, sk, tid) / 128.f + EPS);
        for (int n = tid; n < 768; n += 512) { float a = 0.f; for (int k = 0; k < 256; ++k) a += z[964 + k] * rq * gq[k] * w_uq[(size_t)k * 768 + n]; qb[n] = a; }
        for (int n = tid; n < 1024; n += 512) { float a = 0.f; for (int k = 0; k < 128; ++k) a += z[1220 + k] * rk * gkv[k] * w_ukv[(size_t)k * 1024 + n]; kvb[n] = a; }
        __syncthreads();
        float e2 = 0.f, g2 = 0.f, e3 = 0.f, g3 = 0.f;
        const double p = (double)pos[m];
        for (int n = tid; n < 768; n += 512) { const int h = n / 96, c = n % 96; float ref;
            if (c < 64) ref = qb[n];
            else { const int j = c - 64, i = j >> 1; const double ang = p * pow(10000.0, -(double)(2 * i) / 32.0); const float cs = (float)cos(ang), sn = (float)sin(ang);
                   const float x1 = qb[h * 96 + 64 + i], x2 = qb[h * 96 + 80 + i]; ref = (j & 1) ? (x1 * sn + x2 * cs) : (x1 * cs - x2 * sn); }
            dbg_upd(e2, g2, bf2f(QB[m * 768 + n]), ref * C2B); }
        for (int n = tid; n < 512; n += 512) { const int h = n >> 6, d = n & 63;
            dbg_upd(e3, g3, bf2f(KN[m * 512 + n]), kvb[h * 128 + d]); dbg_upd(e3, g3, bf2f(VT[(size_t)n * M + m]), kvb[h * 128 + 64 + d]); }
        float e3b = 0.f, g3b = 0.f;
        for (int j = tid; j < 32; j += 512) { const int i = j >> 1; const double ang = p * pow(10000.0, -(double)(2 * i) / 32.0); const float cs = (float)cos(ang), sn = (float)sin(ang);
            const float x1 = z[1348 + i], x2 = z[1364 + i]; const float ref = (j & 1) ? (x1 * sn + x2 * cs) : (x1 * cs - x2 * sn); dbg_upd(e3b, g3b, bf2f(KR[m * 32 + j]), ref); }
        { const float ea = dbg_block_max(red, e2, tid), ga = dbg_block_max(red, g2, tid), eb = dbg_block_max(red, e3, tid), gb = dbg_block_max(red, g3, tid), ec = dbg_block_max(red, e3b, tid), gc = dbg_block_max(red, g3b, tid);
          if (tid == 0) { atomicMax(ctl + DBG_W_QB, __float_as_uint(ea / (ga + 1e-20f))); atomicMax(ctl + DBG_W_KV, __float_as_uint(fmaxf(eb / (gb + 1e-20f), ec / (gc + 1e-20f)))); } }
        __syncthreads();
    }
}

constexpr int DBG_W_CK = 32;
__device__ __forceinline__ void dbg_checksum(unsigned char* ws, float* outbuf, int phase, int rep, int bx, int G, int tid) {
    size_t lo = 0, hi = 0; const unsigned* base = (const unsigned*)ws;
    if (phase == 0) { lo = 1 * MiB; hi = 100 * MiB; }
    else if (phase == 1) { lo = 5 * MiB; hi = 7 * MiB; }
    else if (phase == 2) { lo = 356 * MiB; hi = 468 * MiB; }
    else if (phase == 3) { lo = 100 * MiB; hi = 164 * MiB; }
    else if (phase == 4) { lo = 356 * MiB; hi = 420 * MiB; }
    else { base = (const unsigned*)outbuf; lo = 0; hi = 128 * MiB; }
    unsigned long long acc = 0ull;
    for (size_t i = lo / 4 + (size_t)bx * 512 + tid; i < hi / 4; i += (size_t)G * 512) acc += (unsigned long long)base[i] * (unsigned long long)((i & 1023u) + 1u);
    if (phase == 1) for (size_t i = (100 * MiB) / 4 + (size_t)bx * 512 + tid; i < (356 * MiB) / 4; i += (size_t)G * 512) acc += (unsigned long long)base[i] * (unsigned long long)((i & 1023u) + 1u);
    if (phase == 2) for (size_t i = (220 * MiB) / 4 + (size_t)bx * 512 + tid; i < (228 * MiB) / 4; i += (size_t)G * 512) acc += (unsigned long long)base[i] * (unsigned long long)((i & 1023u) + 1u);
    for (int o = 1; o < 64; o <<= 1) acc += __shfl_xor(acc, o);
    if ((tid & 63) == 0) atomicAdd((unsigned long long*)(ws + WS_CTL) + (DBG_W_CK / 2 + 2 * phase + rep), acc);
}
__device__ __forceinline__ float dbg_output_scale(unsigned char* ws) {
    const unsigned* ctl = (const unsigned*)(ws + WS_CTL);
    float e[6]; for (int i = 0; i < 6; ++i) e[i] = __uint_as_float(__hip_atomic_load(ctl + 16 + i, __ATOMIC_RELAXED, __HIP_MEMORY_SCOPE_AGENT));
    const unsigned mm = __hip_atomic_load(ctl + DBG_W_MASK, __ATOMIC_RELAXED, __HIP_MEMORY_SCOPE_AGENT);
#define DBG_BK(x) ((x) < 0.04f ? 0 : ((x) < 0.2f ? 1 : 2))
#if DBG_CHECK == 3
    { const unsigned long long* ck = (const unsigned long long*)(ws + WS_CTL) + DBG_W_CK / 2; int k = 0;
      for (int p = 0; p < 6; ++p) { const unsigned long long a = __hip_atomic_load(ck + 2 * p, __ATOMIC_RELAXED, __HIP_MEMORY_SCOPE_AGENT), b = __hip_atomic_load(ck + 2 * p + 1, __ATOMIC_RELAXED, __HIP_MEMORY_SCOPE_AGENT); if (a != b) k += (1 << p); }
      (void)e; (void)mm; return 1.f + (float)k; }
    const int c1 = 0, c2 = 0, c3 = 0;
#elif DBG_CHECK == 1
    const int c1 = DBG_BK(e[0]), c2 = mm <= 20u ? 0 : (mm <= 2000u ? 1 : 2), c3 = DBG_BK(e[2]);
#else
    const int c1 = DBG_BK(e[3]), c2 = DBG_BK(e[4]), c3 = DBG_BK(e[5]);
#endif
    return 1.f + (float)(c1 + 3 * c2 + 9 * c3);
}
#endif
struct Args { const void* in[17]; float* out; unsigned char* ws; int ph_lo, ph_hi; };
__global__ void __launch_bounds__(NWAVES * 64, 2) trunk_fwd(Args args) {
    extern __shared__ __attribute__((aligned(16))) unsigned char lds[];
    Frame F;
    F.lds = (LAS unsigned char*)lds;
    F.tid = threadIdx.x; F.lane = F.tid & 63; F.wave = __builtin_amdgcn_readfirstlane(F.tid >> 6);
    F.G = gridDim.x; F.bx = blockIdx.x;
    F.x = (const float*)args.in[0]; F.pos = (const int*)args.in[1]; F.rel_bias = (const float*)args.in[15]; F.out = args.out; F.ws = args.ws;
    volatile LAS unsigned* MISC = (volatile LAS unsigned*)(F.lds + MISC_OFF);
    if (F.tid < 32) MISC[F.tid] = 0u;
#if defined(DBG_LDS_FILL)
    for (int i = F.tid; i < MISC_OFF / 4; i += NWAVES * 64) ((LAS unsigned*)F.lds)[i] = 0xffffffffu;
#endif
    __syncthreads();
    unsigned* ctl = (unsigned*)(F.ws + WS_CTL);
#if MK_ONE_LAUNCH
    XcdBarrier bar = xcd_barrier_post(ctl + CW_BAR, MISC + 8);
#define GRID_BAR() xcd_barrier(bar)
#else
#define GRID_BAR() do { } while (0)
#endif
    const float* g1 = (const float*)args.in[2]; const float* w_in = (const float*)args.in[3]; const float* b_gate = (const float*)args.in[4];
    const float* gq = (const float*)args.in[5]; const float* gkv = (const float*)args.in[6]; const float* w_uq = (const float*)args.in[7]; const float* w_ukv = (const float*)args.in[8];
    const float* w_a = (const float*)args.in[9]; const float* w_b = (const float*)args.in[10]; const float* w_out = (const float*)args.in[11]; const float* g2 = (const float*)args.in[12];
    const float* w_ff1 = (const float*)args.in[13]; const float* w_ff2 = (const float*)args.in[14]; const float* gf = (const float*)args.in[16];
#define PHASE_FRAME() \
    { int t_ = threadIdx.x; asm volatile("" : "+v"(t_)); F.tid = t_; F.lane = t_ & 63; F.wave = __builtin_amdgcn_readfirstlane(t_ >> 6); } \
    size_t z0_ = 0; asm volatile("" : "+s"(z0_)); unsigned char* ws = args.ws + z0_; F.ws = ws;     \
    bf16* WB = (bf16*)(ws + WS_W); bf16* H = (bf16*)(ws + WS_H); bf16* YA = (bf16*)(ws + WS_YA); \
    bf16* IQ = (bf16*)(ws + WS_IQ); bf16* CQ = (bf16*)(ws + WS_CQ); bf16* CKV = (bf16*)(ws + WS_CKV); bf16* AK = (bf16*)(ws + WS_AK); bf16* AVT = (bf16*)(ws + WS_AVT); \
    bf16* IK = (bf16*)(ws + WS_IK); bf16* KR = (bf16*)(ws + WS_KR); bf16* GATES = (bf16*)(ws + WS_GATES); bf16* QB = (bf16*)(ws + WS_QB); bf16* KN = (bf16*)(ws + WS_KN); \
    bf16* VT = (bf16*)(ws + WS_VT); bf16* MERGED = (bf16*)(ws + WS_MERGED); bf16* HID = (bf16*)(ws + WS_HID); \
    float* CS = (float*)(ws + WS_CS); float* SSQQ = (float*)(ws + WS_SSQQ); float* SSQKV = (float*)(ws + WS_SSQKV); float* IW = (float*)(ws + WS_IW); \
    (void)WB; (void)H; (void)YA; (void)IQ; (void)CQ; (void)CKV; (void)AK; (void)AVT; (void)IK; (void)KR; (void)GATES; (void)QB; (void)KN; (void)VT; (void)MERGED; (void)HID; (void)CS; (void)SSQQ; (void)SSQKV; (void)IW;
    const int lo = args.ph_lo, hi = args.ph_hi;
#ifndef DBG_ATT_SCALE
#define DBG_ATT_SCALE 1.0f
#endif
#ifndef PH_ENABLE
#define PH_ENABLE 0x3ff
#endif
#define PHON(k) (((PH_ENABLE) >> (k)) & 1)
#define IN(p) (lo <= (p) && (p) < hi)
#if defined(DBG_CHECK)
    if (lo == 1000) { dbg_check_attn(args.ws, F.out, F.pos, F.rel_bias, F.lds, F.bx, F.G, F.tid); return; }
    if (lo >= 2000 && lo < 2100) { dbg_checksum(args.ws, F.out, (lo - 2000) >> 1, (lo - 2000) & 1, F.bx, F.G, F.tid); return; }
    if (lo == 3000) {
        u32x4* w4 = (u32x4*)(args.ws + DBG_FILL_LO); const u32x4 nn = (u32x4){0xffffffffu, 0xffffffffu, 0xffffffffu, 0xffffffffu};
        for (size_t i = (size_t)F.bx * 512 + F.tid; i < (DBG_FILL_HI - DBG_FILL_LO) / 16; i += (size_t)F.G * 512) w4[i] = nn;
        u32x4* o4 = (u32x4*)F.out; for (size_t i = (size_t)F.bx * 512 + F.tid; i < (size_t)M * DM * 4 / 16; i += (size_t)F.G * 512) o4[i] = nn;
        return; }
    if (lo == 4000) {
        const unsigned* src = (const unsigned*)(args.ws + (size_t)(DBG_PROBE_OFF) * MiB);
        for (size_t i = (size_t)F.bx * 512 + F.tid; i < (size_t)M * DM; i += (size_t)F.G * 512) { const unsigned w = src[i];
            float a = __uint_as_float(w << 16), b = __uint_as_float(w & 0xffff0000u); if (!(fabsf(a) < 1e30f)) a = 0.f; if (!(fabsf(b) < 1e30f)) b = 0.f; F.out[i] = a + 2.f * b; }
        return; }
    if (lo == 1001) { dbg_check_proj(args.ws, F.pos, w_in, b_gate, gq, gkv, w_uq, w_ukv, F.lds, F.bx, F.G, F.tid); return; }
#endif
#if defined(DBG_SPLIT_BR)
    if (lo >= 5000 && lo < 5008) { PHASE_FRAME();
        pg8::Gemm g{YA, WB + W_AB_OFF, 2 * M, 2048, 512}; pg8::BranchOrder S; S.init(F.G, F.bx, lo & 1); pg8::EpiBranch E{MERGED, GATES};
        pg8::gemm_phase<pg8::EpiBranch, pg8::BranchOrder, true, true>(F.lds, g, S, E);
        return; }
#endif
    for (int l = 0; l < DEPTH; ++l) {
        const int p0 = l * PH_PER_LAYER;
        const float* xcur = (l == 0) ? F.x : F.out;
        if (PHON(0) && IN(p0 + 0) && l == 0) { PHASE_FRAME();
            rope_table(F); pos_tables(F);
            prep_weights<0>(F, 0, 0, g1, g2, w_in, gq, gkv, w_uq, w_ukv, w_a, w_b, w_out, w_ff1, w_ff2);
            init_rows(F);
            GRID_BAR();
        }
        if (PHON(1) && IN(p0 + 1)) { PHASE_FRAME();
            pg8::Gemm g{H, WB + W_IN_OFF, M, NIN, DM}; pg8::StaticOrder S; S.init(M, NIN, F.G, F.bx);
            pg8::EpiIn E{YA, IQ, CQ, CKV, AK, AVT, IK, KR, GATES, IW, SSQQ, SSQKV, CS, b_gate + l * 2048, (const unsigned long long*)(ws + WS_RSS) + M};
            pg8::gemm_phase<pg8::EpiIn, pg8::StaticOrder, true, true>(F.lds, g, S, E);
            GRID_BAR();
        }
        if (PHON(2) && IN(p0 + 2)) { PHASE_FRAME();
#ifndef SUB_ENABLE
#define SUB_ENABLE 0xf
#endif
            if ((SUB_ENABLE) & 1) { pg8::Gemm g{CQ, WB + W_UQ_OFF, M, 768, 256}; pg8::StaticOrder S; S.init(M, 768, F.G, F.bx); pg8::EpiUQ E{QB, SSQQ, CS};
              pg8::gemm_phase<pg8::EpiUQ, pg8::StaticOrder, true, true>(F.lds, g, S, E); }
            if ((SUB_ENABLE) & 2) { pg8::Gemm g{CKV, WB + W_UK_OFF, M, 512, 128}; pg8::StaticOrder S; S.init(M, 512, F.G, F.bx); pg8::EpiUK E{KN, SSQKV};
              pg8::gemm_phase<pg8::EpiUK, pg8::StaticOrder, true, true>(F.lds, g, S, E); }
            if ((SUB_ENABLE) & 4) { pg8::Gemm g{WB + W_UV_OFF, CKV, 512, M, 128}; pg8::StaticOrder S; S.init(512, M, F.G, F.bx); pg8::EpiUV E{VT, SSQKV};
              pg8::gemm_phase<pg8::EpiUV, pg8::StaticOrder, true, true>(F.lds, g, S, E); }
            if ((SUB_ENABLE) & 8) idx_phase(F);
#if defined(DBG_CHECK)
            if (l == 0) dbg_copy_aq(F.ws, F.out, F.bx, F.G, F.tid);
#endif
            GRID_BAR();
        }
        if (PHON(3) && IN(p0 + 3)) { PHASE_FRAME(); attn_phase(F);
            prep_weights<1>(F, l, 49152, g1, g2, w_in, gq, gkv, w_uq, w_ukv, w_a, w_b, w_out, w_ff1, w_ff2);
            if (l + 1 < DEPTH) prep_weights<0>(F, l + 1, 49152, g1, g2, w_in, gq, gkv, w_uq, w_ukv, w_a, w_b, w_out, w_ff1, w_ff2);
            { unsigned long long* rs = (unsigned long long*)(ws + WS_RSS);
              for (int e = F.bx * (NWAVES * 64) + F.tid; e < 2 * M; e += F.G * NWAVES * 64) rs[e] = 0ull; }
            GRID_BAR(); }
        if (PHON(4) && IN(p0 + 4)) { PHASE_FRAME();
            pg8::Gemm g{YA, WB + W_AB_OFF, 2 * M, 2048, 512}; pg8::BranchOrder S; S.init(F.G, F.bx); pg8::EpiBranch E{MERGED, GATES};
            pg8::gemm_phase<pg8::EpiBranch, pg8::BranchOrder, true, true>(F.lds, g, S, E);
            GRID_BAR();
        }
        if (PHON(5) && IN(p0 + 5)) { PHASE_FRAME();
            pg8::Gemm g{MERGED, WB + W_OUT_OFF, M, DM, DM}; pg8::StaticOrder S; S.init(M, DM, F.G, F.bx); pg8::EpiRes E{xcur, F.out, DBG_ATT_SCALE, H, (unsigned long long*)(ws + WS_RSS)};
            pg8::gemm_phase<pg8::EpiRes, pg8::StaticOrder, true, true>(F.lds, g, S, E);
            GRID_BAR();
        }
        if (PHON(7) && IN(p0 + 7)) { PHASE_FRAME();
            pg8::Gemm g{H, WB + W_FF1_OFF, M, DFF, DM}; pg8::StaticOrder S; S.init(M, DFF, F.G, F.bx); pg8::EpiFF1 E{HID, (const unsigned long long*)(ws + WS_RSS)};
            pg8::gemm_phase<pg8::EpiFF1, pg8::StaticOrder, true, true>(F.lds, g, S, E);
            GRID_BAR();
        }
        if (PHON(8) && IN(p0 + 8)) { PHASE_FRAME();
            pg8::Gemm g{HID, WB + W_FF2_OFF, M, DM, DFF}; pg8::StaticOrder S; S.init(M, DM, F.G, F.bx); pg8::EpiRes E{F.out, F.out, 1.0f, H, (unsigned long long*)(ws + WS_RSS) + M};
            pg8::gemm_phase<pg8::EpiRes, pg8::StaticOrder, true, true>(F.lds, g, S, E);
            GRID_BAR();
        }
    }
    if (PHON(9) && IN(DEPTH * PH_PER_LAYER)) { PHASE_FRAME(); float osc = 1.f;
#if defined(DBG_CHECK)
        osc = dbg_output_scale(F.ws);
#endif
        norm_rows<true>(F, F.out, gf, nullptr, F.out, osc); }
#undef IN
}

extern "C" void kernel_launch(void* const* d_in, const int* in_sizes, int n_in, void* d_out, int out_size, void* d_ws, size_t ws_size, hipStream_t stream) {
    static int grid = 0;
    if (grid == 0) {
        if (n_in != 17 || in_sizes[0] != M * DM || out_size != M * DM || ws_size < WS_END) { fprintf(stderr, "kernel_launch: unexpected shapes (n_in %d, in0 %d, out %d, ws %zu); nothing launched\n", n_in, n_in > 0 ? in_sizes[0] : -1, out_size, ws_size); grid = -1; return; }
        int dev = 0, cus = 0, per_cu = 0;
        if (hipGetDevice(&dev) != hipSuccess || hipDeviceGetAttribute(&cus, hipDeviceAttributeMultiprocessorCount, dev) != hipSuccess) { grid = -1; return; }
        if (hipFuncSetAttribute((const void*)trunk_fwd, hipFuncAttributeMaxDynamicSharedMemorySize, LDS_BYTES) != hipSuccess) { fprintf(stderr, "kernel_launch: hipFuncSetAttribute failed\n"); grid = -1; return; }
        if (hipOccupancyMaxActiveBlocksPerMultiprocessor(&per_cu, (const void*)trunk_fwd, NWAVES * 64, LDS_BYTES) != hipSuccess || per_cu < 1)
            fprintf(stderr, "kernel_launch: note: occupancy query reports %d workgroups per CU\n", per_cu);
        (void)hipGetLastError();
        grid = cus;
    }
    if (grid < 0) return;
    if (hipMemsetAsync((char*)d_ws + WS_CTL, 0, CTL_ZERO_BYTES, stream) != hipSuccess) return;
    Args a{};
    for (int i = 0; i < 17; ++i) a.in[i] = d_in[i];
    a.out = (float*)d_out; a.ws = (unsigned char*)d_ws;
#if MK_ONE_LAUNCH
    a.ph_lo = 0; a.ph_hi = N_PHASES;
    hipLaunchKernelGGL(trunk_fwd, dim3(grid), dim3(NWAVES * 64), LDS_BYTES, stream, a);
#elif defined(DBG_CHECK) && DBG_CHECK == 3
#define DBG_L(a_, b_) do { a.ph_lo = (a_); a.ph_hi = (b_); hipLaunchKernelGGL(trunk_fwd, dim3(grid), dim3(NWAVES * 64), LDS_BYTES, stream, a); } while (0)
    DBG_L(0, 1); DBG_L(2000, 2001); DBG_L(0, 1); DBG_L(2001, 2002);
    DBG_L(1, 2); DBG_L(2002, 2003); DBG_L(1, 2); DBG_L(2003, 2004);
    DBG_L(2, 3); DBG_L(2004, 2005); DBG_L(2, 3); DBG_L(2005, 2006);
    DBG_L(3, 4); DBG_L(2006, 2007); DBG_L(1, 2); DBG_L(3, 4); DBG_L(2007, 2008);
    DBG_L(4, 5); DBG_L(2008, 2009); DBG_L(2, 3); DBG_L(4, 5); DBG_L(2009, 2010);
    DBG_L(5, 6); DBG_L(2010, 2011); DBG_L(5, 6); DBG_L(2011, 2012);
    for (int p = 6; p < N_PHASES; ++p) DBG_L(p, p + 1);
#elif defined(DBG_CHECK) && DBG_CHECK == 5
    a.ph_lo = 3000; a.ph_hi = 3001; hipLaunchKernelGGL(trunk_fwd, dim3(grid), dim3(NWAVES * 64), LDS_BYTES, stream, a);
    for (int p = 0; p < (DBG_PROBE_PH); ++p) { a.ph_lo = p; a.ph_hi = p + 1; hipLaunchKernelGGL(trunk_fwd, dim3(grid), dim3(NWAVES * 64), LDS_BYTES, stream, a); }
    if ((DBG_PROBE_OFF) >= 0) { a.ph_lo = 4000; a.ph_hi = 4001; hipLaunchKernelGGL(trunk_fwd, dim3(grid), dim3(NWAVES * 64), LDS_BYTES, stream, a); }
#elif defined(DBG_CHECK) && DBG_CHECK == 4
    a.ph_lo = 3000; a.ph_hi = 3001; hipLaunchKernelGGL(trunk_fwd, dim3(grid), dim3(NWAVES * 64), LDS_BYTES, stream, a);
    for (int p = 0; p < N_PHASES; ++p) { a.ph_lo = p; a.ph_hi = p + 1; hipLaunchKernelGGL(trunk_fwd, dim3(grid), dim3(NWAVES * 64), LDS_BYTES, stream, a); }
#else
    for (int p = 0; p < N_PHASES; ++p) {
#if defined(DBG_SPLIT_BR)
        if (p < DEPTH * PH_PER_LAYER && p % PH_PER_LAYER == 4) { for (int br = 0; br < 2; ++br) { a.ph_lo = 5000 + 2 * (p / PH_PER_LAYER) + br; a.ph_hi = a.ph_lo + 1; hipLaunchKernelGGL(trunk_fwd, dim3(grid), dim3(NWAVES * 64), LDS_BYTES, stream, a); } continue; }
#endif
        a.ph_lo = p; a.ph_hi = p + 1; hipLaunchKernelGGL(trunk_fwd, dim3(grid), dim3(NWAVES * 64), LDS_BYTES, stream, a);
#if defined(DBG_CHECK)
        if (p == 3) { a.ph_lo = 1000; a.ph_hi = 1001; hipLaunchKernelGGL(trunk_fwd, dim3(grid), dim3(NWAVES * 64), LDS_BYTES, stream, a); }
        if (p == 2) { a.ph_lo = 1001; a.ph_hi = 1002; hipLaunchKernelGGL(trunk_fwd, dim3(grid), dim3(NWAVES * 64), LDS_BYTES, stream, a); }
#endif
    }
#endif
}
```

```cpp
#include <hip/hip_runtime.h>
#include <cstdio>
#include <cstdint>
namespace pg8 {
#define PG8_LAS __attribute__((address_space(3)))
typedef unsigned short bf16_t;
typedef short bf16x8 __attribute__((ext_vector_type(8)));
typedef float f32x4 __attribute__((ext_vector_type(4)));
typedef unsigned u32x4 __attribute__((ext_vector_type(4)));
constexpr int BM = 256, BK = 64, HALF = 128, HTB = HALF * BK * 2  , STAGE_BYTES = 8 * HTB, NXCD = 8, WGM = 8;

__host__ __device__ __forceinline__ int lds_byte(int r, int c) { const int st = (r >> 4) * 2 + (c >> 5), rr = r & 15, cc = c & 31, ob = rr * 64 + cc * 2; return st * 1024 + (ob ^ (((ob >> 9) & 1) << 5)); }
__host__ __device__ __forceinline__ void stage_rc(int b, int& R, int& C) { const int st = b / 1024, sb = b % 1024, swz = sb ^ (((sb >> 9) & 1) << 5); R = (st >> 1) * 16 + swz / 64; C = (st & 1) * 32 + (swz % 64) / 2; }
__host__ __device__ __forceinline__ int perm32(int rho) { const int n = rho >> 4, i = rho & 15; return 8 * (i >> 2) + 4 * n + (i & 3); }

struct Unit { int pm, pn; };
struct Gemm { const bf16_t* A; const bf16_t* Bt; int M, N, K; };

struct StaticOrder {
    int nM, nN, nwg, G, c;
    __host__ __device__ void init(int M, int N, int G_, int c_) { nM = M / BM; nN = N / BM; nwg = nM * nN; G = G_; c = c_; }
    __host__ __device__ bool next(int i, Unit& u) const {
        const long L = (long)i * G + c; if (L >= nwg) return false;
        int wgid = (int)L; { const int q = nwg / NXCD, r = nwg % NXCD, xcd = wgid % NXCD, off = wgid / NXCD; wgid = (xcd < r ? xcd * (q + 1) : r * (q + 1) + (xcd - r) * q) + off; }
        const int nig = WGM * nN, gid = wgid / nig, fm = gid * WGM, gsz = (nM - fm) < WGM ? (nM - fm) : WGM;
        u.pm = fm + ((wgid % nig) % gsz); u.pn = (wgid % nig) / gsz; return true;
    }
    __device__ __forceinline__ void a_ready(const Unit&) const {}
    __device__ __forceinline__ void done(const Unit&) const {}
};

typedef float f32x2c_t __attribute__((ext_vector_type(2))); typedef __bf16 bf16x2c_t __attribute__((ext_vector_type(2)));
__device__ __forceinline__ unsigned cvt_pk_bf16(float lo, float hi) { const f32x2c_t v = {lo, hi}; const bf16x2c_t b = __builtin_convertvector(v, bf16x2c_t); return __builtin_bit_cast(unsigned, b); }
typedef float f32x2 __attribute__((ext_vector_type(2)));
typedef int i32x4 __attribute__((ext_vector_type(4)));
__device__ __forceinline__ f32x4 mma16(const bf16x8 a, const bf16x8 b, const f32x4 c) { return __builtin_amdgcn_mfma_f32_16x16x32_bf16(a, b, c, 0, 0, 0); }
__device__ __forceinline__ i32x4 mma16(const bf16x8 a, const bf16x8 b, const i32x4 c) { return __builtin_amdgcn_mfma_i32_16x16x64_i8(__builtin_bit_cast(i32x4, a), __builtin_bit_cast(i32x4, b), c, 0, 0, 0); }
__device__ __forceinline__ f32x4 acc_zero(f32x4*) { return (f32x4){0.f, 0.f, 0.f, 0.f}; }
__device__ __forceinline__ i32x4 acc_zero(i32x4*) { return (i32x4){0, 0, 0, 0}; }
template <class Epi, class Sched, bool ALIGN_EPI = false, bool SP2 = false, bool AKT = false, bool BKT = false>
__device__ __forceinline__ void gemm_phase(PG8_LAS unsigned char* lds, const Gemm g, const Sched& S, const Epi& E) {
    int tid_ = threadIdx.x; asm volatile("" : "+v"(tid_));
    const int tid = tid_, wid = __builtin_amdgcn_readfirstlane(tid >> 6), lane = tid & 63, wr = wid >> 2, wc = wid & 3, fr = lane & 15, fq = lane >> 4;
    int Kx_ = g.K; asm volatile("" : "+s"(Kx_)); const int K = Kx_, nt = K / BK;
    unsigned voffA[2], voffB[2];
#pragma unroll
    for (int i = 0; i < 2; ++i) { int R, C; stage_rc(tid * 16 + i * 8192, R, C); const int Rb = Epi::PERM ? ((R & ~31) + perm32(R & 31)) : R;
        voffA[i] = AKT ? (unsigned)(R * BK + C) * 2u : (unsigned)(R * K + C) * 2u; voffB[i] = BKT ? (unsigned)(Rb * BK + C) * 2u : (unsigned)(Rb * K + C) * 2u; }
    const unsigned kstepA = AKT ? (unsigned)(BM * BK * 2) : (unsigned)(BK * 2), kstepB = BKT ? (unsigned)(BM * BK * 2) : (unsigned)(BK * 2);
    const unsigned hstepA = AKT ? (unsigned)(HALF * BK * 2) : (unsigned)(HALF * K * 2), hstepB = BKT ? (unsigned)(HALF * BK * 2) : (unsigned)(HALF * K * 2);
    const unsigned tstep = (unsigned)(BM * K * 2);
    const __amdgpu_buffer_rsrc_t rsA = __builtin_amdgcn_make_buffer_rsrc((void*)g.A, 0, -1, 0x00020000), rsB = __builtin_amdgcn_make_buffer_rsrc((void*)g.Bt, 0, -1, 0x00020000);
    const unsigned ldsw = (unsigned)wid * 1024u;
    const int aoff = lds_byte(wr * 64 + fr, fq * 8), boff = lds_byte(wc * 32 + fr, fq * 8);
#define PG8_SA(b, h) (((b) * 2 + (h)) * HTB)
#define PG8_SB(b, h) ((4 + (b) * 2 + (h)) * HTB)
#define PG8_STAGE(bufoff, soff, voff) do { _Pragma("unroll") for (int _i = 0; _i < 2; ++_i) \
        __builtin_amdgcn_raw_ptr_buffer_load_lds(PG8_RS(voff), (PG8_LAS void*)(lds + (bufoff) + ldsw + _i * 8192), 16, (int)(voff)[_i], (int)(soff), 0, 0); } while (0)
#define PG8_RS(voff) (((voff) == voffA) ? rsA : rsB)
#define PG8_LDA(dst, b, h) do { _Pragma("unroll") for (int m = 0; m < 4; ++m) _Pragma("unroll") for (int k = 0; k < 2; ++k) dst[m][k] = *(const PG8_LAS bf16x8*)(lds + PG8_SA(b, h) + aoff + m * 2048 + k * 1024); } while (0)
#define PG8_LDB(dst, b, h) do { _Pragma("unroll") for (int n = 0; n < 2; ++n) _Pragma("unroll") for (int k = 0; k < 2; ++k) dst[n][k] = *(const PG8_LAS bf16x8*)(lds + PG8_SB(b, h) + boff + n * 2048 + k * 1024); } while (0)
#define PG8_MMA(ai, bj, At, Bt) do { __builtin_amdgcn_s_setprio(1); _Pragma("unroll") for (int m = 0; m < 4; ++m) _Pragma("unroll") for (int n = 0; n < 2; ++n) _Pragma("unroll") for (int k = 0; k < 2; ++k) \
        acc[ai][bj][m][n] = mma16(Bt[n][k], At[m][k], acc[ai][bj][m][n]); __builtin_amdgcn_s_setprio(0); } while (0)
#define PG8_WAIT_V(n) asm volatile("s_waitcnt vmcnt(" #n ")" ::: "memory")
#define PG8_WAIT_L(n) asm volatile("s_waitcnt lgkmcnt(" #n ")" ::: "memory")
#define PG8_BAR __builtin_amdgcn_s_barrier()
#define PG8_SCHED __builtin_amdgcn_sched_barrier(0)
    Unit cur, nxt; int ui = 0;
    if (!S.next(0, cur)) return;
    typedef typename Epi::acc_t acc_t;
    acc_t acc[2][2][4][2];
#pragma unroll
    for (int a = 0; a < 2; ++a)
#pragma unroll
        for (int b = 0; b < 2; ++b)
#pragma unroll
            for (int m = 0; m < 4; ++m)
#pragma unroll
                for (int n = 0; n < 2; ++n) acc[a][b][m][n] = acc_zero((acc_t*)nullptr);
    bf16x8 At[4][2], B0[2][2], B1[2][2];
    unsigned cA = (unsigned)__builtin_amdgcn_readfirstlane(cur.pm) * tstep, cB = (unsigned)__builtin_amdgcn_readfirstlane(cur.pn) * tstep;
    S.a_ready(cur);
    if constexpr (SP2) {
        PG8_STAGE(PG8_SB(0, 0), cB, voffB); PG8_STAGE(PG8_SB(0, 1), cB + hstepB, voffB); PG8_STAGE(PG8_SA(0, 0), cA, voffA); PG8_STAGE(PG8_SA(0, 1), cA + hstepA, voffA);
        if (wr == 1) PG8_BAR;
        PG8_WAIT_V(2); PG8_BAR;
        PG8_STAGE(PG8_SB(1, 0), cB + kstepB, voffB); PG8_STAGE(PG8_SA(1, 0), cA + kstepA, voffA); PG8_STAGE(PG8_SB(1, 1), cB + hstepB + kstepB, voffB);
        PG8_WAIT_V(6); PG8_BAR;
    } else {
        PG8_STAGE(PG8_SB(0, 0), cB, voffB); PG8_STAGE(PG8_SA(0, 0), cA, voffA); PG8_STAGE(PG8_SB(0, 1), cB + hstepB, voffB); PG8_STAGE(PG8_SA(0, 1), cA + hstepA, voffA);
        if (wr == 1) PG8_BAR;
        PG8_WAIT_V(4); PG8_BAR;
        PG8_STAGE(PG8_SB(1, 0), cB + kstepB, voffB); PG8_STAGE(PG8_SA(1, 0), cA + kstepA, voffA); PG8_STAGE(PG8_SB(1, 1), cB + hstepB + kstepB, voffB);
        PG8_WAIT_V(6); PG8_BAR;
    }
    for (;;) {
        const bool has_next = S.next(ui + 1, nxt);
        const unsigned nA = has_next ? (unsigned)__builtin_amdgcn_readfirstlane(nxt.pm) * tstep : cA, nB = has_next ? (unsigned)__builtin_amdgcn_readfirstlane(nxt.pn) * tstep : cB;
        asm volatile(".p2align 8" ::: "memory");
        for (int t = 0; t < nt; t += 2) {
            const bool last = (t == nt - 2);
            const unsigned a1 = cA + (unsigned)(t + 1) * kstepA;
            const unsigned a2 = last ? nA : cA + (unsigned)(t + 2) * kstepA, b2 = last ? nB : cB + (unsigned)(t + 2) * kstepB;
            const unsigned a3 = a2 + kstepA, b3 = b2 + kstepB;
            if (last && has_next) S.a_ready(nxt);
            if constexpr (SP2) {
            PG8_LDB(B0, 0, 0); PG8_LDB(B1, 0, 1); PG8_SCHED; PG8_LDA(At, 0, 0); PG8_STAGE(PG8_SA(1, 1), a1 + hstepA, voffA);
            PG8_WAIT_V(8); PG8_WAIT_L(0); PG8_BAR; PG8_MMA(0, 0, At, B0); PG8_MMA(0, 1, At, B1); PG8_BAR; PG8_SCHED;
            PG8_LDA(At, 0, 1); PG8_STAGE(PG8_SB(0, 0), b2, voffB); PG8_STAGE(PG8_SB(0, 1), b2 + hstepB, voffB); PG8_STAGE(PG8_SA(0, 0), a2, voffA);
            PG8_WAIT_V(8); PG8_WAIT_L(0); PG8_BAR; PG8_MMA(1, 0, At, B0); PG8_MMA(1, 1, At, B1); PG8_BAR; PG8_SCHED;
            PG8_LDB(B0, 1, 0); PG8_LDB(B1, 1, 1); PG8_SCHED; PG8_LDA(At, 1, 0); PG8_STAGE(PG8_SA(0, 1), a2 + hstepA, voffA);
            PG8_WAIT_V(8); PG8_WAIT_L(0); PG8_BAR; PG8_MMA(0, 0, At, B0); PG8_MMA(0, 1, At, B1); PG8_BAR; PG8_SCHED;
            PG8_LDA(At, 1, 1); PG8_STAGE(PG8_SB(1, 0), b3, voffB); PG8_STAGE(PG8_SB(1, 1), b3 + hstepB, voffB); PG8_STAGE(PG8_SA(1, 0), a3, voffA);
            PG8_WAIT_V(8); PG8_WAIT_L(0); PG8_BAR; PG8_MMA(1, 0, At, B0); PG8_MMA(1, 1, At, B1); PG8_BAR; PG8_SCHED;
            } else {
            PG8_LDB(B0, 0, 0); PG8_SCHED; PG8_LDA(At, 0, 0); PG8_STAGE(PG8_SA(1, 1), a1 + hstepA, voffA);
            PG8_WAIT_L(8); PG8_BAR; PG8_WAIT_L(0); PG8_MMA(0, 0, At, B0); PG8_BAR; PG8_SCHED;
            PG8_LDB(B1, 0, 1); PG8_STAGE(PG8_SB(0, 0), b2, voffB);
            PG8_BAR; PG8_WAIT_L(0); PG8_MMA(0, 1, At, B1); PG8_BAR;
            PG8_LDA(At, 0, 1); PG8_STAGE(PG8_SA(0, 0), a2, voffA);
            PG8_BAR; PG8_WAIT_L(0); PG8_MMA(1, 0, At, B0); PG8_BAR; PG8_SCHED;
            PG8_STAGE(PG8_SB(0, 1), b2 + hstepB, voffB);
            PG8_WAIT_V(6); PG8_BAR; PG8_MMA(1, 1, At, B1); PG8_BAR;
            PG8_LDB(B0, 1, 0); PG8_SCHED; PG8_LDA(At, 1, 0); PG8_STAGE(PG8_SA(0, 1), a2 + hstepA, voffA);
            PG8_WAIT_L(8); PG8_BAR; PG8_WAIT_L(0); PG8_MMA(0, 0, At, B0); PG8_BAR; PG8_SCHED;
            PG8_LDB(B1, 1, 1); PG8_STAGE(PG8_SB(1, 0), b3, voffB);
            PG8_BAR; PG8_WAIT_L(0); PG8_MMA(0, 1, At, B1); PG8_BAR;
            PG8_LDA(At, 1, 1); PG8_STAGE(PG8_SA(1, 0), a3, voffA);
            PG8_BAR; PG8_WAIT_L(0); PG8_MMA(1, 0, At, B0); PG8_BAR; PG8_SCHED;
            PG8_STAGE(PG8_SB(1, 1), b3 + hstepB, voffB);
            PG8_WAIT_V(6); PG8_BAR; PG8_MMA(1, 1, At, B1); PG8_BAR;
            }
        }
        if constexpr (ALIGN_EPI) { if (wr == 0) PG8_BAR; }
        if constexpr (!Epi::AFTER_DRAIN) { E(acc, cur, wr, wc, fr, fq); S.done(cur); }
        if (!has_next) break;
#pragma unroll
        for (int a = 0; a < 2; ++a)
#pragma unroll
            for (int b = 0; b < 2; ++b)
#pragma unroll
                for (int m = 0; m < 4; ++m)
#pragma unroll
                    for (int n = 0; n < 2; ++n) acc[a][b][m][n] = acc_zero((acc_t*)nullptr);
        cur = nxt; cA = nA; cB = nB; ++ui;
        if constexpr (ALIGN_EPI) { if (wr == 1) PG8_BAR; }
    }
    PG8_WAIT_V(0);
    if constexpr (!ALIGN_EPI) { if (wr == 0) PG8_BAR; }
    PG8_BAR;
    if constexpr (Epi::AFTER_DRAIN) { E.fused(acc, cur, wr, wc, fr, fq, lds, wid, lane); S.done(cur); }
#undef PG8_SA
#undef PG8_SB
#undef PG8_STAGE
#undef PG8_RS
#undef PG8_LDA
#undef PG8_LDB
#undef PG8_MMA
#undef PG8_WAIT_V
#undef PG8_WAIT_L
#undef PG8_BAR
#undef PG8_SCHED
}
}
#define LAS __attribute__((address_space(3)))
#define XB_TMO      128
#define XB_XCNT(j)  (256  + 64 * (j))
#define XB_XSUB(j)  (1280 + 64 * (j))
#define XB_XGEN(j)  (2304 + 64 * (j))
#define XB_TOP      3328
#define XB_TOPGEN   3392
#define XCD_BAR_WORDS 3456
#define XB_SPIN_CAP (1u << 18)

__device__ __forceinline__ unsigned xb_ld(unsigned* p)              { return __hip_atomic_load(p, __ATOMIC_RELAXED, __HIP_MEMORY_SCOPE_AGENT); }
__device__ __forceinline__ unsigned xb_add(unsigned* p, unsigned v) { return __hip_atomic_fetch_add(p, v, __ATOMIC_RELAXED, __HIP_MEMORY_SCOPE_AGENT); }
__device__ __forceinline__ unsigned xb_xcc_id() { return (unsigned)__builtin_amdgcn_s_getreg((3 << 11) | 20) & 0xFu; }
#define XB_SPIN(cond, bar) do { unsigned _sp = 0; while (cond) { __builtin_amdgcn_s_sleep(0); \
    if ((++_sp & 255u) == 0u) { if (xb_ld(&(bar)[XB_TMO])) break; if (_sp > XB_SPIN_CAP) { atomicAdd(&(bar)[XB_TMO], 1u); break; } } } } while (0)

struct XcdBarrier {
    unsigned* bar; unsigned x;
    volatile LAS unsigned* st;
};

__device__ __forceinline__ XcdBarrier xcd_barrier_post(unsigned* bar, volatile LAS unsigned* st) {
    XcdBarrier b; b.bar = bar; b.x = xb_xcc_id(); b.st = st;
    if (threadIdx.x == 0) (void)xb_add(&bar[XB_XCNT(b.x)], 1u);
    return b;
}
__device__ __forceinline__ void xcd_barrier_complete(unsigned* bar, unsigned x, unsigned& nloc, unsigned& nx) {
    const unsigned G = gridDim.x * gridDim.y * gridDim.z;
    unsigned sum, cnt, mine, sp = 0u;
    for (;;) {
        sum = 0u; cnt = 0u; mine = 0u;
#pragma unroll
        for (unsigned j = 0; j < 16; ++j) { const unsigned c = xb_ld(&bar[XB_XCNT(j)]); sum += c; cnt += (c > 0u) ? 1u : 0u; mine = (j == x) ? c : mine; }
        if (sum == G) break;
        __builtin_amdgcn_s_sleep(1);
        if ((++sp & 255u) == 0u) { if (xb_ld(&bar[XB_TMO])) break; if (sp > XB_SPIN_CAP) { atomicAdd(&bar[XB_TMO], 1u); break; } }
    }
    nloc = mine > 0u ? mine : 1u; nx = cnt > 0u ? cnt : 1u;
}

__device__ __forceinline__ void xcd_barrier(const XcdBarrier& b) {
    asm volatile("s_waitcnt vmcnt(0)" ::: "memory");
    __syncthreads();
    if (threadIdx.x == 0) {
        unsigned* bar = b.bar;
        __builtin_amdgcn_s_waitcnt(0);
        unsigned nloc = b.st[0], nx = b.st[1];
        if (nloc == 0u) { xcd_barrier_complete(bar, b.x, nloc, nx); b.st[0] = nloc; b.st[1] = nx; }
        const unsigned old = xb_add(&bar[XB_XSUB(b.x)], 1u);
        const unsigned gen = old / nloc;
        if (old + 1u == (gen + 1u) * nloc) {
            __builtin_amdgcn_fence(__ATOMIC_RELEASE, "agent");
            asm volatile("s_waitcnt vmcnt(0)" ::: "memory");
            const unsigned og = xb_add(&bar[XB_TOP], 1u);
            const unsigned tg = og / nx;
            if (og + 1u == (tg + 1u) * nx) xb_add(&bar[XB_TOPGEN], 1u);
            else XB_SPIN(xb_ld(&bar[XB_TOPGEN]) == tg, bar);
            __builtin_amdgcn_fence(__ATOMIC_ACQUIRE, "agent");
            xb_add(&bar[XB_XGEN(b.x)], 1u);
            asm volatile("s_waitcnt vmcnt(0)" ::: "memory");
        } else {
            XB_SPIN(xb_ld(&bar[XB_XGEN(b.x)]) == gen, bar);
            __builtin_amdgcn_fence(__ATOMIC_ACQUIRE, "agent");
            asm volatile("s_waitcnt vmcnt(0)" ::: "memory");
        }
    }
    __syncthreads();
}
#define GAS __attribute__((address_space(1)))
typedef unsigned short bf16;
typedef unsigned u32x4 __attribute__((ext_vector_type(4)));
typedef unsigned u32x2 __attribute__((ext_vector_type(2)));
typedef float f32x4 __attribute__((ext_vector_type(4)));
typedef float f32x16 __attribute__((ext_vector_type(16)));
typedef short bf16x8 __attribute__((ext_vector_type(8)));
typedef int i32x4 __attribute__((ext_vector_type(4)));
#define LDS_WAIT() asm volatile("s_waitcnt lgkmcnt(0)" ::: "memory")
__device__ __forceinline__ float xor32_sum(float x) { const auto r = __builtin_amdgcn_permlane32_swap(__float_as_uint(x), __float_as_uint(x), false, false); return __uint_as_float(r[0]) + __uint_as_float(r[1]); }
__device__ __forceinline__ float xor32_max(float x) { const auto r = __builtin_amdgcn_permlane32_swap(__float_as_uint(x), __float_as_uint(x), false, false); return fmaxf(__uint_as_float(r[0]), __uint_as_float(r[1])); }
__device__ __forceinline__ float xor16_sum(float x) { const auto r = __builtin_amdgcn_permlane16_swap(__float_as_uint(x), __float_as_uint(x), false, false); return __uint_as_float(r[0]) + __uint_as_float(r[1]); }

constexpr int NWAVES = 8;
constexpr int NB = 16, SEQ = 2048, M = NB * SEQ, DM = 1024, DEPTH = 4, DIN = 3428, NIN = 3584, DFF = 4096;
constexpr int TOPK = 256;
constexpr float EPS = 1e-6f;
constexpr float LOG2E = 1.4426950408889634f;
constexpr float C2A = 0.125f * LOG2E;
constexpr float C2B = 0.10206207261596575f * LOG2E;
#ifndef MK_ONE_LAUNCH
#define MK_ONE_LAUNCH 1
#endif
constexpr int PH_PER_LAYER = 9, N_PHASES = DEPTH * PH_PER_LAYER + 1;

constexpr size_t MiB = 1u << 20;
constexpr size_t WS_CTL = 0, CTL_ZERO_BYTES = 64 * 1024;
constexpr int CW_BAR = 1024;
constexpr size_t WS_CS = 1 * MiB;
constexpr size_t WS_SSQQ = 5 * MiB, WS_SSQKV = 5 * MiB + 512 * 1024;
constexpr size_t WS_IW = 6 * MiB;
constexpr size_t WS_PTAB = 7 * MiB;
constexpr size_t WS_W = 8 * MiB;
constexpr size_t W_IN_OFF = 0, W_UQ_OFF = (size_t)NIN * 1024, W_UK_OFF = W_UQ_OFF + 768 * 256, W_UV_OFF = W_UK_OFF + 512 * 128, W_AB_OFF = W_UV_OFF + 512 * 128,
                 W_OUT_OFF = W_AB_OFF + 2048 * 512, W_FF1_OFF = W_OUT_OFF + 1024 * 1024, W_FF2_OFF = W_FF1_OFF + 4096 * 1024, W_END_OFF = W_FF2_OFF + 4096 * 1024;
static_assert(W_END_OFF * 2 <= 28 * MiB, "weight copies");
constexpr size_t WS_H = 36 * MiB;
constexpr size_t WS_YA = 100 * MiB, WS_YB = 132 * MiB;
constexpr size_t WS_IQ = 164 * MiB, WS_CQ = 180 * MiB, WS_CKV = 196 * MiB, WS_AK = 204 * MiB, WS_AVT = 208 * MiB, WS_IK = 212 * MiB, WS_KR = 216 * MiB;
constexpr size_t WS_RSS = 468 * MiB;
constexpr size_t WS_MASK = 220 * MiB;
constexpr size_t WS_GATES = 228 * MiB;
constexpr size_t WS_QB = 356 * MiB, WS_KN = 404 * MiB, WS_VT = 436 * MiB, WS_END = 470 * MiB;
constexpr size_t WS_RMAX = 468 * MiB + 512 * 1024;
constexpr size_t WS_SX = 468 * MiB + 768 * 1024;
constexpr size_t WS_SWF = 468 * MiB + 896 * 1024;
constexpr size_t WS_SWI = 468 * MiB + 960 * 1024;
constexpr size_t WS_XB8 = 356 * MiB;
constexpr size_t WS_MERGED = 356 * MiB;
constexpr size_t WS_HID = 100 * MiB;
static_assert(WS_YB == WS_YA + (size_t)M * 512 * 2 && WS_HID + (size_t)M * DFF * 2 <= WS_MERGED && WS_MERGED + (size_t)M * DM * 2 <= WS_VT, "d_ws map");

constexpr int RING_BYTES = 131072;
constexpr int MISC_OFF = 143360;
constexpr int LDS_BYTES = 147456;

struct Frame {
    LAS unsigned char* lds;
    int tid, lane, wave, G, bx;
    const float* x; const int* pos; const float* rel_bias; float* out;
    unsigned char* ws;
};

namespace pg8 {
typedef unsigned u32x2v __attribute__((ext_vector_type(2)));
__device__ __forceinline__ u32x4 pack8(const f32x4 a, const f32x4 b) { u32x4 w; w.x = cvt_pk_bf16(a[0], a[1]); w.y = cvt_pk_bf16(a[2], a[3]); w.z = cvt_pk_bf16(b[0], b[1]); w.w = cvt_pk_bf16(b[2], b[3]); return w; }
__device__ __forceinline__ f32x4 cvtf(const i32x4 a) { return __builtin_convertvector(a, f32x4); }
__device__ __forceinline__ float amax4(const f32x4 a) { return fmaxf(fmaxf(fabsf(a[0]), fabsf(a[1])), fmaxf(fabsf(a[2]), fabsf(a[3]))); }
__device__ __forceinline__ float ssq8(const f32x4 a, const f32x4 b) { return (a[0] * a[0] + a[1] * a[1]) + (a[2] * a[2] + a[3] * a[3]) + (b[0] * b[0] + b[1] * b[1]) + (b[2] * b[2] + b[3] * b[3]); }
__device__ __forceinline__ void unpack8(const u32x4 w, f32x4& a, f32x4& b) {
    a[0] = __uint_as_float(w.x << 16); a[1] = __uint_as_float(w.x & 0xffff0000u); a[2] = __uint_as_float(w.y << 16); a[3] = __uint_as_float(w.y & 0xffff0000u);
    b[0] = __uint_as_float(w.z << 16); b[1] = __uint_as_float(w.z & 0xffff0000u); b[2] = __uint_as_float(w.w << 16); b[3] = __uint_as_float(w.w & 0xffff0000u); }

__device__ __forceinline__ unsigned q8x4(const f32x4 v, float sx) {
    int q[4];
#pragma unroll
    for (int e = 0; e < 4; ++e) { q[e] = (int)__builtin_rintf(v[e] * sx); q[e] = min(max(q[e], -127), 127) & 255; }
    return (unsigned)q[0] | ((unsigned)q[1] << 8) | ((unsigned)q[2] << 16) | ((unsigned)q[3] << 24);
}
__device__ __forceinline__ unsigned pku8(const f32x4 v) {
    const unsigned q0 = (unsigned)(v[0] + 0.5f), q1 = (unsigned)(v[1] + 0.5f), q2 = (unsigned)(v[2] + 0.5f), q3 = (unsigned)(v[3] + 0.5f);
    return q0 | (q1 << 8) | (q2 << 16) | (q3 << 24);
}
__device__ __forceinline__ void unpack_u8(const u32x2v w, f32x4& a, f32x4& b) {
    a[0] = (float)(w.x & 255u); a[1] = (float)((w.x >> 8) & 255u); a[2] = (float)((w.x >> 16) & 255u); a[3] = (float)(w.x >> 24);
    b[0] = (float)(w.y & 255u); b[1] = (float)((w.y >> 8) & 255u); b[2] = (float)((w.y >> 16) & 255u); b[3] = (float)(w.y >> 24); }
__device__ __forceinline__ float row_rstd(const unsigned long long* RS, int row) {
    const unsigned long long v = RS[row];
    const float t = (float)v * (1.f / 4294967296.f);
    return __builtin_amdgcn_rsqf(t * (1.f / 1024.f) + EPS);
}
struct EpiIn {
    static constexpr bool PERM = true, AFTER_DRAIN = false; typedef f32x4 acc_t;
    bf16_t *AQ, *IQ, *CQ, *CKV, *AK, *AVT, *IK, *KR, *GATES; float *IW, *SSQQ, *SSQKV; const float *CS, *bgate; const unsigned long long* RSS;
    __device__ __forceinline__ void operator()(const f32x4 (&acc)[2][2][4][2], const Unit& u, int wr, int wc, int fr, int fq) const {
        asm volatile("" : "+v"(fr), "+v"(fq));
        const int pn = u.pn; const int row0 = u.pm * BM + wr * 64 + fr; const int cw = wc * 32 + 8 * fq;
        float rsv[2][4];
#pragma unroll
        for (int ai = 0; ai < 2; ++ai)
#pragma unroll
            for (int m = 0; m < 4; ++m) rsv[ai][m] = row_rstd(RSS, row0 + ai * HALF + m * 16);
        if (pn < 4) {
            bf16_t* base; int ld; float sc;
            if (pn < 2) { base = AQ + pn * 256; ld = 512; sc = C2A; } else if (pn == 2) { base = IQ; ld = 256; sc = 1.f; } else { base = CQ; ld = 256; sc = 1.f; }
#pragma unroll
            for (int ai = 0; ai < 2; ++ai)
#pragma unroll
                for (int m = 0; m < 4; ++m) { const int row = row0 + ai * HALF + m * 16; float ss = 0.f; const float rs = rsv[ai][m] * sc;
#pragma unroll
                    for (int bj = 0; bj < 2; ++bj) { const f32x4 v0 = acc[ai][bj][m][0] * rs, v1 = acc[ai][bj][m][1] * rs;
                        *(u32x4*)(base + (size_t)row * ld + bj * HALF + cw) = pack8(v0, v1); ss += ssq8(v0, v1); }
                    if (pn == 3) { ss = xor16_sum(ss); ss = xor32_sum(ss); if (fq == 0) SSQQ[(size_t)row * 4 + wc] = ss; } }
        } else if (pn == 4) {
#pragma unroll
            for (int ai = 0; ai < 2; ++ai)
#pragma unroll
                for (int m = 0; m < 4; ++m) { const int row = row0 + ai * HALF + m * 16; const float rs = rsv[ai][m];
                    { const f32x4 v0 = acc[ai][0][m][0] * rs, v1 = acc[ai][0][m][1] * rs; *(u32x4*)(CKV + (size_t)row * 128 + cw) = pack8(v0, v1);
                      float ss = ssq8(v0, v1); ss = xor16_sum(ss); ss = xor32_sum(ss); if (fq == 0) SSQKV[(size_t)row * 4 + wc] = ss; }
                    { const f32x4 v0 = acc[ai][1][m][0] * rs, v1 = acc[ai][1][m][1] * rs; const u32x4 w = pack8(v0, v1);
                      if (wc < 2) *(u32x4*)(AK + (size_t)row * 64 + cw) = w;
                      else { bf16_t* vt = AVT + ((size_t)(row >> 11) * 64 + (cw - 64)) * SEQ + (row & (SEQ - 1));
                             vt[0 * SEQ] = (bf16_t)(w.x & 0xffffu); vt[1 * SEQ] = (bf16_t)(w.x >> 16); vt[2 * SEQ] = (bf16_t)(w.y & 0xffffu); vt[3 * SEQ] = (bf16_t)(w.y >> 16);
                             vt[4 * SEQ] = (bf16_t)(w.z & 0xffffu); vt[5 * SEQ] = (bf16_t)(w.z >> 16); vt[6 * SEQ] = (bf16_t)(w.w & 0xffffu); vt[7 * SEQ] = (bf16_t)(w.w >> 16); }
#if defined(DBG_THROTTLE)
                      asm volatile("s_waitcnt vmcnt(8)" ::: "memory");
#endif
                    } }
        } else if (pn == 5) {
#pragma unroll
            for (int ai = 0; ai < 2; ++ai)
#pragma unroll
                for (int m = 0; m < 4; ++m) { const int row = row0 + ai * HALF + m * 16; const float rs = rsv[ai][m]; const f32x4 v0 = acc[ai][0][m][0] * rs, v1 = acc[ai][0][m][1] * rs;
                    if (wc < 2) *(u32x4*)(IK + (size_t)row * 64 + cw) = pack8(v0, v1);
                    else if (wc == 2) { const f32x4 c4 = *(const f32x4*)(CS + (size_t)row * 32 + 4 * fq), s4 = *(const f32x4*)(CS + (size_t)row * 32 + 16 + 4 * fq);
                        f32x4 o0, o1; o0[0] = v0[0] * c4[0] - v0[1] * s4[0]; o0[1] = v0[0] * s4[0] + v0[1] * c4[0]; o0[2] = v0[2] * c4[1] - v0[3] * s4[1]; o0[3] = v0[2] * s4[1] + v0[3] * c4[1];
                        o1[0] = v1[0] * c4[2] - v1[1] * s4[2]; o1[1] = v1[0] * s4[2] + v1[1] * c4[2]; o1[2] = v1[2] * c4[3] - v1[3] * s4[3]; o1[3] = v1[2] * s4[3] + v1[3] * c4[3];
                        *(u32x4*)(KR + (size_t)row * 32 + 8 * fq) = pack8(o0, o1); }
                    else if (fq == 0) *(f32x4*)(IW + (size_t)row * 4) = v0; }
        } else {
            const int cg0 = (pn - 6) * 256 + cw;
            f32x4 bv[2][2];
#pragma unroll
            for (int bj = 0; bj < 2; ++bj) { bv[bj][0] = *(const f32x4*)(bgate + cg0 + bj * HALF); bv[bj][1] = *(const f32x4*)(bgate + cg0 + bj * HALF + 4); }
#pragma unroll
            for (int ai = 0; ai < 2; ++ai)
#pragma unroll
                for (int m = 0; m < 4; ++m) { const int row = row0 + ai * HALF + m * 16; const float rs = rsv[ai][m];
#pragma unroll
                    for (int bj = 0; bj < 2; ++bj) { f32x4 v0 = acc[ai][bj][m][0] * rs + bv[bj][0], v1 = acc[ai][bj][m][1] * rs + bv[bj][1];
#pragma unroll
                        for (int e = 0; e < 4; ++e) { v0[e] = __builtin_amdgcn_rcpf(1.f + __builtin_amdgcn_exp2f(-LOG2E * v0[e])); v1[e] = __builtin_amdgcn_rcpf(1.f + __builtin_amdgcn_exp2f(-LOG2E * v1[e])); }
                        __builtin_nontemporal_store(pack8(v0, v1), (u32x4*)(GATES + (size_t)row * 2048 + cg0 + bj * HALF)); } }
        }
    }
};
struct EpiIn8 {
    static constexpr bool PERM = true, AFTER_DRAIN = false; typedef i32x4 acc_t;
    bf16_t *AQ, *IQ, *CQ, *CKV, *AK, *AVT, *IK, *KR, *GATES; float *IW, *SSQQ, *SSQKV; const float *CS, *bgate, *SX, *SWI;
    __device__ __forceinline__ void operator()(const i32x4 (&acc)[2][2][4][2], const Unit& u, int wr, int wc, int fr, int fq) const {
        asm volatile("" : "+v"(fr), "+v"(fq));
        const int pn = u.pn; const int row0 = u.pm * BM + wr * 64 + fr; const int cw = wc * 32 + 8 * fq;
        float rsv[2][4];
#pragma unroll
        for (int ai = 0; ai < 2; ++ai)
#pragma unroll
            for (int m = 0; m < 4; ++m) rsv[ai][m] = SX[row0 + ai * HALF + m * 16];
        f32x4 sw[2][2];
#pragma unroll
        for (int bj = 0; bj < 2; ++bj) { sw[bj][0] = *(const f32x4*)(SWI + pn * BM + bj * HALF + cw); sw[bj][1] = *(const f32x4*)(SWI + pn * BM + bj * HALF + cw + 4); }
        if (pn < 4) {
            bf16_t* base; int ld; float sc;
            if (pn < 2) { base = AQ + pn * 256; ld = 512; sc = C2A; } else if (pn == 2) { base = IQ; ld = 256; sc = 1.f; } else { base = CQ; ld = 256; sc = 1.f; }
#pragma unroll
            for (int ai = 0; ai < 2; ++ai)
#pragma unroll
                for (int m = 0; m < 4; ++m) { const int row = row0 + ai * HALF + m * 16; float ss = 0.f; const float rs = rsv[ai][m] * sc;
#pragma unroll
                    for (int bj = 0; bj < 2; ++bj) { const f32x4 v0 = (cvtf(acc[ai][bj][m][0]) * sw[bj][0]) * rs, v1 = (cvtf(acc[ai][bj][m][1]) * sw[bj][1]) * rs;
                        *(u32x4*)(base + (size_t)row * ld + bj * HALF + cw) = pack8(v0, v1); ss += ssq8(v0, v1); }
                    if (pn == 3) { ss = xor16_sum(ss); ss = xor32_sum(ss); if (fq == 0) SSQQ[(size_t)row * 4 + wc] = ss; } }
        } else if (pn == 4) {
#pragma unroll
            for (int ai = 0; ai < 2; ++ai)
#pragma unroll
                for (int m = 0; m < 4; ++m) { const int row = row0 + ai * HALF + m * 16; const float rs = rsv[ai][m];
                    { const f32x4 v0 = (cvtf(acc[ai][0][m][0]) * sw[0][0]) * rs, v1 = (cvtf(acc[ai][0][m][1]) * sw[0][1]) * rs; *(u32x4*)(CKV + (size_t)row * 128 + cw) = pack8(v0, v1);
                      float ss = ssq8(v0, v1); ss = xor16_sum(ss); ss = xor32_sum(ss); if (fq == 0) SSQKV[(size_t)row * 4 + wc] = ss; }
                    { const f32x4 v0 = (cvtf(acc[ai][1][m][0]) * sw[1][0]) * rs, v1 = (cvtf(acc[ai][1][m][1]) * sw[1][1]) * rs; const u32x4 w = pack8(v0, v1);
                      if (wc < 2) *(u32x4*)(AK + (size_t)row * 64 + cw) = w;
                      else { bf16_t* vt = AVT + ((size_t)(row >> 11) * 64 + (cw - 64)) * SEQ + (row & (SEQ - 1));
                             vt[0 * SEQ] = (bf16_t)(w.x & 0xffffu); vt[1 * SEQ] = (bf16_t)(w.x >> 16); vt[2 * SEQ] = (bf16_t)(w.y & 0xffffu); vt[3 * SEQ] = (bf16_t)(w.y >> 16);
                             vt[4 * SEQ] = (bf16_t)(w.z & 0xffffu); vt[5 * SEQ] = (bf16_t)(w.z >> 16); vt[6 * SEQ] = (bf16_t)(w.w & 0xffffu); vt[7 * SEQ] = (bf16_t)(w.w >> 16); }
#if defined(DBG_THROTTLE)
                      asm volatile("s_waitcnt vmcnt(8)" ::: "memory");
#endif
                    } }
        } else if (pn == 5) {
#pragma unroll
            for (int ai = 0; ai < 2; ++ai)
#pragma unroll
                for (int m = 0; m < 4; ++m) { const int row = row0 + ai * HALF + m * 16; const float rs = rsv[ai][m]; const f32x4 v0 = (cvtf(acc[ai][0][m][0]) * sw[0][0]) * rs, v1 = (cvtf(acc[ai][0][m][1]) * sw[0][1]) * rs;
                    if (wc < 2) *(u32x4*)(IK + (size_t)row * 64 + cw) = pack8(v0, v1);
                    else if (wc == 2) { const f32x4 c4 = *(const f32x4*)(CS + (size_t)row * 32 + 4 * fq), s4 = *(const f32x4*)(CS + (size_t)row * 32 + 16 + 4 * fq);
                        f32x4 o0, o1; o0[0] = v0[0] * c4[0] - v0[1] * s4[0]; o0[1] = v0[0] * s4[0] + v0[1] * c4[0]; o0[2] = v0[2] * c4[1] - v0[3] * s4[1]; o0[3] = v0[2] * s4[1] + v0[3] * c4[1];
                        o1[0] = v1[0] * c4[2] - v1[1] * s4[2]; o1[1] = v1[0] * s4[2] + v1[1] * c4[2]; o1[2] = v1[2] * c4[3] - v1[3] * s4[3]; o1[3] = v1[2] * s4[3] + v1[3] * c4[3];
                        *(u32x4*)(KR + (size_t)row * 32 + 8 * fq) = pack8(o0, o1); }
                    else if (fq == 0) *(f32x4*)(IW + (size_t)row * 4) = v0; }
        } else {
            const int cg0 = (pn - 6) * 256 + cw;
            f32x4 bv[2][2];
#pragma unroll
            for (int bj = 0; bj < 2; ++bj) { bv[bj][0] = *(const f32x4*)(bgate + cg0 + bj * HALF); bv[bj][1] = *(const f32x4*)(bgate + cg0 + bj * HALF + 4); }
#pragma unroll
            for (int ai = 0; ai < 2; ++ai)
#pragma unroll
                for (int m = 0; m < 4; ++m) { const int row = row0 + ai * HALF + m * 16; const float rs = rsv[ai][m];
#pragma unroll
                    for (int bj = 0; bj < 2; ++bj) { f32x4 v0 = (cvtf(acc[ai][bj][m][0]) * sw[bj][0]) * rs + bv[bj][0], v1 = (cvtf(acc[ai][bj][m][1]) * sw[bj][1]) * rs + bv[bj][1];
#pragma unroll
                        for (int e = 0; e < 4; ++e) { v0[e] = __builtin_amdgcn_rcpf(__builtin_fmaf(__builtin_amdgcn_exp2f(-LOG2E * v0[e]), 1.f / 255.f, 1.f / 255.f)); v1[e] = __builtin_amdgcn_rcpf(__builtin_fmaf(__builtin_amdgcn_exp2f(-LOG2E * v1[e]), 1.f / 255.f, 1.f / 255.f)); }
                        u32x2v w8; w8.x = pku8(v0); w8.y = pku8(v1);
                        __builtin_nontemporal_store(w8, (u32x2v*)((unsigned char*)GATES + (size_t)row * 2048 + cg0 + bj * HALF)); } }
        }
    }
};
struct EpiUQ {
    static constexpr bool PERM = true, AFTER_DRAIN = false; typedef f32x4 acc_t;
    bf16_t* QB; const float *SSQQ, *CS;
    __device__ __forceinline__ void operator()(const f32x4 (&acc)[2][2][4][2], const Unit& u, int wr, int wc, int fr, int fq) const {
        asm volatile("" : "+v"(fr), "+v"(fq));
        const int row0 = u.pm * BM + wr * 64 + fr; const int cw = wc * 32 + 8 * fq;
#pragma unroll
        for (int ai = 0; ai < 2; ++ai)
#pragma unroll
            for (int m = 0; m < 4; ++m) { const int row = row0 + ai * HALF + m * 16; const f32x4 sq = *(const f32x4*)(SSQQ + (size_t)row * 4);
                const float rs = __builtin_amdgcn_rsqf(((sq[0] + sq[1]) + (sq[2] + sq[3])) * (1.f / 256.f) + EPS) * C2B;
#pragma unroll
                for (int bj = 0; bj < 2; ++bj) { const int col0 = u.pn * BM + bj * HALF + cw; const int cm = col0 % 96;
                    f32x4 v0 = acc[ai][bj][m][0] * rs, v1 = acc[ai][bj][m][1] * rs;
                    if (cm >= 64) { const int i0 = (cm - 64) >> 1; const f32x4 c4 = *(const f32x4*)(CS + (size_t)row * 32 + i0), s4 = *(const f32x4*)(CS + (size_t)row * 32 + 16 + i0);
                        f32x4 o0, o1; o0[0] = v0[0] * c4[0] - v0[1] * s4[0]; o0[1] = v0[0] * s4[0] + v0[1] * c4[0]; o0[2] = v0[2] * c4[1] - v0[3] * s4[1]; o0[3] = v0[2] * s4[1] + v0[3] * c4[1];
                        o1[0] = v1[0] * c4[2] - v1[1] * s4[2]; o1[1] = v1[0] * s4[2] + v1[1] * c4[2]; o1[2] = v1[2] * c4[3] - v1[3] * s4[3]; o1[3] = v1[2] * s4[3] + v1[3] * c4[3];
                        v0 = o0; v1 = o1; }
                    *(u32x4*)(QB + (size_t)row * 768 + col0) = pack8(v0, v1); } }
    }
};
struct EpiUK {
    static constexpr bool PERM = true, AFTER_DRAIN = false; typedef f32x4 acc_t;
    bf16_t* KN; const float* SSQKV;
    __device__ __forceinline__ void operator()(const f32x4 (&acc)[2][2][4][2], const Unit& u, int wr, int wc, int fr, int fq) const {
        asm volatile("" : "+v"(fr), "+v"(fq));
        const int row0 = u.pm * BM + wr * 64 + fr; const int cw = wc * 32 + 8 * fq;
#pragma unroll
        for (int ai = 0; ai < 2; ++ai)
#pragma unroll
            for (int m = 0; m < 4; ++m) { const int row = row0 + ai * HALF + m * 16; const f32x4 sq = *(const f32x4*)(SSQKV + (size_t)row * 4);
                const float rs = __builtin_amdgcn_rsqf(((sq[0] + sq[1]) + (sq[2] + sq[3])) * (1.f / 128.f) + EPS);
#pragma unroll
                for (int bj = 0; bj < 2; ++bj) *(u32x4*)(KN + (size_t)row * 512 + u.pn * BM + bj * HALF + cw) = pack8(acc[ai][bj][m][0] * rs, acc[ai][bj][m][1] * rs); }
    }
};
struct EpiUV {
    static constexpr bool PERM = true, AFTER_DRAIN = false; typedef f32x4 acc_t;
    bf16_t* VT; const float* SSQKV;
    __device__ __forceinline__ void operator()(const f32x4 (&acc)[2][2][4][2], const Unit& u, int wr, int wc, int fr, int fq) const {
        asm volatile("" : "+v"(fr), "+v"(fq));
        const int row0 = u.pm * BM + wr * 64 + fr; const int cw = wc * 32 + 8 * fq;
        f32x4 r0[2], r1[2];
#pragma unroll
        for (int bj = 0; bj < 2; ++bj) { const int c0 = u.pn * BM + bj * HALF + cw;
#pragma unroll
            for (int e = 0; e < 8; ++e) { const f32x4 sq = *(const f32x4*)(SSQKV + (size_t)(c0 + e) * 4); const float rs = __builtin_amdgcn_rsqf(((sq[0] + sq[1]) + (sq[2] + sq[3])) * (1.f / 128.f) + EPS);
                if (e < 4) r0[bj][e] = rs; else r1[bj][e - 4] = rs; } }
#pragma unroll
        for (int ai = 0; ai < 2; ++ai)
#pragma unroll
            for (int m = 0; m < 4; ++m) { const int row = row0 + ai * HALF + m * 16;
#pragma unroll
                for (int bj = 0; bj < 2; ++bj) *(u32x4*)(VT + (size_t)row * M + u.pn * BM + bj * HALF + cw) = pack8(acc[ai][bj][m][0] * r0[bj], acc[ai][bj][m][1] * r1[bj]); }
    }
};
#ifndef DBG_BR_A
#define DBG_BR_A 1
#define DBG_BR_B 1
#endif
struct EpiBranch {
    static constexpr bool PERM = true, AFTER_DRAIN = false; typedef f32x4 acc_t;
    bf16_t* MERGED; const bf16_t* GATES;
    __device__ __forceinline__ void operator()(const f32x4 (&acc)[2][2][4][2], const Unit& u, int wr, int wc, int fr, int fq) const {
        asm volatile("" : "+v"(fr), "+v"(fq));
        const int br = u.pn >> 2, pn = u.pn & 3, pm = u.pm & 127;
        const int row0 = pm * BM + wr * 64 + fr; const int cw = pn * BM + wc * 32 + 8 * fq;
#pragma unroll
        for (int ai = 0; ai < 2; ++ai) {
            u32x2v gw[4][2]; u32x4 pw[4][2];
#pragma unroll
            for (int m = 0; m < 4; ++m)
#pragma unroll
                for (int bj = 0; bj < 2; ++bj) { const int row = row0 + ai * HALF + m * 16;
                    gw[m][bj] = *(const u32x2v*)((const unsigned char*)GATES + (size_t)row * 2048 + br * 1024 + bj * HALF + cw);
                    pw[m][bj] = br ? *(const u32x4*)(MERGED + (size_t)row * 1024 + bj * HALF + cw) : (u32x4){0u, 0u, 0u, 0u}; }
#pragma unroll
            for (int m = 0; m < 4; ++m)
#pragma unroll
                for (int bj = 0; bj < 2; ++bj) { const int row = row0 + ai * HALF + m * 16;
                    f32x4 g0, g1, p0, p1; unpack_u8(gw[m][bj], g0, g1); unpack8(pw[m][bj], p0, p1);
                    const float on_ = (br ? (float)(DBG_BR_B) : (float)(DBG_BR_A)) * (1.f / 255.f);
                    const f32x4 v0 = acc[ai][bj][m][0] * g0 * on_ + p0, v1 = acc[ai][bj][m][1] * g1 * on_ + p1;
                    *(u32x4*)(MERGED + (size_t)row * 1024 + bj * HALF + cw) = pack8(v0, v1); }
        }
    }
};
template <bool RMX> struct EpiResT {
    static constexpr bool PERM = true, AFTER_DRAIN = false; typedef f32x4 acc_t;
    bf16_t* XB; unsigned long long* RSS; unsigned* RMAX;
    __device__ __forceinline__ void operator()(const f32x4 (&acc)[2][2][4][2], const Unit& u, int wr, int wc, int fr, int fq) const {
        asm volatile("" : "+v"(fr), "+v"(fq));
        const int row0 = u.pm * BM + wr * 64 + fr; const int cw = u.pn * BM + wc * 32 + 8 * fq;
#pragma unroll
        for (int ai = 0; ai < 2; ++ai) {
            u32x4 bs[4][2];
#pragma unroll
            for (int m = 0; m < 4; ++m)
#pragma unroll
                for (int bj = 0; bj < 2; ++bj) bs[m][bj] = *(const u32x4*)(XB + (size_t)(row0 + ai * HALF + m * 16) * DM + bj * HALF + cw);
#pragma unroll
            for (int m = 0; m < 4; ++m) { const int row = row0 + ai * HALF + m * 16; float ss = 0.f, mx = 0.f;
#pragma unroll
                for (int bj = 0; bj < 2; ++bj) { f32x4 b0, b1; unpack8(bs[m][bj], b0, b1);
                    const f32x4 o0 = b0 + acc[ai][bj][m][0], o1 = b1 + acc[ai][bj][m][1];
                    ss += ssq8(o0, o1); *(u32x4*)(XB + (size_t)row * DM + bj * HALF + cw) = pack8(o0, o1);
                    if (RMX) mx = fmaxf(fmaxf(mx, amax4(o0)), amax4(o1)); }
                ss += __shfl_xor(ss, 16); ss += __shfl_xor(ss, 32);
                if (RMX) { mx = fmaxf(mx, __shfl_xor(mx, 16)); mx = fmaxf(mx, __shfl_xor(mx, 32)); }
                if (fq == 0) (void)__hip_atomic_fetch_add(RSS + row, (unsigned long long)(ss * 4294967296.f), __ATOMIC_RELAXED, __HIP_MEMORY_SCOPE_AGENT);
                if (RMX && fq == 0) (void)__hip_atomic_fetch_max(RMAX + row, __builtin_bit_cast(unsigned, mx), __ATOMIC_RELAXED, __HIP_MEMORY_SCOPE_AGENT); }
        }
    }
};
struct EpiFF1 {
    static constexpr bool PERM = true, AFTER_DRAIN = false; typedef f32x4 acc_t;
    bf16_t* HID; const unsigned long long* RSS;
    __device__ __forceinline__ void operator()(const f32x4 (&acc)[2][2][4][2], const Unit& u, int wr, int wc, int fr, int fq) const {
        asm volatile("" : "+v"(fr), "+v"(fq));
        const int row0 = u.pm * BM + wr * 64 + fr; const int cw = wc * 32 + 8 * fq;
        float rsv[2][4];
#pragma unroll
        for (int ai = 0; ai < 2; ++ai)
#pragma unroll
            for (int m = 0; m < 4; ++m) rsv[ai][m] = row_rstd(RSS, row0 + ai * HALF + m * 16);
#pragma unroll
        for (int ai = 0; ai < 2; ++ai)
#pragma unroll
            for (int m = 0; m < 4; ++m) { const int row = row0 + ai * HALF + m * 16; const float rs = rsv[ai][m];
#pragma unroll
                for (int bj = 0; bj < 2; ++bj) { f32x4 v0 = acc[ai][bj][m][0] * rs, v1 = acc[ai][bj][m][1] * rs;
#pragma unroll
                    for (int e = 0; e < 4; ++e) { const float a = fmaxf(v0[e], 0.f), b = fmaxf(v1[e], 0.f); v0[e] = a * a; v1[e] = b * b; }
                    __builtin_nontemporal_store(pack8(v0, v1), (u32x4*)(HID + (size_t)u.pm * (BM * DFF) + (size_t)(u.pn * 4 + bj * 2 + (wc >> 1)) * (BM * BK) + (size_t)(row - u.pm * BM) * BK + (wc & 1) * 32 + 8 * fq)); } }
    }
};
struct EpiFF18 {
    static constexpr bool PERM = true, AFTER_DRAIN = false; typedef i32x4 acc_t;
    bf16_t* HID; const float *SX, *SWF;
    __device__ __forceinline__ void operator()(const i32x4 (&acc)[2][2][4][2], const Unit& u, int wr, int wc, int fr, int fq) const {
        asm volatile("" : "+v"(fr), "+v"(fq));
        const int row0 = u.pm * BM + wr * 64 + fr; const int cw = wc * 32 + 8 * fq;
        float rsv[2][4]; f32x4 sw[2][2];
#pragma unroll
        for (int ai = 0; ai < 2; ++ai)
#pragma unroll
            for (int m = 0; m < 4; ++m) rsv[ai][m] = SX[row0 + ai * HALF + m * 16];
#pragma unroll
        for (int bj = 0; bj < 2; ++bj) { sw[bj][0] = *(const f32x4*)(SWF + u.pn * BM + bj * HALF + cw); sw[bj][1] = *(const f32x4*)(SWF + u.pn * BM + bj * HALF + cw + 4); }
#pragma unroll
        for (int ai = 0; ai < 2; ++ai)
#pragma unroll
            for (int m = 0; m < 4; ++m) { const int row = row0 + ai * HALF + m * 16; const float rs = rsv[ai][m];
#pragma unroll
                for (int bj = 0; bj < 2; ++bj) { f32x4 v0, v1;
#pragma unroll
                    for (int e = 0; e < 4; ++e) { const float a = fmaxf((float)acc[ai][bj][m][0][e] * (rs * sw[bj][0][e]), 0.f), b = fmaxf((float)acc[ai][bj][m][1][e] * (rs * sw[bj][1][e]), 0.f); v0[e] = a * a; v1[e] = b * b; }
                    __builtin_nontemporal_store(pack8(v0, v1), (u32x4*)(HID + (size_t)u.pm * (BM * DFF) + (size_t)(u.pn * 4 + bj * 2 + (wc >> 1)) * (BM * BK) + (size_t)(row - u.pm * BM) * BK + (wc & 1) * 32 + 8 * fq)); } }
    }
};
struct BranchOrder {
    StaticOrder so; int brsel;
    __device__ void init(int G, int c, int brsel_ = -1) { so.init(M, DM, G, c); brsel = brsel_; }
    __device__ bool next(int i, Unit& u) const { Unit b; if (brsel >= 0) { if (!so.next(i, b)) return false; u.pm = b.pm + 128 * brsel; u.pn = b.pn + 4 * brsel; return true; }
        if (!so.next(i >> 1, b)) return false; const int br = i & 1; u.pm = b.pm + 128 * br; u.pn = b.pn + 4 * br; return true; }
    __device__ __forceinline__ void a_ready(const Unit&) const {}
    __device__ __forceinline__ void done(const Unit&) const {}
};
}

__device__ __forceinline__ unsigned f2bf(float f) { unsigned u = __builtin_bit_cast(unsigned, f); return (u + 0x7fffu + ((u >> 16) & 1u)) >> 16; }
__device__ __forceinline__ unsigned pk2(float lo, float hi) { return f2bf(lo) | (f2bf(hi) << 16); }
__device__ __forceinline__ float wave_sum(float v) {
#pragma unroll
    for (int o = 1; o < 64; o <<= 1) v += __shfl_xor(v, o);
    return v;
}
template <int KIND> __device__ __forceinline__ int src_col(int n) {
    if (KIND == 1) {
        if (n < 512) return n;
        if (n < 768) return 640 + (n - 512);
        if (n < 1024) return 964 + (n - 768);
        if (n < 1152) return 1220 + (n - 1024);
        if (n < 1216) return 512 + (n - 1152);
        if (n < 1280) return 576 + (n - 1216);
        if (n < 1344) return 896 + (n - 1280);
        if (n < 1376) { const int j = n - 1344; return 1348 + 16 * (j & 1) + (j >> 1); }
        if (n < 1380) return 960 + (n - 1376);
        if (n < 1536) return -1;
        return 1380 + (n - 1536);
    } else if (KIND == 2) {
        const int h = n / 96, c = n % 96; if (c < 64) return h * 96 + c; const int j = c - 64; return h * 96 + 64 + 16 * (j & 1) + (j >> 1);
    } else if (KIND == 3) {
        return (n >> 6) * 128 + (n & 63);
    } else if (KIND == 4) {
        return (n >> 6) * 128 + 64 + (n & 63);
    }
    return n;
}
template <int KIND> __device__ __forceinline__ void prep_item(const float* W, int K, int Nsrc, bf16* WT, LAS float* scr, int item, int nblk, int lane, const float* gain) {
    const int kb = item / nblk, nb = item % nblk, k0 = 64 * kb, n0 = 32 * nb;
    const int sc = src_col<KIND>(n0 + (lane & 31));
#pragma unroll 8
    for (int i = 0; i < 32; ++i) { const int kk = 2 * i + (lane >> 5); float v = (sc >= 0) ? W[(size_t)(k0 + kk) * Nsrc + sc] : 0.f; if (gain) v *= gain[k0 + kk]; scr[kk * 33 + (lane & 31)] = v; }
    LDS_WAIT(); asm volatile("" ::: "memory");
    const int c = lane & 7;
#pragma unroll
    for (int j = 0; j < 4; ++j) { const int n = (lane >> 3) + 8 * j; const LAS float* s = scr + (8 * c) * 33 + n;
        u32x4 o; o.x = pk2(s[0 * 33], s[1 * 33]); o.y = pk2(s[2 * 33], s[3 * 33]); o.z = pk2(s[4 * 33], s[5 * 33]); o.w = pk2(s[6 * 33], s[7 * 33]);
        *(GAS u32x4*)(WT + (size_t)((n0 + n) >> 8) * 256 * K + (size_t)kb * (256 * 64) + ((n0 + n) & 255) * 64 + 8 * c) = o; }
    LDS_WAIT(); asm volatile("" ::: "memory");
}
template <int KIND> __device__ __forceinline__ void prep8_wg(const float* W, int Nsrc, const float* gain, signed char* W8, float* SW, LAS float* scr, LAS float* cm  , int nb, int lane, int wave) {
    const int srcc = src_col<KIND>(32 * nb + (lane & 31)); const int src = srcc < 0 ? 0 : srcc; const float live = srcc < 0 ? 0.f : 1.f;
    float mx = 0.f;
#pragma unroll 16
    for (int i = 0; i < 64; ++i) { const int k = 128 * wave + (lane >> 5) + 2 * i; mx = fmaxf(mx, fabsf(W[(size_t)k * Nsrc + src] * gain[k] * live)); }
    mx = fmaxf(mx, __shfl_xor(mx, 32));
    if (lane < 32) cm[wave * 32 + lane] = mx;
    __syncthreads();
    mx = cm[lane & 31];
#pragma unroll
    for (int w2 = 1; w2 < NWAVES; ++w2) mx = fmaxf(mx, cm[w2 * 32 + (lane & 31)]);
    const float sc = (mx > 0.f) ? 127.f / mx : 1.f;
    if (wave == 0 && lane < 32) SW[32 * nb + lane] = (mx > 0.f) ? mx * (1.f / 127.f) : 1.f;
#pragma unroll 1
    for (int kk2 = 0; kk2 < 2; ++kk2) { const int k0 = 128 * wave + 64 * kk2;
#pragma unroll 8
        for (int i = 0; i < 32; ++i) { const int kk = 2 * i + (lane >> 5); scr[kk * 33 + (lane & 31)] = W[(size_t)(k0 + kk) * Nsrc + src] * gain[k0 + kk] * (sc * live); }
        LDS_WAIT(); asm volatile("" ::: "memory");
        { const int n = lane >> 1, hf = lane & 1; const LAS float* sp = scr + (32 * hf) * 33 + n; unsigned w[8];
#pragma unroll
          for (int g = 0; g < 8; ++g) { unsigned acc4 = 0u;
#pragma unroll
              for (int e = 0; e < 4; ++e) { int q = (int)__builtin_rintf(sp[(4 * g + e) * 33]); q = min(max(q, -127), 127) & 255; acc4 |= (unsigned)q << (8 * e); }
              w[g] = acc4; }
          const int col = 32 * nb + n;
          GAS u32x4* dst = (GAS u32x4*)(W8 + (size_t)(col >> 8) * (256 * 1024) + (size_t)wave * (256 * 128) + (col & 255) * 128 + 64 * kk2 + 32 * hf);
          dst[0] = (u32x4){w[0], w[1], w[2], w[3]}; dst[1] = (u32x4){w[4], w[5], w[6], w[7]}; }
        LDS_WAIT(); asm volatile("" ::: "memory");
    }
    __syncthreads();
}
__device__ __forceinline__ void quant_rows(Frame& F, int sel) {
    const bf16* XB = (const bf16*)(F.ws + WS_H); signed char* XB8 = (signed char*)(F.ws + WS_XB8); const unsigned* RMAX = (const unsigned*)(F.ws + WS_RMAX) + sel * M;
    const unsigned long long* RS = (const unsigned long long*)(F.ws + WS_RSS) + sel * M; float* SX = (float*)(F.ws + WS_SX);
    const int gw = F.bx * NWAVES + F.wave, NGW = F.G * NWAVES;
    for (int r0 = 4 * gw; r0 < M; r0 += 4 * NGW) {
        u32x4 a[4], b[4]; unsigned mb[4]; unsigned long long sq[4];
#pragma unroll
        for (int q = 0; q < 4; ++q) { const int row = r0 + q; mb[q] = RMAX[row]; sq[q] = RS[row];
            a[q] = *(const GAS u32x4*)(XB + (size_t)row * DM + 16 * F.lane); b[q] = *(const GAS u32x4*)(XB + (size_t)row * DM + 16 * F.lane + 8); }
#pragma unroll
        for (int q = 0; q < 4; ++q) { const int row = r0 + q;
            const float mx = __builtin_bit_cast(float, mb[q]); const float sc = (mx > 0.f) ? 127.f / mx : 1.f;
            pg8::f32x4 v0, v1, v2, v3; pg8::unpack8(a[q], v0, v1); pg8::unpack8(b[q], v2, v3);
            u32x4 o; o.x = pg8::q8x4(v0, sc); o.y = pg8::q8x4(v1, sc); o.z = pg8::q8x4(v2, sc); o.w = pg8::q8x4(v3, sc);
            *(GAS u32x4*)(XB8 + (size_t)(row >> 8) * (256 * 1024) + (size_t)(F.lane >> 3) * (256 * 128) + (row & 255) * 128 + (F.lane & 7) * 16) = o;
            if (F.lane == 0) { const float t = (float)sq[q] * (1.f / 4294967296.f); SX[row] = ((mx > 0.f) ? mx * (1.f / 127.f) : 1.f) * __builtin_amdgcn_rsqf(t * (1.f / 1024.f) + EPS); } }
    }
}
template <int GROUP> __device__ __forceinline__ void prep_weights(Frame& F, int l, int lds_off, const float* g1, const float* g2, const float* w_in, const float* gq, const float* gkv, const float* w_uq, const float* w_ukv,
                                                                  const float* w_a, const float* w_b, const float* w_out, const float* w_ff1, const float* w_ff2) {
    LAS float* scr = (LAS float*)(F.lds + lds_off + F.wave * 8704);
    bf16* WB = (bf16*)(F.ws + WS_W);
    const int gw = F.bx * NWAVES + F.wave, NGW = F.G * NWAVES;
    constexpr int I_IN = 0  , I_UQ = 4 * 24, I_UK = 2 * 16, I_UV = 2 * 16, I_A = 8 * 32, I_B = 8 * 32, I_O = 16 * 32, I_1 = 0  , I_2 = 64 * 32;
    if (GROUP == 0) {
        for (int nb = F.bx; nb < NIN / 32; nb += F.G)
            prep8_wg<1>(w_in + (size_t)l * DM * DIN, DIN, g1 + l * DM, (signed char*)(WB + W_IN_OFF), (float*)(F.ws + WS_SWI), scr, (LAS float*)(F.lds + lds_off + NWAVES * 8704), nb, F.lane, F.wave);
        for (int it = gw; it < I_IN + I_UQ + I_UK + I_UV; it += NGW) {
            int r = it;
            if (r < I_IN) { prep_item<1>(w_in + (size_t)l * DM * DIN, DM, DIN, WB + W_IN_OFF, scr, r, NIN / 32, F.lane, g1 + l * DM); continue; } r -= I_IN;
            if (r < I_UQ) { prep_item<2>(w_uq + (size_t)l * 256 * 768, 256, 768, WB + W_UQ_OFF, scr, r, 24, F.lane, gq + l * 256); continue; } r -= I_UQ;
            if (r < I_UK) { prep_item<3>(w_ukv + (size_t)l * 128 * 1024, 128, 1024, WB + W_UK_OFF, scr, r, 16, F.lane, gkv + l * 128); continue; } r -= I_UK;
            prep_item<4>(w_ukv + (size_t)l * 128 * 1024, 128, 1024, WB + W_UV_OFF, scr, r, 16, F.lane, gkv + l * 128);
        }
    } else {
        for (int nb = F.bx; nb < DFF / 32; nb += F.G)
            prep8_wg<0>(w_ff1 + (size_t)l * DM * DFF, DFF, g2 + l * DM, (signed char*)(WB + W_FF1_OFF), (float*)(F.ws + WS_SWF), scr, (LAS float*)(F.lds + lds_off + NWAVES * 8704), nb, F.lane, F.wave);
        for (int it = gw; it < I_A + I_B + I_O + I_1 + I_2; it += NGW) {
            int r = it;
            if (r < I_A) { prep_item<0>(w_a + (size_t)l * 512 * 1024, 512, 1024, WB + W_AB_OFF, scr, r, 32, F.lane, nullptr); continue; } r -= I_A;
            if (r < I_B) { prep_item<0>(w_b + (size_t)l * 512 * 1024, 512, 1024, WB + W_AB_OFF + 1024 * 512, scr, r, 32, F.lane, nullptr); continue; } r -= I_B;
            if (r < I_O) { prep_item<0>(w_out + (size_t)l * 1024 * 1024, 1024, 1024, WB + W_OUT_OFF, scr, r, 32, F.lane, nullptr); continue; } r -= I_O;
            if (r < I_1) { prep_item<0>(w_ff1 + (size_t)l * 1024 * 4096, 1024, 4096, WB + W_FF1_OFF, scr, r, 128, F.lane, g2 + l * DM); continue; } r -= I_1;
            prep_item<0>(w_ff2 + (size_t)l * 4096 * 1024, 4096, 1024, WB + W_FF2_OFF, scr, r, 32, F.lane, nullptr);
        }
    }
}
__device__ __forceinline__ void init_rows(Frame& F) {
    bf16* XB = (bf16*)(F.ws + WS_H); unsigned long long* RSB = (unsigned long long*)(F.ws + WS_RSS) + M;
    const int gw = F.bx * NWAVES + F.wave, NGW = F.G * NWAVES;
    for (int m = gw; m < M; m += NGW) {
        const GAS f32x4* xr = (const GAS f32x4*)(F.x + (size_t)m * DM) + F.lane;
        f32x4 v[4]; float s = 0.f;
#pragma unroll
        for (int j = 0; j < 4; ++j) { v[j] = xr[64 * j]; s += (v[j].x * v[j].x + v[j].y * v[j].y) + (v[j].z * v[j].z + v[j].w * v[j].w); }
        s = wave_sum(s);
        GAS unsigned long long* o8 = (GAS unsigned long long*)(XB + (size_t)m * DM) + F.lane;
#pragma unroll
        for (int j = 0; j < 4; ++j) o8[64 * j] = (unsigned long long)pk2(v[j].x, v[j].y) | ((unsigned long long)pk2(v[j].z, v[j].w) << 32);
        float mx = 0.f;
#pragma unroll
        for (int j = 0; j < 4; ++j) mx = fmaxf(mx, fmaxf(fmaxf(fabsf(v[j].x), fabsf(v[j].y)), fmaxf(fabsf(v[j].z), fabsf(v[j].w))));
#pragma unroll
        for (int o = 1; o < 64; o <<= 1) mx = fmaxf(mx, __shfl_xor(mx, o));
        if (F.lane == 0) { RSB[m] = (unsigned long long)(s * 4294967296.f); ((unsigned*)(F.ws + WS_RMAX))[M + m] = __builtin_bit_cast(unsigned, mx); }
    }
}
__device__ __forceinline__ void rope_table(Frame& F) {
    float* CS = (float*)(F.ws + WS_CS);
    for (int e = F.bx * (NWAVES * 64) + F.tid; e < M * 16; e += F.G * NWAVES * 64) { const int m = e >> 4, i = e & 15;
        const float invf = powf(10000.f, -(float)(2 * i) * (1.f / 32.f)); const float ang = (float)F.pos[m] * invf;
        float s, c; sincosf(ang, &s, &c); CS[(size_t)m * 32 + i] = c; CS[(size_t)m * 32 + 16 + i] = s; }
}
__device__ __forceinline__ void pos_tables(Frame& F) {
    int* KMAX = (int*)(F.ws + WS_PTAB); int* QMIN = KMAX + NB * 32;
    for (int e = F.bx * (NWAVES * 64) + F.tid; e < NB * 32 + NB * 64; e += F.G * NWAVES * 64) {
        if (e < NB * 32) { const int* p = F.pos + (size_t)(e >> 5) * SEQ + (e & 31) * 64; int m = p[0]; for (int i = 1; i < 64; ++i) m = max(m, p[i]); KMAX[e] = m; }
        else { const int q = e - NB * 32; const int* p = F.pos + (size_t)(q >> 6) * SEQ + (q & 63) * 32; int m = p[0]; for (int i = 1; i < 32; ++i) m = min(m, p[i]); QMIN[q] = m; }
    }
}
template <bool OUT_F32> __device__ __forceinline__ void norm_rows(Frame& F, const float* src, const float* g, bf16* dstb, float* dstf, float oscale = 1.f) {
    const int gw = F.bx * NWAVES + F.wave, NGW = F.G * NWAVES;
    f32x4 gv[4];
#pragma unroll
    for (int j = 0; j < 4; ++j) gv[j] = *((const f32x4*)g + F.lane + 64 * j);
    for (int m = gw; m < M; m += NGW) {
        const GAS f32x4* xr = (const GAS f32x4*)(src + (size_t)m * DM) + F.lane;
        f32x4 v[4]; float s = 0.f;
#pragma unroll
        for (int j = 0; j < 4; ++j) { v[j] = xr[64 * j]; s += (v[j].x * v[j].x + v[j].y * v[j].y) + (v[j].z * v[j].z + v[j].w * v[j].w); }
        const float rstd = oscale / sqrtf(wave_sum(s) * (1.f / DM) + EPS);
        if (OUT_F32) { GAS f32x4* o = (GAS f32x4*)(dstf + (size_t)m * DM) + F.lane;
#pragma unroll
            for (int j = 0; j < 4; ++j) o[64 * j] = v[j] * rstd * gv[j];
        } else { GAS unsigned long long* o8 = (GAS unsigned long long*)(dstb + (size_t)m * DM) + F.lane;
#pragma unroll
            for (int j = 0; j < 4; ++j) { const f32x4 y = v[j] * rstd * gv[j]; o8[64 * j] = (unsigned long long)pk2(y.x, y.y) | ((unsigned long long)pk2(y.z, y.w) << 32); } }
    }
}

__device__ __forceinline__ void final_norm(Frame& F, const float* g, float oscale) {
    const bf16* XB = (const bf16*)(F.ws + WS_H);
    const int gw = F.bx * NWAVES + F.wave, NGW = F.G * NWAVES;
    f32x4 gv[4];
#pragma unroll
    for (int j = 0; j < 2; ++j) { gv[2 * j] = *((const f32x4*)g + 2 * (F.lane + 64 * j)); gv[2 * j + 1] = *((const f32x4*)g + 2 * (F.lane + 64 * j) + 1); }
    for (int m0 = 4 * gw; m0 < M; m0 += 4 * NGW) {
        u32x4 raw[4][2];
#pragma unroll
        for (int q = 0; q < 4; ++q) { const GAS u32x4* xr = (const GAS u32x4*)(XB + (size_t)(m0 + q) * DM) + F.lane;
            raw[q][0] = xr[0]; raw[q][1] = xr[64]; }
#pragma unroll
        for (int q = 0; q < 4; ++q) { const int m = m0 + q;
            f32x4 v[4]; float s = 0.f;
#pragma unroll
            for (int j = 0; j < 2; ++j) { pg8::unpack8(raw[q][j], v[2 * j], v[2 * j + 1]); }
#pragma unroll
            for (int j = 0; j < 4; ++j) s += (v[j].x * v[j].x + v[j].y * v[j].y) + (v[j].z * v[j].z + v[j].w * v[j].w);
            const float rstd = oscale / sqrtf(wave_sum(s) * (1.f / DM) + EPS);
            GAS f32x4* o = (GAS f32x4*)(F.out + (size_t)m * DM) + 2 * F.lane;
#pragma unroll
            for (int j = 0; j < 2; ++j) { __builtin_nontemporal_store(v[2 * j] * rstd * gv[2 * j], o + 128 * j); __builtin_nontemporal_store(v[2 * j + 1] * rstd * gv[2 * j + 1], o + 128 * j + 1); } }
    }
}

constexpr int SC_PITCH = SEQ + 4;
constexpr int IDX_MB_OFF = 16 * SC_PITCH * 4;
static_assert(IDX_MB_OFF + 16 * 32 * 8 <= MISC_OFF, "indexer LDS");
__device__ __forceinline__ unsigned fkey(float f) { const unsigned u = __float_as_uint(f + 0.0f); return u ^ ((unsigned)((int)u >> 31) | 0x80000000u); }
__device__ __forceinline__ unsigned wave_sum_u32(unsigned v) {
    v += (unsigned)__builtin_amdgcn_update_dpp(0, (int)v, 0x111, 0xf, 0xf, true);
    v += (unsigned)__builtin_amdgcn_update_dpp(0, (int)v, 0x112, 0xf, 0xf, true);
    v += (unsigned)__builtin_amdgcn_update_dpp(0, (int)v, 0x114, 0xf, 0xf, true);
    v += (unsigned)__builtin_amdgcn_update_dpp(0, (int)v, 0x118, 0xf, 0xf, true);
    v += (unsigned)__builtin_amdgcn_update_dpp(0, (int)v, 0x142, 0xa, 0xf, false);
    v += (unsigned)__builtin_amdgcn_update_dpp(0, (int)v, 0x143, 0xc, 0xf, false);
    return (unsigned)__builtin_amdgcn_readlane((int)v, 63);
}
template <int S> __device__ __forceinline__ void tr32_stage(unsigned (&a)[32]) {
    constexpr unsigned m = (S == 4) ? 0x0F0F0F0Fu : (S == 2) ? 0x33333333u : 0x55555555u;
#pragma unroll
    for (int k = 0; k < 32; ++k) if (!(k & S)) { const unsigned lo = a[k], hi = a[k + S];
        if (S == 16) { a[k] = __builtin_amdgcn_perm(hi, lo, 0x05040100u); a[k + S] = __builtin_amdgcn_perm(hi, lo, 0x07060302u); }
        else if (S == 8) { a[k] = __builtin_amdgcn_perm(hi, lo, 0x06020400u); a[k + S] = __builtin_amdgcn_perm(hi, lo, 0x07030501u); }
        else { a[k] = (lo & m) | ((hi << S) & ~m); a[k + S] = ((lo >> S) & m) | (hi & ~m); } }
}
__device__ __forceinline__ void tr32(unsigned (&a)[32]) { tr32_stage<16>(a); tr32_stage<8>(a); tr32_stage<4>(a); tr32_stage<2>(a); tr32_stage<1>(a); }
__device__ __forceinline__ void emit_words(unsigned G, unsigned C, int cnt, int rem, unsigned long long& myword, int lane) {
    if (cnt <= rem) { const unsigned Fw = G | C;
#pragma unroll
        for (int j = 0; j < 32; ++j) { const unsigned long long mk = __ballot((Fw >> j) & 1u); if (lane == j) myword = mk; }
    } else {
        int need = rem;
#pragma unroll
        for (int j = 0; j < 32; ++j) { const unsigned long long gt = __ballot((G >> j) & 1u), eq = __ballot((C >> j) & 1u); const int c = __popcll(eq); unsigned long long take;
            if (c <= need) { take = eq; need -= c; }
            else { const int below = __builtin_amdgcn_mbcnt_hi((unsigned)(eq >> 32), __builtin_amdgcn_mbcnt_lo((unsigned)eq, 0u)); take = __ballot(((C >> j) & 1u) && (below < need)); need = 0; }
            if (lane == j) myword = gt | take; }
    }
}
__device__ __forceinline__ void select_bits(unsigned (&ka)[32], unsigned Ca, unsigned long long& worda, int lane) {
    tr32(ka);
    unsigned Ga = 0u;
    int ra = TOPK;
    int ca = (int)wave_sum_u32((unsigned)__popc(Ca));
    bool da = (ca <= ra);
#pragma unroll
    for (int b = 31; b >= 0; --b) {
        if (da) break;
        const unsigned pa = ka[b];
        const unsigned oa = Ca & pa;
        const int na = (int)wave_sum_u32((unsigned)__popc(oa));
        const bool up = (na >= ra);
        Ca = up ? oa : (Ca & ~pa); Ga = up ? Ga : (Ga | oa); ca = up ? na : ca - na; ra = up ? ra : ra - na; da = (ca == ra);
    }
    emit_words(Ga, Ca, ca, ra, worda, lane);
}
__device__ __forceinline__ void idx_phase(Frame& F) {
    const bf16* IQ = (const bf16*)(F.ws + WS_IQ); const bf16* IK = (const bf16*)(F.ws + WS_IK); const float* IW = (const float*)(F.ws + WS_IW);
    unsigned long long* MASK = (unsigned long long*)(F.ws + WS_MASK);
    LAS float* sc = (LAS float*)F.lds; LAS unsigned long long* mb = (LAS unsigned long long*)(F.lds + IDX_MB_OFF);
    const int lane = F.lane, n = lane & 15, kg = lane >> 4, w = F.wave;
    for (int uidx = F.bx; uidx < NB * 128; uidx += F.G) {
        const int c0_ = uidx & 255, c = ((c0_ & 7) << 5) | (c0_ >> 3),     i = uidx >> 8, b = c >> 4, s = c & 15;
        const int jb = (i >> 1) * 32 + ((i & 1) ? 31 - s : s);
        const int q0 = jb * 16, ntile = jb + 1; const size_t rowb = (size_t)b * SEQ;
        bf16x8 qf[4][2];
#pragma unroll
        for (int h = 0; h < 4; ++h)
#pragma unroll
            for (int ks = 0; ks < 2; ++ks) qf[h][ks] = *(const bf16x8*)(IQ + (rowb + q0 + n) * 256 + h * 64 + ks * 32 + kg * 8);
        const f32x4 w4 = *(const f32x4*)(IW + (rowb + q0 + n) * 4);
        float pinf_ = __builtin_inff(); asm volatile("" : "+s"(pinf_));
#ifndef IDX_REP_SCORE
#define IDX_REP_SCORE 1
#define IDX_REP_SELECT 1
#endif
        for (int rep_ = 0; rep_ < IDX_REP_SCORE; ++rep_)
        for (int t0 = w; t0 < ntile; t0 += 8 * NWAVES) {
            bf16x8 kf[8][2];
#pragma unroll
            for (int u = 0; u < 8; ++u) { const int tt = t0 + u * NWAVES; if (tt < ntile) { const bf16* kp = IK + (rowb + tt * 16 + n) * 64 + kg * 8; kf[u][0] = *(const bf16x8*)kp; kf[u][1] = *(const bf16x8*)(kp + 32); } }
#pragma unroll
            for (int u = 0; u < 8; ++u) { const int tt = t0 + u * NWAVES;
                if (tt < ntile) { float z0 = 0.f, z1 = 0.f, z2 = 0.f, z3 = 0.f;
#pragma unroll
                    for (int h = 0; h < 4; ++h) { f32x4 a = (f32x4){0.f, 0.f, 0.f, 0.f};
                        a = __builtin_amdgcn_mfma_f32_16x16x32_bf16(kf[u][0], qf[h][0], a, 0, 0, 0); a = __builtin_amdgcn_mfma_f32_16x16x32_bf16(kf[u][1], qf[h][1], a, 0, 0, 0);
                        z0 = __builtin_fmaf(w4[h], __builtin_amdgcn_fmed3f(a[0], 0.f, pinf_), z0); z1 = __builtin_fmaf(w4[h], __builtin_amdgcn_fmed3f(a[1], 0.f, pinf_), z1);
                        z2 = __builtin_fmaf(w4[h], __builtin_amdgcn_fmed3f(a[2], 0.f, pinf_), z2); z3 = __builtin_fmaf(w4[h], __builtin_amdgcn_fmed3f(a[3], 0.f, pinf_), z3);
                        asm volatile("" : "+v"(z0), "+v"(z1), "+v"(z2), "+v"(z3)); }
                    *(LAS f32x4*)(sc + n * SC_PITCH + tt * 16 + 4 * kg) = (f32x4){z0, z1, z2, z3}; } }
        }
        __syncthreads();
        for (int rep_ = 0; rep_ < IDX_REP_SELECT; ++rep_)
#pragma unroll 1
        for (int rr = 0; rr < 2; ++rr) {
            const int r = 2 * w + rr, t = q0 + r;
            unsigned ka[32];
#pragma unroll
            for (int j = 0; j < 32; ++j) ka[j] = fkey(sc[r * SC_PITCH + j * 64 + lane]);
            const int jm = t >> 6; const unsigned valid = (lane <= (t & 63)) ? ((2u << jm) - 1u) : ((1u << jm) - 1u);
            unsigned long long worda = 0ull;
            if (t + 1 <= TOPK) {
#pragma unroll
                for (int j = 0; j < 32; ++j) { const unsigned long long ma = __ballot((valid >> j) & 1u); if (lane == j) worda = ma; }
            } else select_bits(ka, valid, worda, lane);
            if (lane < 32) mb[r * 32 + lane] = worda;
        }
        __syncthreads();
        { const int j = F.tid >> 4, q = F.tid & 15; MASK[((size_t)b * 32 + j) * SEQ + q0 + q] = mb[q * 32 + j]; }
        __syncthreads();
    }
}

constexpr int KP_A = 144, KP_B = 208, VP = 136;
constexpr int KBUF_SZ = 64 * KP_B, VBUF_SZ = 64 * VP, KBUF = 0, VBUF = 2 * KBUF_SZ, LUT_OFF = VBUF + 2 * VBUF_SZ;
constexpr int POSB_OFF = LUT_OFF + 4160;
constexpr float ATT_THR = 8.f;
struct AttnSt { f32x16 o[2]; f32x16 cinit; float lrun; };
__device__ __forceinline__ void attn_reference(AttnSt& st, f32x16& s0, f32x16& s1, bool first) {
    const float pinf = __builtin_inff();
    float mx = __builtin_amdgcn_fmed3f(s0[0], s1[0], pinf);
#pragma unroll
    for (int r = 1; r < 16; ++r) { mx = __builtin_amdgcn_fmed3f(mx, s0[r], pinf); mx = __builtin_amdgcn_fmed3f(mx, s1[r], pinf); }
    mx = xor32_max(mx);
    if (first || __any(mx > ATT_THR)) {
        const float dl = first ? mx : fmaxf(mx, 0.f);
#pragma unroll
        for (int r = 0; r < 16; ++r) { s0[r] -= dl; s1[r] -= dl; st.cinit[r] -= dl; }
        if (!first) { const float a = __builtin_amdgcn_exp2f(-dl); st.lrun *= a;
#pragma unroll
            for (int r = 0; r < 16; ++r) { st.o[0][r] *= a; st.o[1][r] *= a; } }
    }
}
__device__ __forceinline__ void attn_exp(f32x16& s0, f32x16& s1) {
#pragma unroll
    for (int r = 0; r < 16; ++r) { s0[r] = __builtin_amdgcn_exp2f(s0[r]); s1[r] = __builtin_amdgcn_exp2f(s1[r]); }
}
__device__ __forceinline__ void attn_vload(u32x4 (&vw)[2][4], const LAS char* vt, int r32, int hi) {
#pragma unroll
    for (int d0 = 0; d0 < 2; ++d0)
#pragma unroll
        for (int ks = 0; ks < 4; ++ks) { const LAS char* p = vt + (32 * d0 + r32) * VP + 32 * ks + 8 * hi;
            const u32x2 lo = *(const LAS u32x2*)p, hh = *(const LAS u32x2*)(p + 16); vw[d0][ks] = (u32x4){lo.x, lo.y, hh.x, hh.y}; }
}
__device__ __forceinline__ void attn_pv(AttnSt& st, const f32x16& s0, const f32x16& s1, const u32x4 (&vw)[2][4]) {
    float ps0 = 0.f, ps1 = 0.f;
#pragma unroll
    for (int r = 0; r < 16; ++r) { ps0 += s0[r]; ps1 += s1[r]; asm volatile("" : "+v"(ps0), "+v"(ps1)); }
    st.lrun += ps0 + ps1;
    bf16x8 pf[4];
#pragma unroll
    for (int ks = 0; ks < 4; ++ks) { u32x4 w;
        if (ks < 2) { const int b = 8 * ks; w.x = pg8::cvt_pk_bf16(s0[b], s0[b + 1]); w.y = pg8::cvt_pk_bf16(s0[b + 2], s0[b + 3]); w.z = pg8::cvt_pk_bf16(s0[b + 4], s0[b + 5]); w.w = pg8::cvt_pk_bf16(s0[b + 6], s0[b + 7]); }
        else { const int b = 8 * (ks - 2); w.x = pg8::cvt_pk_bf16(s1[b], s1[b + 1]); w.y = pg8::cvt_pk_bf16(s1[b + 2], s1[b + 3]); w.z = pg8::cvt_pk_bf16(s1[b + 4], s1[b + 5]); w.w = pg8::cvt_pk_bf16(s1[b + 6], s1[b + 7]); }
        pf[ks] = __builtin_bit_cast(bf16x8, w); }
#pragma unroll
    for (int ks = 0; ks < 4; ++ks)
#pragma unroll
        for (int d0 = 0; d0 < 2; ++d0) st.o[d0] = __builtin_amdgcn_mfma_f32_32x32x16_bf16(__builtin_bit_cast(bf16x8, vw[d0][ks]), pf[ks], st.o[d0], 0, 0, 0);
}
__device__ __forceinline__ void store_o(bf16* op, const f32x16 (&o)[2], float inv) {
#pragma unroll
    for (int d0 = 0; d0 < 2; ++d0)
#pragma unroll
        for (int g = 0; g < 4; ++g) { u32x2 w; w.x = pg8::cvt_pk_bf16(o[d0][4 * g] * inv, o[d0][4 * g + 1] * inv); w.y = pg8::cvt_pk_bf16(o[d0][4 * g + 2] * inv, o[d0][4 * g + 3] * inv);
            *(u32x2*)(op + 32 * d0 + 8 * g) = w; }
}
__device__ __forceinline__ void dsa_unit(Frame& F, int b, int jq) {
    const int lane = F.lane, r32 = lane & 31, hi = lane >> 5, w = F.wave, tid = F.tid;
    LAS char* lds = (LAS char*)F.lds;
    bf16* AQ = (bf16*)(F.ws + WS_YA); const bf16* AK = (const bf16*)(F.ws + WS_AK); const bf16* AVT = (const bf16*)(F.ws + WS_AVT);
    const unsigned long long* MASK = (const unsigned long long*)(F.ws + WS_MASK);
    const size_t rowb = (size_t)b * SEQ; const int q0 = jq * 32;
    bf16x8 qf[4];
    { const bf16* qp = AQ + (rowb + q0 + r32) * 512 + w * 64 + hi * 8;
#pragma unroll
      for (int d0 = 0; d0 < 4; ++d0) qf[d0] = *(const bf16x8*)(qp + d0 * 16); }
    const int posq = F.pos[rowb + q0 + r32];
    const int* KMAX = (const int*)(F.ws + WS_PTAB);
    const int qmin = __builtin_amdgcn_readfirstlane(KMAX[NB * 32 + b * 64 + jq]);
    const int NT = (jq + 2) >> 1;
    const LAS float* lut = (const LAS float*)(lds + LUT_OFF) + w * 129;
    AttnSt st; st.lrun = 0.f;
#pragma unroll
    for (int r = 0; r < 16; ++r) { st.o[0][r] = 0.f; st.o[1][r] = 0.f; st.cinit[r] = 0.f; }
    const int srow = tid >> 3, sch = tid & 7;
    const bf16* kgp = AK + (rowb + srow) * 64 + sch * 8;
    const bf16* vgp = AVT + ((size_t)b * 64 + srow) * SEQ + sch * 8;
    const unsigned long long* mwp = MASK + (size_t)b * 32 * SEQ + q0 + r32;
    int kmaxv = KMAX[b * 32 + (lane & 31)];
    asm volatile("" : "+v"(qf[0]), "+v"(qf[1]), "+v"(qf[2]), "+v"(qf[3]), "+v"(kmaxv));
    const int* ppg = F.pos + rowb + (tid & 63);
    u32x4 kA = *(const u32x4*)kgp, vA = *(const u32x4*)vgp, kB = kA, vB = vA; unsigned long long mA = mwp[0], mB = mA; int pA = ppg[0], pB = pA;
    if (NT > 1) { kB = *(const u32x4*)(kgp + (size_t)64 * 64); vB = *(const u32x4*)(vgp + 64); mB = mwp[SEQ]; pB = ppg[64]; }
#define DSA_TILE(t_, KR_, VR_, MR_, PR_) do { const int tt_ = (t_); \
        LAS char* kb = lds + KBUF + (tt_ & 1) * KBUF_SZ; LAS char* vb = lds + VBUF + (tt_ & 1) * VBUF_SZ; \
        *(LAS u32x4*)(kb + srow * KP_A + sch * 16) = KR_; \
        *(LAS u32x2*)(vb + srow * VP + sch * 16) = (u32x2){VR_.x, VR_.y}; *(LAS u32x2*)(vb + srow * VP + sch * 16 + 8) = (u32x2){VR_.z, VR_.w}; \
        const unsigned long long mw = MR_; \
        if (tid < 64) ((LAS int*)(lds + POSB_OFF))[(tt_ & 1) * 64 + tid] = PR_; \
        __syncthreads(); \
        { const int tn_ = min(tt_ + 2, NT - 1);     \
          KR_ = *(const u32x4*)(kgp + (size_t)tn_ * 64 * 64); VR_ = *(const u32x4*)(vgp + tn_ * 64); MR_ = mwp[(size_t)tn_ * SEQ]; PR_ = ppg[tn_ * 64]; } \
        const bool far = (qmin - __builtin_amdgcn_readlane(kmaxv, tt_) >= 128); \
        f32x16 s0, s1; \
        { bf16x8 kf0[4], kf1[4];     \
          _Pragma("unroll") for (int d0 = 0; d0 < 4; ++d0) { kf0[d0] = *(const LAS bf16x8*)(kb + r32 * KP_A + d0 * 32 + hi * 16); kf1[d0] = *(const LAS bf16x8*)(kb + (32 + r32) * KP_A + d0 * 32 + hi * 16); } \
          __builtin_amdgcn_sched_barrier(0); \
          s0 = __builtin_amdgcn_mfma_f32_32x32x16_bf16(kf0[0], qf[0], st.cinit, 0, 0, 0); s1 = __builtin_amdgcn_mfma_f32_32x32x16_bf16(kf1[0], qf[0], st.cinit, 0, 0, 0); \
          _Pragma("unroll") for (int d0 = 1; d0 < 4; ++d0) { s0 = __builtin_amdgcn_mfma_f32_32x32x16_bf16(kf0[d0], qf[d0], s0, 0, 0, 0); s1 = __builtin_amdgcn_mfma_f32_32x32x16_bf16(kf1[d0], qf[d0], s1, 0, 0, 0); } } \
        u32x4 vw[2][4]; attn_vload(vw, vb, r32, hi); \
        if (!far) { const LAS int* pk = (const LAS int*)(lds + POSB_OFF) + (tt_ & 1) * 64 + 4 * hi; float bv0[16], bv1[16]; \
            _Pragma("unroll") for (int g = 0; g < 4; ++g) { const i32x4 p0 = *(const LAS i32x4*)(pk + 8 * g), p1 = *(const LAS i32x4*)(pk + 32 + 8 * g); \
                _Pragma("unroll") for (int e = 0; e < 4; ++e) { bv0[4 * g + e] = lut[min(max(posq - p0[e], 0), 128)]; bv1[4 * g + e] = lut[min(max(posq - p1[e], 0), 128)]; } } \
            _Pragma("unroll") for (int r = 0; r < 16; ++r) { s0[r] += bv0[r]; s1[r] += bv1[r]; } } \
        attn_reference(st, s0, s1, tt_ == 0); \
        attn_exp(s0, s1); \
        { const unsigned wl = (unsigned)mw >> (4 * hi), wh = (unsigned)(mw >> 32) >> (4 * hi); int one_ = 1; asm volatile("" : "+s"(one_));     \
          _Pragma("unroll") for (int r = 0; r < 16; ++r) { const int c = (r & 3) + 8 * (r >> 2); \
              s0[r] = __uint_as_float(__float_as_uint(s0[r]) & (unsigned)__builtin_amdgcn_sbfe((int)wl, c, one_)); s1[r] = __uint_as_float(__float_as_uint(s1[r]) & (unsigned)__builtin_amdgcn_sbfe((int)wh, c, one_)); } }     \
        attn_pv(st, s0, s1, vw); } while (0)
    asm volatile(".p2align 8" ::: "memory");
    for (int t = 0; t < NT; t += 2) {
        DSA_TILE(t, kA, vA, mA, pA);
        if (t + 1 < NT) DSA_TILE(t + 1, kB, vB, mB, pB);
    }
#undef DSA_TILE
    st.lrun = xor32_sum(st.lrun);
    store_o(AQ + (rowb + q0 + r32) * 512 + w * 64 + 4 * hi, st.o, 1.f / st.lrun);
    __syncthreads();
}
__device__ __forceinline__ void mla_unit(Frame& F, int b, int h, int qb) {
    const int lane = F.lane, r32 = lane & 31, hi = lane >> 5, w = F.wave, tid = F.tid;
    LAS char* lds = (LAS char*)F.lds;
    const bf16* QB = (const bf16*)(F.ws + WS_QB); const bf16* KN = (const bf16*)(F.ws + WS_KN); const bf16* KR = (const bf16*)(F.ws + WS_KR); const bf16* VT = (const bf16*)(F.ws + WS_VT);
    bf16* YB = (bf16*)(F.ws + WS_YB);
    const size_t rowb = (size_t)b * SEQ; const int q0w = qb * 256 + w * 32;
    bf16x8 qf[6];
    { const bf16* qp = QB + (rowb + q0w + r32) * 768 + h * 96 + hi * 8;
#pragma unroll
      for (int d0 = 0; d0 < 6; ++d0) qf[d0] = *(const bf16x8*)(qp + d0 * 16); }
    const int NT = 4 * (qb + 1);
    AttnSt st; st.lrun = 0.f;
#pragma unroll
    for (int r = 0; r < 16; ++r) { st.o[0][r] = 0.f; st.o[1][r] = 0.f; st.cinit[r] = 0.f; }
    const int srow = tid >> 3, sch = tid & 7, rrow = (tid >> 2) & 63, rch = tid & 3;
    const bf16* kgp = KN + (rowb + srow) * 512 + h * 64 + sch * 8;
    const bf16* rgp = KR + (rowb + rrow) * 32 + rch * 8;
    const bf16* vgp = VT + (size_t)(h * 64 + srow) * M + rowb + sch * 8;
    u32x4 kA = *(const u32x4*)kgp, vA = *(const u32x4*)vgp, rA = *(const u32x4*)rgp;
    u32x4 kB = *(const u32x4*)(kgp + (size_t)64 * 512), vB = *(const u32x4*)(vgp + 64), rB = *(const u32x4*)(rgp + (size_t)64 * 32);
#define MLA_TILE(t_, KR_, VR_, RR_) do { const int tt_ = (t_); \
        LAS char* kb = lds + KBUF + (tt_ & 1) * KBUF_SZ; LAS char* vb = lds + VBUF + (tt_ & 1) * VBUF_SZ; \
        *(LAS u32x4*)(kb + srow * KP_B + sch * 16) = KR_; \
        if (tid < 256) *(LAS u32x4*)(kb + rrow * KP_B + 128 + rch * 16) = RR_; \
        *(LAS u32x2*)(vb + srow * VP + sch * 16) = (u32x2){VR_.x, VR_.y}; *(LAS u32x2*)(vb + srow * VP + sch * 16 + 8) = (u32x2){VR_.z, VR_.w}; \
        __syncthreads(); \
        { const int tn_ = min(tt_ + 2, NT - 1); \
          KR_ = *(const u32x4*)(kgp + (size_t)tn_ * 64 * 512); VR_ = *(const u32x4*)(vgp + tn_ * 64); RR_ = *(const u32x4*)(rgp + (size_t)tn_ * 64 * 32); } \
        if (tt_ * 64 <= q0w + 31) { \
            f32x16 s0, s1; \
            { bf16x8 kf0[6], kf1[6]; \
              _Pragma("unroll") for (int d0 = 0; d0 < 6; ++d0) { kf0[d0] = *(const LAS bf16x8*)(kb + r32 * KP_B + d0 * 32 + hi * 16); kf1[d0] = *(const LAS bf16x8*)(kb + (32 + r32) * KP_B + d0 * 32 + hi * 16); } \
              __builtin_amdgcn_sched_barrier(0); \
              s0 = __builtin_amdgcn_mfma_f32_32x32x16_bf16(kf0[0], qf[0], st.cinit, 0, 0, 0); s1 = __builtin_amdgcn_mfma_f32_32x32x16_bf16(kf1[0], qf[0], st.cinit, 0, 0, 0); \
              _Pragma("unroll") for (int d0 = 1; d0 < 6; ++d0) { s0 = __builtin_amdgcn_mfma_f32_32x32x16_bf16(kf0[d0], qf[d0], s0, 0, 0, 0); s1 = __builtin_amdgcn_mfma_f32_32x32x16_bf16(kf1[d0], qf[d0], s1, 0, 0, 0); } } \
            u32x4 vw[2][4]; attn_vload(vw, vb, r32, hi); \
            attn_reference(st, s0, s1, tt_ == 0); \
            attn_exp(s0, s1); \
            if (tt_ * 64 + 63 > q0w) { const int qi = q0w + r32, kv0 = tt_ * 64 + 4 * hi; \
                _Pragma("unroll") for (int r = 0; r < 16; ++r) { const int kv = kv0 + (r & 3) + 8 * (r >> 2); if (kv > qi) s0[r] = 0.f; if (kv + 32 > qi) s1[r] = 0.f; } } \
            attn_pv(st, s0, s1, vw); } } while (0)
    asm volatile(".p2align 8" ::: "memory");
    for (int t = 0; t < NT; t += 2) {
        MLA_TILE(t, kA, vA, rA);
        MLA_TILE(t + 1, kB, vB, rB);
    }
#undef MLA_TILE
    st.lrun = xor32_sum(st.lrun);
    store_o(YB + (rowb + q0w + r32) * 512 + h * 64 + 4 * hi, st.o, 1.f / st.lrun);
    __syncthreads();
}
__device__ __forceinline__ void attn_phase(Frame& F) {
    { LAS float* lut = (LAS float*)(F.lds + LUT_OFF);
      for (int e = F.tid; e < 8 * 129; e += NWAVES * 64) { const int h = e / 129, n = e % 129; int bk;
          if (n < 16) bk = n; else { const float z = logf((float)n * (1.f / 16.f)) / 2.0794415416798357f * 16.f; bk = 16 + (int)z; if (bk > 31) bk = 31; }
          lut[e] = (F.rel_bias[bk * 8 + h] - F.rel_bias[31 * 8 + h]) * LOG2E; }
      __syncthreads(); }
#ifndef ATT_DSA_ON
#define ATT_DSA_ON 1
#endif
#ifndef ATT_MLA_ON
#define ATT_MLA_ON 1
#endif
    if (ATT_DSA_ON)
    for (int uidx = F.bx; uidx < NB * 64; uidx += F.G) {
        const int c0_ = uidx & 255, c = ((c0_ & 7) << 5) | (c0_ >> 3),     i = uidx >> 8, b = c >> 4, s = c & 15;
        const int jq = (i >> 1) * 32 + ((i & 1) ? 31 - s : s);
        dsa_unit(F, b, jq);
    }
    if (ATT_MLA_ON)
    for (int uidx = F.bx; uidx < NB * 8 * 8; uidx += F.G) {
        const int c0_ = uidx & 255, c = ((c0_ & 7) << 5) | (c0_ >> 3),     i = uidx >> 8, bh = c >> 1, sub = c & 1;
        const int qb = sub ? ((i == 0) ? 1 : (i == 1) ? 6 : (i == 2) ? 2 : 5) : ((i == 0) ? 0 : (i == 1) ? 7 : (i == 2) ? 3 : 4);
        mla_unit(F, bh >> 3, bh & 7, qb);
    }
}
#if defined(DBG_CHECK)
#ifndef DBG_PROBE_OFF
#define DBG_PROBE_OFF 100
#define DBG_PROBE_PH 2
#endif
#ifndef DBG_FILL_LO
#define DBG_FILL_LO (1 * MiB)
#define DBG_FILL_HI (468 * MiB)
#endif
constexpr size_t WS_DBG_AQ_UNUSED = 0;
constexpr int DBG_W_DSA = 16, DBG_W_MASK = 17, DBG_W_MLA = 18, DBG_W_DIR = 19, DBG_W_QB = 20, DBG_W_KV = 21;
__device__ __forceinline__ float bf2f(bf16 v) { return __uint_as_float((unsigned)v << 16); }
__device__ __forceinline__ int dbg_bucket(int n) { if (n < 0) n = 0; if (n < 16) return n; const double z = log((double)n / 16.0) / log(8.0) * 16.0; int b = 16 + (int)z; return b > 31 ? 31 : b; }
__device__ __forceinline__ float dbg_block_max(LAS float* red, float v, int tid) {
    for (int o = 1; o < 64; o <<= 1) v = fmaxf(v, __shfl_xor(v, o));
    __syncthreads(); if ((tid & 63) == 0) red[tid >> 6] = v; __syncthreads();
    float r = red[0]; for (int i = 1; i < NWAVES; ++i) r = fmaxf(r, red[i]); __syncthreads(); return r;
}
__device__ __forceinline__ float dbg_block_sum(LAS float* red, float v, int tid) {
    for (int o = 1; o < 64; o <<= 1) v += __shfl_xor(v, o);
    __syncthreads(); if ((tid & 63) == 0) red[tid >> 6] = v; __syncthreads();
    float r = 0.f; for (int i = 0; i < NWAVES; ++i) r += red[i]; __syncthreads(); return r;
}
__device__ __forceinline__ int dbg_sample_t(int k) { return (k == 0) ? 0 : (k == 1) ? 255 : (k == 2) ? 256 : (k == 3) ? 257 : (k == 4) ? 2047 : (k == 5) ? 300 : 100 + 173 * k; }
__device__ __forceinline__ void dbg_copy_aq(unsigned char* ws, float* outbuf, int bx, int G, int tid) {
    const u32x4* src = (const u32x4*)(ws + WS_YA); u32x4* dst = (u32x4*)outbuf;
    for (size_t i = (size_t)bx * 512 + tid; i < (size_t)M * 512 * 2 / 16; i += (size_t)G * 512) dst[i] = src[i];
}
__device__ __forceinline__ void dbg_check_attn(unsigned char* ws, const float* outbuf, const int* pos, const float* rel_bias, LAS unsigned char* lds, int bx, int G, int tid) {
    unsigned* ctl = (unsigned*)(ws + WS_CTL);
    const bf16* AQc = (const bf16*)outbuf; const bf16* YA = (const bf16*)(ws + WS_YA); const bf16* YB = (const bf16*)(ws + WS_YB);
    const bf16* AK = (const bf16*)(ws + WS_AK); const bf16* AVT = (const bf16*)(ws + WS_AVT); const bf16* IQ = (const bf16*)(ws + WS_IQ); const bf16* IK = (const bf16*)(ws + WS_IK);
    const float* IW = (const float*)(ws + WS_IW); const unsigned long long* MASK = (const unsigned long long*)(ws + WS_MASK);
    const bf16* QB = (const bf16*)(ws + WS_QB); const bf16* KN = (const bf16*)(ws + WS_KN); const bf16* KR = (const bf16*)(ws + WS_KR); const bf16* VT = (const bf16*)(ws + WS_VT);
    LAS float* sc = (LAS float*)lds; LAS float* lg = sc + 2048; LAS float* sel = lg + 2048; LAS float* red = sel + 2048; LAS float* yacc = red + 16;
    for (int unit = bx; unit < NB * 12; unit += G) {
        const int b = unit / 12, t = dbg_sample_t(unit % 12); const size_t rowb = (size_t)b * SEQ;
        for (int s = tid; s < SEQ; s += 512) { float v = 0.f;
            if (s <= t) { for (int h = 0; h < 4; ++h) { float d = 0.f; for (int e = 0; e < 64; ++e) d += bf2f(IQ[(rowb + t) * 256 + h * 64 + e]) * bf2f(IK[(rowb + s) * 64 + e]); v += IW[(rowb + t) * 4 + h] * fmaxf(d, 0.f); } }
            sc[s] = v; }
        __syncthreads();
        int mism = 0;
        for (int s = tid; s < SEQ; s += 512) { float pick = 0.f;
            if (s <= t) { int cnt = 0; const float me = sc[s]; for (int s2 = 0; s2 <= t; ++s2) { const float o = sc[s2]; cnt += (o > me || (o == me && s2 < s)) ? 1 : 0; } pick = (t + 1 <= TOPK || cnt < TOPK) ? 1.f : 0.f; }
            sel[s] = pick;
            const int fast = (int)((MASK[((size_t)b * 32 + (s >> 6)) * SEQ + t] >> (s & 63)) & 1ull);
            mism += (fast != (int)pick) ? 1 : 0; }
        { const float tot = dbg_block_sum(red, (float)mism, tid); if (tid == 0 && tot > 0.f) atomicAdd(ctl + DBG_W_MASK, (unsigned)tot); }
        for (int h = 0; h < 8; ++h) {
            float lmax = -3e38f;
            for (int s = tid; s < SEQ; s += 512) { float v = -3e38f;
                if (s <= t && sel[s] != 0.f) { float d = 0.f; for (int e = 0; e < 64; ++e) d += bf2f(AQc[(rowb + t) * 512 + h * 64 + e]) * bf2f(AK[(rowb + s) * 64 + e]);
                    v = d + LOG2E * rel_bias[dbg_bucket(pos[rowb + t] - pos[rowb + s]) * 8 + h]; }
                lg[s] = v; lmax = fmaxf(lmax, v); }
            const float mx = dbg_block_max(red, lmax, tid);
            float ps = 0.f;
            for (int s = tid; s < SEQ; s += 512) { const float p = (lg[s] > -1e38f) ? exp2f(lg[s] - mx) : 0.f; lg[s] = p; ps += p; }
            const float tot = dbg_block_sum(red, ps, tid);
            { const int d = tid & 63, part = tid >> 6; float a = 0.f; for (int s = part; s <= t; s += 8) a += lg[s] * bf2f(AVT[((size_t)b * 64 + d) * SEQ + s]); yacc[part * 64 + d] = a; }
            __syncthreads();
            float err = 0.f, mag = 0.f;
            if (tid < 64) { float y = 0.f; for (int p = 0; p < 8; ++p) y += yacc[p * 64 + tid]; y /= tot; const float f = bf2f(YA[(rowb + t) * 512 + h * 64 + tid]); err = fabsf(f - y); mag = fabsf(y); }
            const float emax = dbg_block_max(red, err, tid), mmax = dbg_block_max(red, mag, tid);
            if (tid == 0) atomicMax(ctl + DBG_W_DSA, __float_as_uint(emax / (mmax + 1e-20f)));
            __syncthreads();
        }
        for (int h = 0; h < 8; ++h) {
            float lmax = -3e38f;
            for (int s = tid; s < SEQ; s += 512) { float v = -3e38f;
                if (s <= t) { float d = 0.f; for (int e = 0; e < 64; ++e) d += bf2f(QB[(rowb + t) * 768 + h * 96 + e]) * bf2f(KN[(rowb + s) * 512 + h * 64 + e]);
                    for (int e = 0; e < 32; ++e) d += bf2f(QB[(rowb + t) * 768 + h * 96 + 64 + e]) * bf2f(KR[(rowb + s) * 32 + e]); v = d; }
                lg[s] = v; lmax = fmaxf(lmax, v); }
            const float mx = dbg_block_max(red, lmax, tid);
            float ps = 0.f;
            for (int s = tid; s < SEQ; s += 512) { const float p = (lg[s] > -1e38f) ? exp2f(lg[s] - mx) : 0.f; lg[s] = p; ps += p; }
            const float tot = dbg_block_sum(red, ps, tid);
            { const int d = tid & 63, part = tid >> 6; float a = 0.f; for (int s = part; s <= t; s += 8) a += lg[s] * bf2f(VT[(size_t)(h * 64 + d) * M + rowb + s]); yacc[part * 64 + d] = a; }
            __syncthreads();
            float err = 0.f, mag = 0.f;
            if (tid < 64) { float y = 0.f; for (int p = 0; p < 8; ++p) y += yacc[p * 64 + tid]; y /= tot; const float f = bf2f(YB[(rowb + t) * 512 + h * 64 + tid]); err = fabsf(f - y); mag = fabsf(y); }
            const float emax = dbg_block_max(red, err, tid), mmax = dbg_block_max(red, mag, tid);
            if (tid == 0) atomicMax(ctl + DBG_W_MLA, __float_as_uint(emax / (mmax + 1e-20f)));
            __syncthreads();
        }
    }
}

__device__ __forceinline__ void dbg_upd(float& e, float& g, float fast, float ref) { e = fmaxf(e, fabsf(fast - ref)); g = fmaxf(g, fabsf(ref)); }
__device__ __forceinline__ void dbg_check_proj(unsigned char* ws, const int* pos, const float* g1, const float* w_in, const float* b_gate, const float* gq, const float* gkv, const float* w_uq, const float* w_ukv,
                                               LAS unsigned char* lds, int bx, int G, int tid) {
    unsigned* ctl = (unsigned*)(ws + WS_CTL);
    const bf16* H = (const bf16*)(ws + WS_H); const bf16* AQ = (const bf16*)(ws + WS_YA); const bf16* AK = (const bf16*)(ws + WS_AK); const bf16* AVT = (const bf16*)(ws + WS_AVT);
    const bf16* IQ = (const bf16*)(ws + WS_IQ); const bf16* IK = (const bf16*)(ws + WS_IK); const float* IW = (const float*)(ws + WS_IW); const bf16* GATES = (const bf16*)(ws + WS_GATES);
    const bf16* QB = (const bf16*)(ws + WS_QB); const bf16* KN = (const bf16*)(ws + WS_KN); const bf16* KR = (const bf16*)(ws + WS_KR); const bf16* VT = (const bf16*)(ws + WS_VT);
    LAS float* z = (LAS float*)lds;
    LAS float* hrow = z + 3456;
    LAS float* qb = hrow + 1024;
    LAS float* kvb = qb + 768;
    LAS float* red = kvb + 1024;
    for (int unit = bx; unit < 256; unit += G) {
        const int b = unit >> 4, t = (unit & 15) * 131 + 7; const size_t m = (size_t)b * SEQ + t;
        { float sx = 0.f; for (int k = tid; k < DM; k += 512) { const float xv = bf2f(H[m * DM + k]); sx += xv * xv; }
          const float rx = 1.f / sqrtf(dbg_block_sum(red, sx, tid) / (float)DM + EPS);
          for (int k = tid; k < DM; k += 512) hrow[k] = bf2f(H[m * DM + k]) * rx * g1[k]; }
        __syncthreads();
        for (int c = tid; c < DIN; c += 512) { float a = 0.f; for (int k = 0; k < DM; ++k) a += hrow[k] * w_in[(size_t)k * DIN + c]; z[c] = a; }
        __syncthreads();
        float e1 = 0.f, g1 = 0.f;
        for (int c = tid; c < 512; c += 512) dbg_upd(e1, g1, bf2f(AQ[m * 512 + c]), z[c] * C2A);
        float e1b = 0.f, g1b = 0.f;
        for (int c = tid; c < 64; c += 512) { dbg_upd(e1b, g1b, bf2f(AK[m * 64 + c]), z[512 + c]); dbg_upd(e1b, g1b, bf2f(AVT[((size_t)b * 64 + c) * SEQ + t]), z[576 + c]); dbg_upd(e1b, g1b, bf2f(IK[m * 64 + c]), z[896 + c]); }
        for (int c = tid; c < 256; c += 512) dbg_upd(e1b, g1b, bf2f(IQ[m * 256 + c]), z[640 + c]);
        for (int c = tid; c < 4; c += 512) dbg_upd(e1b, g1b, IW[m * 4 + c], z[960 + c]);
        float e1c = 0.f, g1c = 0.f;
        for (int c = tid; c < 2048; c += 512) dbg_upd(e1c, g1c, bf2f(GATES[m * 2048 + c]), 1.f / (1.f + expf(-(z[1380 + c] + b_gate[c]))));
        { const float ea = dbg_block_max(red, e1, tid), ga = dbg_block_max(red, g1, tid), eb = dbg_block_max(red, e1b, tid), gb = dbg_block_max(red, g1b, tid), ec = dbg_block_max(red, e1c, tid), gc = dbg_block_max(red, g1c, tid);
          if (tid == 0) atomicMax(ctl + DBG_W_DIR, __float_as_uint(fmaxf(fmaxf(ea / (ga + 1e-20f), eb / (gb + 1e-20f)), ec / (gc + 1e-20f)))); }
        float sq = 0.f; for (int k = tid; k < 256; k += 512) sq += z[964 + k] * z[964 + k];
        const float rq = 1.f / sqrtf(dbg_block_sum(red, sq, tid) / 256.f + EPS);
        float sk = 0.f; for (int k = tid; k < 128; k += 512) sk += z[1220 + k] * z[1220 + k];
        const float rk = 1.f / sqrtf(dbg_block_sum(red, sk, tid) / 128.f + EPS);
        for (int n = tid; n < 768; n += 512) { float a = 0.f; for (int k = 0; k < 256; ++k) a += z[964 + k] * rq * gq[k] * w_uq[(size_t)k * 768 + n]; qb[n] = a; }
        for (int n = tid; n < 1024; n += 512) { float a = 0.f; for (int k = 0; k < 128; ++k) a += z[1220 + k] * rk * gkv[k] * w_ukv[(size_t)k * 1024 + n]; kvb[n] = a; }
        __syncthreads();
        float e2 = 0.f, g2 = 0.f, e3 = 0.f, g3 = 0.f;
        const double p = (double)pos[m];
        for (int n = tid; n < 768; n += 512) { const int h = n / 96, c = n % 96; float ref;
            if (c < 64) ref = qb[n];
            else { const int j = c - 64, i = j >> 1; const double ang = p * pow(10000.0, -(double)(2 * i) / 32.0); const float cs = (float)cos(ang), sn = (float)sin(ang);
                   const float x1 = qb[h * 96 + 64 + i], x2 = qb[h * 96 + 80 + i]; ref = (j & 1) ? (x1 * sn + x2 * cs) : (x1 * cs - x2 * sn); }
            dbg_upd(e2, g2, bf2f(QB[m * 768 + n]), ref * C2B); }
        for (int n = tid; n < 512; n += 512) { const int h = n >> 6, d = n & 63;
            dbg_upd(e3, g3, bf2f(KN[m * 512 + n]), kvb[h * 128 + d]); dbg_upd(e3, g3, bf2f(VT[(size_t)n * M + m]), kvb[h * 128 + 64 + d]); }
        float e3b = 0.f, g3b = 0.f;
        for (int j = tid; j < 32; j += 512) { const int i = j >> 1; const double ang = p * pow(10000.0, -(double)(2 * i) / 32.0); const float cs = (float)cos(ang), sn = (float)sin(ang);
            const float x1 = z[1348 + i], x2 = z[1364 + i]; const float ref = (j & 1) ? (x1 * sn + x2 * cs) : (x1 * cs - x2 * sn); dbg_upd(e3b, g3b, bf2f(KR[m * 32 + j]), ref); }
        { const float ea = dbg_block_max(red, e2, tid), ga = dbg_block_max(red, g2, tid), eb = dbg_block_max(red, e3, tid), gb = dbg_block_max(red, g3, tid), ec = dbg_block_max(red, e3b, tid), gc = dbg_block_max(red, g3b, tid);
          if (tid == 0) { atomicMax(ctl + DBG_W_QB, __float_as_uint(ea / (ga + 1e-20f))); atomicMax(ctl + DBG_W_KV, __float_as_uint(fmaxf(eb / (gb + 1e-20f), ec / (gc + 1e-20f)))); } }
        __syncthreads();
    }
}

constexpr int DBG_W_CK = 32;
__device__ __forceinline__ void dbg_checksum(unsigned char* ws, float* outbuf, int phase, int rep, int bx, int G, int tid) {
    size_t lo = 0, hi = 0; const unsigned* base = (const unsigned*)ws;
    if (phase == 0) { lo = 1 * MiB; hi = 100 * MiB; }
    else if (phase == 1) { lo = 5 * MiB; hi = 7 * MiB; }
    else if (phase == 2) { lo = 356 * MiB; hi = 468 * MiB; }
    else if (phase == 3) { lo = 100 * MiB; hi = 164 * MiB; }
    else if (phase == 4) { lo = 356 * MiB; hi = 420 * MiB; }
    else { base = (const unsigned*)outbuf; lo = 0; hi = 128 * MiB; }
    unsigned long long acc = 0ull;
    for (size_t i = lo / 4 + (size_t)bx * 512 + tid; i < hi / 4; i += (size_t)G * 512) acc += (unsigned long long)base[i] * (unsigned long long)((i & 1023u) + 1u);
    if (phase == 1) for (size_t i = (100 * MiB) / 4 + (size_t)bx * 512 + tid; i < (356 * MiB) / 4; i += (size_t)G * 512) acc += (unsigned long long)base[i] * (unsigned long long)((i & 1023u) + 1u);
    if (phase == 2) for (size_t i = (220 * MiB) / 4 + (size_t)bx * 512 + tid; i < (228 * MiB) / 4; i += (size_t)G * 512) acc += (unsigned long long)base[i] * (unsigned long long)((i & 1023u) + 1u);
    for (int o = 1; o < 64; o <<= 1) acc += __shfl_xor(acc, o);
    if ((tid & 63) == 0) atomicAdd((unsigned long long*)(ws + WS_CTL) + (DBG_W_CK / 2 + 2 * phase + rep), acc);
}
__device__ __forceinline__ float dbg_output_scale(unsigned char* ws) {
    const unsigned* ctl = (const unsigned*)(ws + WS_CTL);
    float e[6]; for (int i = 0; i < 6; ++i) e[i] = __uint_as_float(__hip_atomic_load(ctl + 16 + i, __ATOMIC_RELAXED, __HIP_MEMORY_SCOPE_AGENT));
    const unsigned mm = __hip_atomic_load(ctl + DBG_W_MASK, __ATOMIC_RELAXED, __HIP_MEMORY_SCOPE_AGENT);
#define DBG_BK(x) ((x) < 0.04f ? 0 : ((x) < 0.2f ? 1 : 2))
#if DBG_CHECK == 3
    { const unsigned long long* ck = (const unsigned long long*)(ws + WS_CTL) + DBG_W_CK / 2; int k = 0;
      for (int p = 0; p < 6; ++p) { const unsigned long long a = __hip_atomic_load(ck + 2 * p, __ATOMIC_RELAXED, __HIP_MEMORY_SCOPE_AGENT), b = __hip_atomic_load(ck + 2 * p + 1, __ATOMIC_RELAXED, __HIP_MEMORY_SCOPE_AGENT); if (a != b) k += (1 << p); }
      (void)e; (void)mm; return 1.f + (float)k; }
    const int c1 = 0, c2 = 0, c3 = 0;
#elif DBG_CHECK == 1
    const int c1 = DBG_BK(e[0]), c2 = mm <= 20u ? 0 : (mm <= 2000u ? 1 : 2), c3 = DBG_BK(e[2]);
#else
    const int c1 = DBG_BK(e[3]), c2 = DBG_BK(e[4]), c3 = DBG_BK(e[5]);
#endif
    return 1.f + (float)(c1 + 3 * c2 + 9 * c3);
}
#endif
struct Args { const void* in[17]; float* out; unsigned char* ws; int ph_lo, ph_hi; };
__global__ void __launch_bounds__(NWAVES * 64, 2) trunk_fwd(Args args) {
    extern __shared__ __attribute__((aligned(16))) unsigned char lds[];
    Frame F;
    F.lds = (LAS unsigned char*)lds;
    F.tid = threadIdx.x; F.lane = F.tid & 63; F.wave = __builtin_amdgcn_readfirstlane(F.tid >> 6);
    F.G = gridDim.x; F.bx = blockIdx.x;
    F.x = (const float*)args.in[0]; F.pos = (const int*)args.in[1]; F.rel_bias = (const float*)args.in[15]; F.out = args.out; F.ws = args.ws;
    volatile LAS unsigned* MISC = (volatile LAS unsigned*)(F.lds + MISC_OFF);
    if (F.tid < 32) MISC[F.tid] = 0u;
#if defined(DBG_LDS_FILL)
    for (int i = F.tid; i < MISC_OFF / 4; i += NWAVES * 64) ((LAS unsigned*)F.lds)[i] = 0xffffffffu;
#endif
    __syncthreads();
    unsigned* ctl = (unsigned*)(F.ws + WS_CTL);
#if MK_ONE_LAUNCH
    XcdBarrier bar = xcd_barrier_post(ctl + CW_BAR, MISC + 8);
#define GRID_BAR() xcd_barrier(bar)
#else
#define GRID_BAR() do { } while (0)
#endif
    const float* g1 = (const float*)args.in[2]; const float* w_in = (const float*)args.in[3]; const float* b_gate = (const float*)args.in[4];
    const float* gq = (const float*)args.in[5]; const float* gkv = (const float*)args.in[6]; const float* w_uq = (const float*)args.in[7]; const float* w_ukv = (const float*)args.in[8];
    const float* w_a = (const float*)args.in[9]; const float* w_b = (const float*)args.in[10]; const float* w_out = (const float*)args.in[11]; const float* g2 = (const float*)args.in[12];
    const float* w_ff1 = (const float*)args.in[13]; const float* w_ff2 = (const float*)args.in[14]; const float* gf = (const float*)args.in[16];
#define PHASE_FRAME() \
    { int t_ = threadIdx.x; asm volatile("" : "+v"(t_)); F.tid = t_; F.lane = t_ & 63; F.wave = __builtin_amdgcn_readfirstlane(t_ >> 6); } \
    size_t z0_ = 0; asm volatile("" : "+s"(z0_)); unsigned char* ws = args.ws + z0_; F.ws = ws;     \
    bf16* WB = (bf16*)(ws + WS_W); bf16* H = (bf16*)(ws + WS_H); bf16* YA = (bf16*)(ws + WS_YA); \
    bf16* IQ = (bf16*)(ws + WS_IQ); bf16* CQ = (bf16*)(ws + WS_CQ); bf16* CKV = (bf16*)(ws + WS_CKV); bf16* AK = (bf16*)(ws + WS_AK); bf16* AVT = (bf16*)(ws + WS_AVT); \
    bf16* IK = (bf16*)(ws + WS_IK); bf16* KR = (bf16*)(ws + WS_KR); bf16* GATES = (bf16*)(ws + WS_GATES); bf16* QB = (bf16*)(ws + WS_QB); bf16* KN = (bf16*)(ws + WS_KN); \
    bf16* VT = (bf16*)(ws + WS_VT); bf16* MERGED = (bf16*)(ws + WS_MERGED); bf16* HID = (bf16*)(ws + WS_HID); \
    float* CS = (float*)(ws + WS_CS); float* SSQQ = (float*)(ws + WS_SSQQ); float* SSQKV = (float*)(ws + WS_SSQKV); float* IW = (float*)(ws + WS_IW); \
    (void)WB; (void)H; (void)YA; (void)IQ; (void)CQ; (void)CKV; (void)AK; (void)AVT; (void)IK; (void)KR; (void)GATES; (void)QB; (void)KN; (void)VT; (void)MERGED; (void)HID; (void)CS; (void)SSQQ; (void)SSQKV; (void)IW;
    const int lo = args.ph_lo, hi = args.ph_hi;
#ifndef DBG_ATT_SCALE
#define DBG_ATT_SCALE 1.0f
#endif
#ifndef PH_ENABLE
#define PH_ENABLE 0x3ff
#endif
#define PHON(k) (((PH_ENABLE) >> (k)) & 1)
#define IN(p) (lo <= (p) && (p) < hi)
#if defined(DBG_CHECK)
    if (lo == 1000) { dbg_check_attn(args.ws, F.out, F.pos, F.rel_bias, F.lds, F.bx, F.G, F.tid); return; }
    if (lo >= 2000 && lo < 2100) { dbg_checksum(args.ws, F.out, (lo - 2000) >> 1, (lo - 2000) & 1, F.bx, F.G, F.tid); return; }
    if (lo == 3000) {
        u32x4* w4 = (u32x4*)(args.ws + DBG_FILL_LO); const u32x4 nn = (u32x4){0xffffffffu, 0xffffffffu, 0xffffffffu, 0xffffffffu};
        for (size_t i = (size_t)F.bx * 512 + F.tid; i < (DBG_FILL_HI - DBG_FILL_LO) / 16; i += (size_t)F.G * 512) w4[i] = nn;
        u32x4* o4 = (u32x4*)F.out; for (size_t i = (size_t)F.bx * 512 + F.tid; i < (size_t)M * DM * 4 / 16; i += (size_t)F.G * 512) o4[i] = nn;
        return; }
    if (lo == 4000) {
        const unsigned* src = (const unsigned*)(args.ws + (size_t)(DBG_PROBE_OFF) * MiB);
        for (size_t i = (size_t)F.bx * 512 + F.tid; i < (size_t)M * DM; i += (size_t)F.G * 512) { const unsigned w = src[i];
            float a = __uint_as_float(w << 16), b = __uint_as_float(w & 0xffff0000u); if (!(fabsf(a) < 1e30f)) a = 0.f; if (!(fabsf(b) < 1e30f)) b = 0.f; F.out[i] = a + 2.f * b; }
        return; }
    if (lo == 1001) { dbg_check_proj(args.ws, F.pos, g1, w_in, b_gate, gq, gkv, w_uq, w_ukv, F.lds, F.bx, F.G, F.tid); return; }
#endif
#if defined(DBG_SPLIT_BR)
    if (lo >= 5000 && lo < 5008) { PHASE_FRAME();
        pg8::Gemm g{YA, WB + W_AB_OFF, 2 * M, 2048, 512}; pg8::BranchOrder S; S.init(F.G, F.bx, lo & 1); pg8::EpiBranch E{MERGED, GATES};
        pg8::gemm_phase<pg8::EpiBranch, pg8::BranchOrder, true, true, false, true>(F.lds, g, S, E);
        return; }
#endif
#if defined(DBG_TIME_PH)
    unsigned long long tacc_ = 0ull, tprev_ = __builtin_amdgcn_s_memrealtime();
#define TSTAMP(k_) do { const unsigned long long tn_ = __builtin_amdgcn_s_memrealtime(); if ((k_) == (DBG_TIME_PH)) tacc_ += tn_ - tprev_; tprev_ = tn_; } while (0)
#else
#define TSTAMP(k_) do { } while (0)
#endif
    for (int l = 0; l < DEPTH; ++l) {
        const int p0 = l * PH_PER_LAYER;
        const float* xcur = (l == 0) ? F.x : F.out;
        if (PHON(0) && IN(p0 + 0) && l == 0) { PHASE_FRAME();
            rope_table(F); pos_tables(F);
            prep_weights<0>(F, 0, 0, g1, g2, w_in, gq, gkv, w_uq, w_ukv, w_a, w_b, w_out, w_ff1, w_ff2);
            init_rows(F);
            GRID_BAR(); TSTAMP(0);
        }
        if (PHON(1) && IN(p0 + 1)) { PHASE_FRAME();
            quant_rows(F, 1); GRID_BAR();
            pg8::Gemm g{(const bf16*)(ws + WS_XB8), WB + W_IN_OFF, M, NIN, DM / 2}; pg8::StaticOrder S; S.init(M, NIN, F.G, F.bx);
            pg8::EpiIn8 E{YA, IQ, CQ, CKV, AK, AVT, IK, KR, GATES, IW, SSQQ, SSQKV, CS, b_gate + l * 2048, (const float*)(ws + WS_SX), (const float*)(ws + WS_SWI)};
            pg8::gemm_phase<pg8::EpiIn8, pg8::StaticOrder, true, true, true, true>(F.lds, g, S, E);
            GRID_BAR(); TSTAMP(1);
        }
        if (PHON(2) && IN(p0 + 2)) { PHASE_FRAME();
#ifndef SUB_ENABLE
#define SUB_ENABLE 0xf
#endif
            if ((SUB_ENABLE) & 1) { pg8::Gemm g{CQ, WB + W_UQ_OFF, M, 768, 256}; pg8::StaticOrder S; S.init(M, 768, F.G, F.bx); pg8::EpiUQ E{QB, SSQQ, CS};
              pg8::gemm_phase<pg8::EpiUQ, pg8::StaticOrder, true, true, false, true>(F.lds, g, S, E); }
            if ((SUB_ENABLE) & 2) { pg8::Gemm g{CKV, WB + W_UK_OFF, M, 512, 128}; pg8::StaticOrder S; S.init(M, 512, F.G, F.bx); pg8::EpiUK E{KN, SSQKV};
              pg8::gemm_phase<pg8::EpiUK, pg8::StaticOrder, true, true, false, true>(F.lds, g, S, E); }
            if ((SUB_ENABLE) & 4) { pg8::Gemm g{WB + W_UV_OFF, CKV, 512, M, 128}; pg8::StaticOrder S; S.init(512, M, F.G, F.bx); pg8::EpiUV E{VT, SSQKV};
              pg8::gemm_phase<pg8::EpiUV, pg8::StaticOrder, true, true, true, false>(F.lds, g, S, E); }
            if ((SUB_ENABLE) & 8) idx_phase(F);
#if defined(DBG_CHECK)
            if (l == 0) dbg_copy_aq(F.ws, F.out, F.bx, F.G, F.tid);
#endif
            GRID_BAR(); TSTAMP(2);
        }
        if (PHON(3) && IN(p0 + 3)) { PHASE_FRAME(); attn_phase(F);
            prep_weights<1>(F, l, 49152, g1, g2, w_in, gq, gkv, w_uq, w_ukv, w_a, w_b, w_out, w_ff1, w_ff2);
            if (l + 1 < DEPTH) prep_weights<0>(F, l + 1, 49152, g1, g2, w_in, gq, gkv, w_uq, w_ukv, w_a, w_b, w_out, w_ff1, w_ff2);
            { unsigned long long* rs = (unsigned long long*)(ws + WS_RSS);
              unsigned* rm = (unsigned*)(ws + WS_RMAX);
              for (int e = F.bx * (NWAVES * 64) + F.tid; e < 2 * M; e += F.G * NWAVES * 64) { rs[e] = 0ull; rm[e] = 0u; } }
            GRID_BAR(); TSTAMP(3); }
        if (PHON(4) && IN(p0 + 4)) { PHASE_FRAME();
            pg8::Gemm g{YA, WB + W_AB_OFF, 2 * M, 2048, 512}; pg8::BranchOrder S; S.init(F.G, F.bx); pg8::EpiBranch E{MERGED, GATES};
            pg8::gemm_phase<pg8::EpiBranch, pg8::BranchOrder, true, true, false, true>(F.lds, g, S, E);
            GRID_BAR(); TSTAMP(4);
        }
        if (PHON(5) && IN(p0 + 5)) { PHASE_FRAME();
            pg8::Gemm g{MERGED, WB + W_OUT_OFF, M, DM, DM}; pg8::StaticOrder S; S.init(M, DM, F.G, F.bx); pg8::EpiResT<true> E{H, (unsigned long long*)(ws + WS_RSS), (unsigned*)(ws + WS_RMAX)};
            pg8::gemm_phase<pg8::EpiResT<true>, pg8::StaticOrder, true, true, false, true>(F.lds, g, S, E);
            GRID_BAR(); TSTAMP(5);
        }
        if (PHON(7) && IN(p0 + 7)) { PHASE_FRAME();
            quant_rows(F, 0); GRID_BAR();
            pg8::Gemm g{(const bf16*)(ws + WS_XB8), WB + W_FF1_OFF, M, DFF, DM / 2}; pg8::StaticOrder S; S.init(M, DFF, F.G, F.bx);
            pg8::EpiFF18 E{HID, (const float*)(ws + WS_SX), (const float*)(ws + WS_SWF)};
            pg8::gemm_phase<pg8::EpiFF18, pg8::StaticOrder, true, true, true, true>(F.lds, g, S, E);
            GRID_BAR(); TSTAMP(7);
        }
        if (PHON(8) && IN(p0 + 8)) { PHASE_FRAME();
            pg8::Gemm g{HID, WB + W_FF2_OFF, M, DM, DFF}; pg8::StaticOrder S; S.init(M, DM, F.G, F.bx); pg8::EpiResT<true> E{H, (unsigned long long*)(ws + WS_RSS) + M, (unsigned*)(ws + WS_RMAX) + M};
            pg8::gemm_phase<pg8::EpiResT<true>, pg8::StaticOrder, true, true, true, true>(F.lds, g, S, E);
            GRID_BAR(); TSTAMP(8);
        }
    }
#if defined(DBG_TIME_PH)
    if (F.bx == 0 && F.tid == 0) __hip_atomic_store((unsigned*)(args.ws + WS_CTL) + 40, (unsigned)(tacc_ / (unsigned long long)(DBG_TIME_DIV)), __ATOMIC_RELAXED, __HIP_MEMORY_SCOPE_AGENT);
    GRID_BAR();
#endif
    if (PHON(9) && IN(DEPTH * PH_PER_LAYER)) { PHASE_FRAME(); float osc = 1.f;
#if defined(DBG_TIME_PH)
        osc = 1.f + (float)__hip_atomic_load((unsigned*)(args.ws + WS_CTL) + 40, __ATOMIC_RELAXED, __HIP_MEMORY_SCOPE_AGENT);
#endif
#if defined(DBG_CHECK)
        osc = dbg_output_scale(F.ws);
#endif
        final_norm(F, gf, osc); }
#undef IN
}

extern "C" void kernel_launch(void* const* d_in, const int* in_sizes, int n_in, void* d_out, int out_size, void* d_ws, size_t ws_size, hipStream_t stream) {
    static int grid = 0;
    if (grid == 0) {
        if (n_in != 17 || in_sizes[0] != M * DM || out_size != M * DM || ws_size < WS_END) { fprintf(stderr, "kernel_launch: unexpected shapes (n_in %d, in0 %d, out %d, ws %zu); nothing launched\n", n_in, n_in > 0 ? in_sizes[0] : -1, out_size, ws_size); grid = -1; return; }
        int dev = 0, cus = 0, per_cu = 0;
        if (hipGetDevice(&dev) != hipSuccess || hipDeviceGetAttribute(&cus, hipDeviceAttributeMultiprocessorCount, dev) != hipSuccess) { grid = -1; return; }
        if (hipFuncSetAttribute((const void*)trunk_fwd, hipFuncAttributeMaxDynamicSharedMemorySize, LDS_BYTES) != hipSuccess) { fprintf(stderr, "kernel_launch: hipFuncSetAttribute failed\n"); grid = -1; return; }
        if (hipOccupancyMaxActiveBlocksPerMultiprocessor(&per_cu, (const void*)trunk_fwd, NWAVES * 64, LDS_BYTES) != hipSuccess || per_cu < 1)
            fprintf(stderr, "kernel_launch: note: occupancy query reports %d workgroups per CU\n", per_cu);
        (void)hipGetLastError();
        grid = cus;
    }
    if (grid < 0) return;
    if (hipMemsetAsync((char*)d_ws + WS_CTL, 0, CTL_ZERO_BYTES, stream) != hipSuccess) return;
    Args a{};
    for (int i = 0; i < 17; ++i) a.in[i] = d_in[i];
    a.out = (float*)d_out; a.ws = (unsigned char*)d_ws;
#if MK_ONE_LAUNCH
    a.ph_lo = 0; a.ph_hi = N_PHASES;
    hipLaunchKernelGGL(trunk_fwd, dim3(grid), dim3(NWAVES * 64), LDS_BYTES, stream, a);
#elif defined(DBG_CHECK) && DBG_CHECK == 3
#define DBG_L(a_, b_) do { a.ph_lo = (a_); a.ph_hi = (b_); hipLaunchKernelGGL(trunk_fwd, dim3(grid), dim3(NWAVES * 64), LDS_BYTES, stream, a); } while (0)
    DBG_L(0, 1); DBG_L(2000, 2001); DBG_L(0, 1); DBG_L(2001, 2002);
    DBG_L(1, 2); DBG_L(2002, 2003); DBG_L(1, 2); DBG_L(2003, 2004);
    DBG_L(2, 3); DBG_L(2004, 2005); DBG_L(2, 3); DBG_L(2005, 2006);
    DBG_L(3, 4); DBG_L(2006, 2007); DBG_L(1, 2); DBG_L(3, 4); DBG_L(2007, 2008);
    DBG_L(4, 5); DBG_L(2008, 2009); DBG_L(2, 3); DBG_L(4, 5); DBG_L(2009, 2010);
    DBG_L(5, 6); DBG_L(2010, 2011); DBG_L(5, 6); DBG_L(2011, 2012);
    for (int p = 6; p < N_PHASES; ++p) DBG_L(p, p + 1);
#elif defined(DBG_CHECK) && DBG_CHECK == 5
    a.ph_lo = 3000; a.ph_hi = 3001; hipLaunchKernelGGL(trunk_fwd, dim3(grid), dim3(NWAVES * 64), LDS_BYTES, stream, a);
    for (int p = 0; p < (DBG_PROBE_PH); ++p) { a.ph_lo = p; a.ph_hi = p + 1; hipLaunchKernelGGL(trunk_fwd, dim3(grid), dim3(NWAVES * 64), LDS_BYTES, stream, a); }
    if ((DBG_PROBE_OFF) >= 0) { a.ph_lo = 4000; a.ph_hi = 4001; hipLaunchKernelGGL(trunk_fwd, dim3(grid), dim3(NWAVES * 64), LDS_BYTES, stream, a); }
#elif defined(DBG_CHECK) && DBG_CHECK == 4
    a.ph_lo = 3000; a.ph_hi = 3001; hipLaunchKernelGGL(trunk_fwd, dim3(grid), dim3(NWAVES * 64), LDS_BYTES, stream, a);
    for (int p = 0; p < N_PHASES; ++p) { a.ph_lo = p; a.ph_hi = p + 1; hipLaunchKernelGGL(trunk_fwd, dim3(grid), dim3(NWAVES * 64), LDS_BYTES, stream, a); }
#else
    for (int p = 0; p < N_PHASES; ++p) {
#if defined(DBG_SPLIT_BR)
        if (p < DEPTH * PH_PER_LAYER && p % PH_PER_LAYER == 4) { for (int br = 0; br < 2; ++br) { a.ph_lo = 5000 + 2 * (p / PH_PER_LAYER) + br; a.ph_hi = a.ph_lo + 1; hipLaunchKernelGGL(trunk_fwd, dim3(grid), dim3(NWAVES * 64), LDS_BYTES, stream, a); } continue; }
#endif
        a.ph_lo = p; a.ph_hi = p + 1; hipLaunchKernelGGL(trunk_fwd, dim3(grid), dim3(NWAVES * 64), LDS_BYTES, stream, a);
#if defined(DBG_CHECK)
        if (p == 3) { a.ph_lo = 1000; a.ph_hi = 1001; hipLaunchKernelGGL(trunk_fwd, dim3(grid), dim3(NWAVES * 64), LDS_BYTES, stream, a); }
        if (p == 2) { a.ph_lo = 1001; a.ph_hi = 1002; hipLaunchKernelGGL(trunk_fwd, dim3(grid), dim3(NWAVES * 64), LDS_BYTES, stream, a); }
#endif
    }
#endif
}
```

```cpp
#include <hip/hip_runtime.h>
#include <cstdio>
#include <cstdint>
namespace pg8 {
#define PG8_LAS __attribute__((address_space(3)))
typedef unsigned short bf16_t;
typedef short bf16x8 __attribute__((ext_vector_type(8)));
typedef float f32x4 __attribute__((ext_vector_type(4)));
typedef unsigned u32x4 __attribute__((ext_vector_type(4)));
constexpr int BM = 256, BK = 64, HALF = 128, HTB = HALF * BK * 2  , STAGE_BYTES = 8 * HTB, NXCD = 8, WGM = 8;

__host__ __device__ __forceinline__ int lds_byte(int r, int c) { const int st = (r >> 4) * 2 + (c >> 5), rr = r & 15, cc = c & 31, ob = rr * 64 + cc * 2; return st * 1024 + (ob ^ (((ob >> 9) & 1) << 5)); }
__host__ __device__ __forceinline__ void stage_rc(int b, int& R, int& C) { const int st = b / 1024, sb = b % 1024, swz = sb ^ (((sb >> 9) & 1) << 5); R = (st >> 1) * 16 + swz / 64; C = (st & 1) * 32 + (swz % 64) / 2; }
__host__ __device__ __forceinline__ int perm32(int rho) { const int n = rho >> 4, i = rho & 15; return 8 * (i >> 2) + 4 * n + (i & 3); }

struct Unit { int pm, pn; };
struct Gemm { const bf16_t* A; const bf16_t* Bt; int M, N, K; };

struct StaticOrder {
    int nM, nN, nwg, G, c;
    __host__ __device__ void init(int M, int N, int G_, int c_) { nM = M / BM; nN = N / BM; nwg = nM * nN; G = G_; c = c_; }
    __host__ __device__ bool next(int i, Unit& u) const {
        const long L = (long)i * G + c; if (L >= nwg) return false;
        int wgid = (int)L; { const int q = nwg / NXCD, r = nwg % NXCD, xcd = wgid % NXCD, off = wgid / NXCD; wgid = (xcd < r ? xcd * (q + 1) : r * (q + 1) + (xcd - r) * q) + off; }
        const int nig = WGM * nN, gid = wgid / nig, fm = gid * WGM, gsz = (nM - fm) < WGM ? (nM - fm) : WGM;
        u.pm = fm + ((wgid % nig) % gsz); u.pn = (wgid % nig) / gsz; return true;
    }
    __device__ __forceinline__ void a_ready(const Unit&) const {}
    __device__ __forceinline__ void done(const Unit&) const {}
};

typedef float f32x2c_t __attribute__((ext_vector_type(2))); typedef __bf16 bf16x2c_t __attribute__((ext_vector_type(2)));
__device__ __forceinline__ unsigned cvt_pk_bf16(float lo, float hi) { const f32x2c_t v = {lo, hi}; const bf16x2c_t b = __builtin_convertvector(v, bf16x2c_t); return __builtin_bit_cast(unsigned, b); }
typedef float f32x2 __attribute__((ext_vector_type(2)));
typedef int i32x4 __attribute__((ext_vector_type(4)));
__device__ __forceinline__ f32x4 mma16(const bf16x8 a, const bf16x8 b, const f32x4 c) { return __builtin_amdgcn_mfma_f32_16x16x32_bf16(a, b, c, 0, 0, 0); }
__device__ __forceinline__ i32x4 mma16(const bf16x8 a, const bf16x8 b, const i32x4 c) { return __builtin_amdgcn_mfma_i32_16x16x64_i8(__builtin_bit_cast(i32x4, a), __builtin_bit_cast(i32x4, b), c, 0, 0, 0); }
__device__ __forceinline__ f32x4 acc_zero(f32x4*) { return (f32x4){0.f, 0.f, 0.f, 0.f}; }
__device__ __forceinline__ i32x4 acc_zero(i32x4*) { return (i32x4){0, 0, 0, 0}; }
template <class Epi, class Sched, bool ALIGN_EPI = false, bool SP2 = false, bool AKT = false, bool BKT = false>
__device__ __forceinline__ void gemm_phase(PG8_LAS unsigned char* lds, const Gemm g, const Sched& S, const Epi& E) {
    int tid_ = threadIdx.x; asm volatile("" : "+v"(tid_));
    const int tid = tid_, wid = __builtin_amdgcn_readfirstlane(tid >> 6), lane = tid & 63, wr = wid >> 2, wc = wid & 3, fr = lane & 15, fq = lane >> 4;
    int Kx_ = g.K; asm volatile("" : "+s"(Kx_)); const int K = Kx_, nt = K / BK;
    unsigned voffA[2], voffB[2];
#pragma unroll
    for (int i = 0; i < 2; ++i) { int R, C; stage_rc(tid * 16 + i * 8192, R, C); const int Rb = Epi::PERM ? ((R & ~31) + perm32(R & 31)) : R;
        voffA[i] = AKT ? (unsigned)(R * BK + C) * 2u : (unsigned)(R * K + C) * 2u; voffB[i] = BKT ? (unsigned)(Rb * BK + C) * 2u : (unsigned)(Rb * K + C) * 2u; }
    const unsigned kstepA = AKT ? (unsigned)(BM * BK * 2) : (unsigned)(BK * 2), kstepB = BKT ? (unsigned)(BM * BK * 2) : (unsigned)(BK * 2);
    const unsigned hstepA = AKT ? (unsigned)(HALF * BK * 2) : (unsigned)(HALF * K * 2), hstepB = BKT ? (unsigned)(HALF * BK * 2) : (unsigned)(HALF * K * 2);
    const unsigned tstep = (unsigned)(BM * K * 2);
    const __amdgpu_buffer_rsrc_t rsA = __builtin_amdgcn_make_buffer_rsrc((void*)g.A, 0, -1, 0x00020000), rsB = __builtin_amdgcn_make_buffer_rsrc((void*)g.Bt, 0, -1, 0x00020000);
    const unsigned ldsw = (unsigned)wid * 1024u;
    const int aoff = lds_byte(wr * 64 + fr, fq * 8), boff = lds_byte(wc * 32 + fr, fq * 8);
#define PG8_SA(b, h) (((b) * 2 + (h)) * HTB)
#define PG8_SB(b, h) ((4 + (b) * 2 + (h)) * HTB)
#define PG8_STAGE(bufoff, soff, voff) do { _Pragma("unroll") for (int _i = 0; _i < 2; ++_i) \
        __builtin_amdgcn_raw_ptr_buffer_load_lds(PG8_RS(voff), (PG8_LAS void*)(lds + (bufoff) + ldsw + _i * 8192), 16, (int)(voff)[_i], (int)(soff), 0, 0); } while (0)
#define PG8_RS(voff) (((voff) == voffA) ? rsA : rsB)
#define PG8_LDA(dst, b, h) do { _Pragma("unroll") for (int m = 0; m < 4; ++m) _Pragma("unroll") for (int k = 0; k < 2; ++k) dst[m][k] = *(const PG8_LAS bf16x8*)(lds + PG8_SA(b, h) + aoff + m * 2048 + k * 1024); } while (0)
#define PG8_LDB(dst, b, h) do { _Pragma("unroll") for (int n = 0; n < 2; ++n) _Pragma("unroll") for (int k = 0; k < 2; ++k) dst[n][k] = *(const PG8_LAS bf16x8*)(lds + PG8_SB(b, h) + boff + n * 2048 + k * 1024); } while (0)
#define PG8_MMA(ai, bj, At, Bt) do { __builtin_amdgcn_s_setprio(1); _Pragma("unroll") for (int m = 0; m < 4; ++m) _Pragma("unroll") for (int n = 0; n < 2; ++n) _Pragma("unroll") for (int k = 0; k < 2; ++k) \
        acc[ai][bj][m][n] = mma16(Bt[n][k], At[m][k], acc[ai][bj][m][n]); __builtin_amdgcn_s_setprio(0); } while (0)
#define PG8_WAIT_V(n) asm volatile("s_waitcnt vmcnt(" #n ")" ::: "memory")
#define PG8_WAIT_L(n) asm volatile("s_waitcnt lgkmcnt(" #n ")" ::: "memory")
#define PG8_BAR __builtin_amdgcn_s_barrier()
#define PG8_SCHED __builtin_amdgcn_sched_barrier(0)
    Unit cur, nxt; int ui = 0;
    if (!S.next(0, cur)) return;
    typedef typename Epi::acc_t acc_t;
    acc_t acc[2][2][4][2];
#pragma unroll
    for (int a = 0; a < 2; ++a)
#pragma unroll
        for (int b = 0; b < 2; ++b)
#pragma unroll
            for (int m = 0; m < 4; ++m)
#pragma unroll
                for (int n = 0; n < 2; ++n) acc[a][b][m][n] = acc_zero((acc_t*)nullptr);
    bf16x8 At[4][2], B0[2][2], B1[2][2];
    unsigned cA = (unsigned)__builtin_amdgcn_readfirstlane(cur.pm) * tstep, cB = (unsigned)__builtin_amdgcn_readfirstlane(cur.pn) * tstep;
    S.a_ready(cur);
    if constexpr (SP2) {
        PG8_STAGE(PG8_SB(0, 0), cB, voffB); PG8_STAGE(PG8_SB(0, 1), cB + hstepB, voffB); PG8_STAGE(PG8_SA(0, 0), cA, voffA); PG8_STAGE(PG8_SA(0, 1), cA + hstepA, voffA);
        if (wr == 1) PG8_BAR;
        PG8_WAIT_V(2); PG8_BAR;
        PG8_STAGE(PG8_SB(1, 0), cB + kstepB, voffB); PG8_STAGE(PG8_SA(1, 0), cA + kstepA, voffA); PG8_STAGE(PG8_SB(1, 1), cB + hstepB + kstepB, voffB);
        PG8_WAIT_V(6); PG8_BAR;
    } else {
        PG8_STAGE(PG8_SB(0, 0), cB, voffB); PG8_STAGE(PG8_SA(0, 0), cA, voffA); PG8_STAGE(PG8_SB(0, 1), cB + hstepB, voffB); PG8_STAGE(PG8_SA(0, 1), cA + hstepA, voffA);
        if (wr == 1) PG8_BAR;
        PG8_WAIT_V(4); PG8_BAR;
        PG8_STAGE(PG8_SB(1, 0), cB + kstepB, voffB); PG8_STAGE(PG8_SA(1, 0), cA + kstepA, voffA); PG8_STAGE(PG8_SB(1, 1), cB + hstepB + kstepB, voffB);
        PG8_WAIT_V(6); PG8_BAR;
    }
    for (;;) {
        const bool has_next = S.next(ui + 1, nxt);
        const unsigned nA = has_next ? (unsigned)__builtin_amdgcn_readfirstlane(nxt.pm) * tstep : cA, nB = has_next ? (unsigned)__builtin_amdgcn_readfirstlane(nxt.pn) * tstep : cB;
        asm volatile(".p2align 8" ::: "memory");
        for (int t = 0; t < nt; t += 2) {
            const bool last = (t == nt - 2);
            const unsigned a1 = cA + (unsigned)(t + 1) * kstepA;
            const unsigned a2 = last ? nA : cA + (unsigned)(t + 2) * kstepA, b2 = last ? nB : cB + (unsigned)(t + 2) * kstepB;
            const unsigned a3 = a2 + kstepA, b3 = b2 + kstepB;
            if (last && has_next) S.a_ready(nxt);
            if constexpr (SP2) {
            PG8_LDB(B0, 0, 0); PG8_LDB(B1, 0, 1); PG8_SCHED; PG8_LDA(At, 0, 0); PG8_STAGE(PG8_SA(1, 1), a1 + hstepA, voffA);
            PG8_WAIT_V(8); PG8_WAIT_L(0); PG8_BAR; PG8_MMA(0, 0, At, B0); PG8_MMA(0, 1, At, B1); PG8_BAR; PG8_SCHED;
            PG8_LDA(At, 0, 1); PG8_STAGE(PG8_SB(0, 0), b2, voffB); PG8_STAGE(PG8_SB(0, 1), b2 + hstepB, voffB); PG8_STAGE(PG8_SA(0, 0), a2, voffA);
            PG8_WAIT_V(8); PG8_WAIT_L(0); PG8_BAR; PG8_MMA(1, 0, At, B0); PG8_MMA(1, 1, At, B1); PG8_BAR; PG8_SCHED;
            PG8_LDB(B0, 1, 0); PG8_LDB(B1, 1, 1); PG8_SCHED; PG8_LDA(At, 1, 0); PG8_STAGE(PG8_SA(0, 1), a2 + hstepA, voffA);
            PG8_WAIT_V(8); PG8_WAIT_L(0); PG8_BAR; PG8_MMA(0, 0, At, B0); PG8_MMA(0, 1, At, B1); PG8_BAR; PG8_SCHED;
            PG8_LDA(At, 1, 1); PG8_STAGE(PG8_SB(1, 0), b3, voffB); PG8_STAGE(PG8_SB(1, 1), b3 + hstepB, voffB); PG8_STAGE(PG8_SA(1, 0), a3, voffA);
            PG8_WAIT_V(8); PG8_WAIT_L(0); PG8_BAR; PG8_MMA(1, 0, At, B0); PG8_MMA(1, 1, At, B1); PG8_BAR; PG8_SCHED;
            } else {
            PG8_LDB(B0, 0, 0); PG8_SCHED; PG8_LDA(At, 0, 0); PG8_STAGE(PG8_SA(1, 1), a1 + hstepA, voffA);
            PG8_WAIT_L(8); PG8_BAR; PG8_WAIT_L(0); PG8_MMA(0, 0, At, B0); PG8_BAR; PG8_SCHED;
            PG8_LDB(B1, 0, 1); PG8_STAGE(PG8_SB(0, 0), b2, voffB);
            PG8_BAR; PG8_WAIT_L(0); PG8_MMA(0, 1, At, B1); PG8_BAR;
            PG8_LDA(At, 0, 1); PG8_STAGE(PG8_SA(0, 0), a2, voffA);
            PG8_BAR; PG8_WAIT_L(0); PG8_MMA(1, 0, At, B0); PG8_BAR; PG8_SCHED;
            PG8_STAGE(PG8_SB(0, 1), b2 + hstepB, voffB);
            PG8_WAIT_V(6); PG8_BAR; PG8_MMA(1, 1, At, B1); PG8_BAR;
            PG8_LDB(B0, 1, 0); PG8_SCHED; PG8_LDA(At, 1, 0); PG8_STAGE(PG8_SA(0, 1), a2 + hstepA, voffA);
            PG8_WAIT_L(8); PG8_BAR; PG8_WAIT_L(0); PG8_MMA(0, 0, At, B0); PG8_BAR; PG8_SCHED;
            PG8_LDB(B1, 1, 1); PG8_STAGE(PG8_SB(1, 0), b3, voffB);
            PG8_BAR; PG8_WAIT_L(0); PG8_MMA(0, 1, At, B1); PG8_BAR;
            PG8_LDA(At, 1, 1); PG8_STAGE(PG8_SA(1, 0), a3, voffA);
            PG8_BAR; PG8_WAIT_L(0); PG8_MMA(1, 0, At, B0); PG8_BAR; PG8_SCHED;
            PG8_STAGE(PG8_SB(1, 1), b3 + hstepB, voffB);
            PG8_WAIT_V(6); PG8_BAR; PG8_MMA(1, 1, At, B1); PG8_BAR;
            }
        }
        if constexpr (ALIGN_EPI) { if (wr == 0) PG8_BAR; }
        if constexpr (!Epi::AFTER_DRAIN) { E(acc, cur, wr, wc, fr, fq); S.done(cur); }
        if (!has_next) break;
#pragma unroll
        for (int a = 0; a < 2; ++a)
#pragma unroll
            for (int b = 0; b < 2; ++b)
#pragma unroll
                for (int m = 0; m < 4; ++m)
#pragma unroll
                    for (int n = 0; n < 2; ++n) acc[a][b][m][n] = acc_zero((acc_t*)nullptr);
        cur = nxt; cA = nA; cB = nB; ++ui;
        if constexpr (ALIGN_EPI) { if (wr == 1) PG8_BAR; }
    }
    PG8_WAIT_V(0);
    if constexpr (!ALIGN_EPI) { if (wr == 0) PG8_BAR; }
    PG8_BAR;
    if constexpr (Epi::AFTER_DRAIN) { E.fused(acc, cur, wr, wc, fr, fq, lds, wid, lane); S.done(cur); }
#undef PG8_SA
#undef PG8_SB
#undef PG8_STAGE
#undef PG8_RS
#undef PG8_LDA
#undef PG8_LDB
#undef PG8_MMA
#undef PG8_WAIT_V
#undef PG8_WAIT_L
#undef PG8_BAR
#undef PG8_SCHED
}
}
#define LAS __attribute__((address_space(3)))
#define XB_TMO      128
#define XB_XCNT(j)  (256  + 64 * (j))
#define XB_XSUB(j)  (1280 + 64 * (j))
#define XB_XGEN(j)  (2304 + 64 * (j))
#define XB_TOP      3328
#define XB_TOPGEN   3392
#define XCD_BAR_WORDS 3456
#define XB_SPIN_CAP (1u << 18)

__device__ __forceinline__ unsigned xb_ld(unsigned* p)              { return __hip_atomic_load(p, __ATOMIC_RELAXED, __HIP_MEMORY_SCOPE_AGENT); }
__device__ __forceinline__ unsigned xb_add(unsigned* p, unsigned v) { return __hip_atomic_fetch_add(p, v, __ATOMIC_RELAXED, __HIP_MEMORY_SCOPE_AGENT); }
__device__ __forceinline__ unsigned xb_xcc_id() { return (unsigned)__builtin_amdgcn_s_getreg((3 << 11) | 20) & 0xFu; }
#define XB_SPIN(cond, bar) do { unsigned _sp = 0; while (cond) { __builtin_amdgcn_s_sleep(1); \
    if ((++_sp & 255u) == 0u) { if (xb_ld(&(bar)[XB_TMO])) break; if (_sp > XB_SPIN_CAP) { atomicAdd(&(bar)[XB_TMO], 1u); break; } } } } while (0)

struct XcdBarrier {
    unsigned* bar; unsigned x;
    volatile LAS unsigned* st;
};

__device__ __forceinline__ XcdBarrier xcd_barrier_post(unsigned* bar, volatile LAS unsigned* st) {
    XcdBarrier b; b.bar = bar; b.x = xb_xcc_id(); b.st = st;
    if (threadIdx.x == 0) (void)xb_add(&bar[XB_XCNT(b.x)], 1u);
    return b;
}
__device__ __forceinline__ void xcd_barrier_complete(unsigned* bar, unsigned x, unsigned& nloc, unsigned& nx) {
    const unsigned G = gridDim.x * gridDim.y * gridDim.z;
    unsigned sum, cnt, mine, sp = 0u;
    for (;;) {
        sum = 0u; cnt = 0u; mine = 0u;
#pragma unroll
        for (unsigned j = 0; j < 16; ++j) { const unsigned c = xb_ld(&bar[XB_XCNT(j)]); sum += c; cnt += (c > 0u) ? 1u : 0u; mine = (j == x) ? c : mine; }
        if (sum == G) break;
        __builtin_amdgcn_s_sleep(1);
        if ((++sp & 255u) == 0u) { if (xb_ld(&bar[XB_TMO])) break; if (sp > XB_SPIN_CAP) { atomicAdd(&bar[XB_TMO], 1u); break; } }
    }
    nloc = mine > 0u ? mine : 1u; nx = cnt > 0u ? cnt : 1u;
}

__device__ __forceinline__ void xcd_barrier(const XcdBarrier& b) {
    asm volatile("s_waitcnt vmcnt(0)" ::: "memory");
    __syncthreads();
    if (threadIdx.x == 0) {
        unsigned* bar = b.bar;
        __builtin_amdgcn_s_waitcnt(0);
        unsigned nloc = b.st[0], nx = b.st[1];
        if (nloc == 0u) { xcd_barrier_complete(bar, b.x, nloc, nx); b.st[0] = nloc; b.st[1] = nx; }
        const unsigned old = xb_add(&bar[XB_XSUB(b.x)], 1u);
        const unsigned gen = old / nloc;
        if (old + 1u == (gen + 1u) * nloc) {
            __builtin_amdgcn_fence(__ATOMIC_RELEASE, "agent");
            asm volatile("s_waitcnt vmcnt(0)" ::: "memory");
            const unsigned og = xb_add(&bar[XB_TOP], 1u);
            const unsigned tg = og / nx;
            if (og + 1u == (tg + 1u) * nx) xb_add(&bar[XB_TOPGEN], 1u);
            else XB_SPIN(xb_ld(&bar[XB_TOPGEN]) == tg, bar);
            __builtin_amdgcn_fence(__ATOMIC_ACQUIRE, "agent");
            xb_add(&bar[XB_XGEN(b.x)], 1u);
            asm volatile("s_waitcnt vmcnt(0)" ::: "memory");
        } else {
            XB_SPIN(xb_ld(&bar[XB_XGEN(b.x)]) == gen, bar);
            __builtin_amdgcn_fence(__ATOMIC_ACQUIRE, "agent");
            asm volatile("s_waitcnt vmcnt(0)" ::: "memory");
        }
    }
    __syncthreads();
}
#define GAS __attribute__((address_space(1)))
typedef unsigned short bf16;
typedef unsigned u32x4 __attribute__((ext_vector_type(4)));
typedef unsigned u32x2 __attribute__((ext_vector_type(2)));
typedef float f32x4 __attribute__((ext_vector_type(4)));
typedef float f32x16 __attribute__((ext_vector_type(16)));
typedef short bf16x8 __attribute__((ext_vector_type(8)));
typedef int i32x4 __attribute__((ext_vector_type(4)));
#define LDS_WAIT() asm volatile("s_waitcnt lgkmcnt(0)" ::: "memory")
__device__ __forceinline__ float xor32_sum(float x) { const auto r = __builtin_amdgcn_permlane32_swap(__float_as_uint(x), __float_as_uint(x), false, false); return __uint_as_float(r[0]) + __uint_as_float(r[1]); }
__device__ __forceinline__ float xor32_max(float x) { const auto r = __builtin_amdgcn_permlane32_swap(__float_as_uint(x), __float_as_uint(x), false, false); return fmaxf(__uint_as_float(r[0]), __uint_as_float(r[1])); }
__device__ __forceinline__ float xor16_sum(float x) { const auto r = __builtin_amdgcn_permlane16_swap(__float_as_uint(x), __float_as_uint(x), false, false); return __uint_as_float(r[0]) + __uint_as_float(r[1]); }

constexpr int NWAVES = 8;
constexpr int NB = 16, SEQ = 2048, M = NB * SEQ, DM = 1024, DEPTH = 4, DIN = 3428, NIN = 3584, DFF = 4096;
constexpr int TOPK = 256;
constexpr float EPS = 1e-6f;
constexpr float LOG2E = 1.4426950408889634f;
constexpr float C2A = 0.125f * LOG2E;
constexpr float C2B = 0.10206207261596575f * LOG2E;
#ifndef MK_ONE_LAUNCH
#define MK_ONE_LAUNCH 1
#endif
constexpr int PH_PER_LAYER = 9, N_PHASES = DEPTH * PH_PER_LAYER + 1;

constexpr size_t MiB = 1u << 20;
constexpr size_t WS_CTL = 0, CTL_ZERO_BYTES = 64 * 1024;
constexpr int CW_BAR = 1024;
constexpr size_t WS_CS = 1 * MiB;
constexpr size_t WS_SSQQ = 5 * MiB, WS_SSQKV = 5 * MiB + 512 * 1024;
constexpr size_t WS_IW = 6 * MiB;
constexpr size_t WS_PTAB = 7 * MiB;
constexpr size_t WS_W = 8 * MiB;
constexpr size_t W_IN_OFF = 0, W_UQ_OFF = (size_t)NIN * 1024, W_UK_OFF = W_UQ_OFF + 768 * 256, W_UV_OFF = W_UK_OFF + 512 * 128, W_AB_OFF = W_UV_OFF + 512 * 128,
                 W_OUT_OFF = W_AB_OFF + 2048 * 512, W_FF1_OFF = W_OUT_OFF + 1024 * 1024, W_FF2_OFF = W_FF1_OFF + 4096 * 1024, W_END_OFF = W_FF2_OFF + 4096 * 1024;
static_assert(W_END_OFF * 2 <= 28 * MiB, "weight copies");
constexpr size_t WS_H = 36 * MiB;
constexpr size_t WS_YA = 100 * MiB, WS_YB = 132 * MiB;
constexpr size_t WS_IQ = 164 * MiB, WS_CQ = 180 * MiB, WS_CKV = 196 * MiB, WS_AK = 204 * MiB, WS_AVT = 208 * MiB, WS_IK = 212 * MiB, WS_KR = 216 * MiB;
constexpr size_t WS_RSS = 468 * MiB;
constexpr size_t WS_MASK = 220 * MiB;
constexpr size_t WS_GATES = 228 * MiB;
constexpr size_t WS_QB = 356 * MiB, WS_KN = 404 * MiB, WS_VT = 436 * MiB, WS_END = 470 * MiB;
constexpr size_t WS_RMAX = 468 * MiB + 512 * 1024;
constexpr size_t WS_SX = 468 * MiB + 768 * 1024;
constexpr size_t WS_SWF = 468 * MiB + 896 * 1024;
constexpr size_t WS_SWI = 468 * MiB + 960 * 1024;
constexpr size_t WS_XB8 = 356 * MiB;
constexpr size_t WS_MERGED = 356 * MiB;
constexpr size_t WS_HID = 100 * MiB;
static_assert(WS_YB == WS_YA + (size_t)M * 512 * 2 && WS_HID + (size_t)M * DFF * 2 <= WS_MERGED && WS_MERGED + (size_t)M * DM * 2 <= WS_VT, "d_ws map");

constexpr int RING_BYTES = 131072;
constexpr int MISC_OFF = 143360;
constexpr int LDS_BYTES = 147456;

struct Frame {
    LAS unsigned char* lds;
    int tid, lane, wave, G, bx;
    const float* x; const int* pos; const float* rel_bias; float* out;
    unsigned char* ws;
};

namespace pg8 {
typedef unsigned u32x2v __attribute__((ext_vector_type(2)));
__device__ __forceinline__ u32x4 pack8(const f32x4 a, const f32x4 b) { u32x4 w; w.x = cvt_pk_bf16(a[0], a[1]); w.y = cvt_pk_bf16(a[2], a[3]); w.z = cvt_pk_bf16(b[0], b[1]); w.w = cvt_pk_bf16(b[2], b[3]); return w; }
__device__ __forceinline__ f32x4 cvtf(const i32x4 a) { return __builtin_convertvector(a, f32x4); }
__device__ __forceinline__ float amax4(const f32x4 a) { return fmaxf(fmaxf(fabsf(a[0]), fabsf(a[1])), fmaxf(fabsf(a[2]), fabsf(a[3]))); }
__device__ __forceinline__ float ssq8(const f32x4 a, const f32x4 b) { return (a[0] * a[0] + a[1] * a[1]) + (a[2] * a[2] + a[3] * a[3]) + (b[0] * b[0] + b[1] * b[1]) + (b[2] * b[2] + b[3] * b[3]); }
__device__ __forceinline__ void unpack8(const u32x4 w, f32x4& a, f32x4& b) {
    a[0] = __uint_as_float(w.x << 16); a[1] = __uint_as_float(w.x & 0xffff0000u); a[2] = __uint_as_float(w.y << 16); a[3] = __uint_as_float(w.y & 0xffff0000u);
    b[0] = __uint_as_float(w.z << 16); b[1] = __uint_as_float(w.z & 0xffff0000u); b[2] = __uint_as_float(w.w << 16); b[3] = __uint_as_float(w.w & 0xffff0000u); }

__device__ __forceinline__ unsigned q8x4(const f32x4 v, float sx) {
    int q[4];
#pragma unroll
    for (int e = 0; e < 4; ++e) { q[e] = (int)__builtin_rintf(v[e] * sx); q[e] = min(max(q[e], -127), 127) & 255; }
    return (unsigned)q[0] | ((unsigned)q[1] << 8) | ((unsigned)q[2] << 16) | ((unsigned)q[3] << 24);
}
__device__ __forceinline__ unsigned pku8(const f32x4 v) {
    const unsigned q0 = (unsigned)(v[0] + 0.5f), q1 = (unsigned)(v[1] + 0.5f), q2 = (unsigned)(v[2] + 0.5f), q3 = (unsigned)(v[3] + 0.5f);
    return q0 | (q1 << 8) | (q2 << 16) | (q3 << 24);
}
__device__ __forceinline__ void unpack_u8(const u32x2v w, f32x4& a, f32x4& b) {
    a[0] = (float)(w.x & 255u); a[1] = (float)((w.x >> 8) & 255u); a[2] = (float)((w.x >> 16) & 255u); a[3] = (float)(w.x >> 24);
    b[0] = (float)(w.y & 255u); b[1] = (float)((w.y >> 8) & 255u); b[2] = (float)((w.y >> 16) & 255u); b[3] = (float)(w.y >> 24); }
__device__ __forceinline__ float row_rstd(const unsigned long long* RS, int row) {
    const unsigned long long v = RS[row];
    const float t = (float)v * (1.f / 4294967296.f);
    return __builtin_amdgcn_rsqf(t * (1.f / 1024.f) + EPS);
}
struct EpiIn {
    static constexpr bool PERM = true, AFTER_DRAIN = false; typedef f32x4 acc_t;
    bf16_t *AQ, *IQ, *CQ, *CKV, *AK, *AVT, *IK, *KR, *GATES; float *IW, *SSQQ, *SSQKV; const float *CS, *bgate; const unsigned long long* RSS;
    __device__ __forceinline__ void operator()(const f32x4 (&acc)[2][2][4][2], const Unit& u, int wr, int wc, int fr, int fq) const {
        asm volatile("" : "+v"(fr), "+v"(fq));
        const int pn = u.pn; const int row0 = u.pm * BM + wr * 64 + fr; const int cw = wc * 32 + 8 * fq;
        float rsv[2][4];
#pragma unroll
        for (int ai = 0; ai < 2; ++ai)
#pragma unroll
            for (int m = 0; m < 4; ++m) rsv[ai][m] = row_rstd(RSS, row0 + ai * HALF + m * 16);
        if (pn < 4) {
            bf16_t* base; int ld; float sc;
            if (pn < 2) { base = AQ + pn * 256; ld = 512; sc = C2A; } else if (pn == 2) { base = IQ; ld = 256; sc = 1.f; } else { base = CQ; ld = 256; sc = 1.f; }
#pragma unroll
            for (int ai = 0; ai < 2; ++ai)
#pragma unroll
                for (int m = 0; m < 4; ++m) { const int row = row0 + ai * HALF + m * 16; float ss = 0.f; const float rs = rsv[ai][m] * sc;
#pragma unroll
                    for (int bj = 0; bj < 2; ++bj) { const f32x4 v0 = acc[ai][bj][m][0] * rs, v1 = acc[ai][bj][m][1] * rs;
                        *(u32x4*)(base + (size_t)row * ld + bj * HALF + cw) = pack8(v0, v1); ss += ssq8(v0, v1); }
                    if (pn == 3) { ss = xor16_sum(ss); ss = xor32_sum(ss); if (fq == 0) SSQQ[(size_t)row * 4 + wc] = ss; } }
        } else if (pn == 4) {
#pragma unroll
            for (int ai = 0; ai < 2; ++ai)
#pragma unroll
                for (int m = 0; m < 4; ++m) { const int row = row0 + ai * HALF + m * 16; const float rs = rsv[ai][m];
                    { const f32x4 v0 = acc[ai][0][m][0] * rs, v1 = acc[ai][0][m][1] * rs; *(u32x4*)(CKV + (size_t)row * 128 + cw) = pack8(v0, v1);
                      float ss = ssq8(v0, v1); ss = xor16_sum(ss); ss = xor32_sum(ss); if (fq == 0) SSQKV[(size_t)row * 4 + wc] = ss; }
                    { const f32x4 v0 = acc[ai][1][m][0] * rs, v1 = acc[ai][1][m][1] * rs; const u32x4 w = pack8(v0, v1);
                      if (wc < 2) *(u32x4*)(AK + (size_t)row * 64 + cw) = w;
                      else { bf16_t* vt = AVT + ((size_t)(row >> 11) * 64 + (cw - 64)) * SEQ + (row & (SEQ - 1));
                             vt[0 * SEQ] = (bf16_t)(w.x & 0xffffu); vt[1 * SEQ] = (bf16_t)(w.x >> 16); vt[2 * SEQ] = (bf16_t)(w.y & 0xffffu); vt[3 * SEQ] = (bf16_t)(w.y >> 16);
                             vt[4 * SEQ] = (bf16_t)(w.z & 0xffffu); vt[5 * SEQ] = (bf16_t)(w.z >> 16); vt[6 * SEQ] = (bf16_t)(w.w & 0xffffu); vt[7 * SEQ] = (bf16_t)(w.w >> 16); }
#if defined(DBG_THROTTLE)
                      asm volatile("s_waitcnt vmcnt(8)" ::: "memory");
#endif
                    } }
        } else if (pn == 5) {
#pragma unroll
            for (int ai = 0; ai < 2; ++ai)
#pragma unroll
                for (int m = 0; m < 4; ++m) { const int row = row0 + ai * HALF + m * 16; const float rs = rsv[ai][m]; const f32x4 v0 = acc[ai][0][m][0] * rs, v1 = acc[ai][0][m][1] * rs;
                    if (wc < 2) *(u32x4*)(IK + (size_t)row * 64 + cw) = pack8(v0, v1);
                    else if (wc == 2) { const f32x4 c4 = *(const f32x4*)(CS + (size_t)row * 32 + 4 * fq), s4 = *(const f32x4*)(CS + (size_t)row * 32 + 16 + 4 * fq);
                        f32x4 o0, o1; o0[0] = v0[0] * c4[0] - v0[1] * s4[0]; o0[1] = v0[0] * s4[0] + v0[1] * c4[0]; o0[2] = v0[2] * c4[1] - v0[3] * s4[1]; o0[3] = v0[2] * s4[1] + v0[3] * c4[1];
                        o1[0] = v1[0] * c4[2] - v1[1] * s4[2]; o1[1] = v1[0] * s4[2] + v1[1] * c4[2]; o1[2] = v1[2] * c4[3] - v1[3] * s4[3]; o1[3] = v1[2] * s4[3] + v1[3] * c4[3];
                        *(u32x4*)(KR + (size_t)row * 32 + 8 * fq) = pack8(o0, o1); }
                    else if (fq == 0) *(f32x4*)(IW + (size_t)row * 4) = v0; }
        } else {
            const int cg0 = (pn - 6) * 256 + cw;
            f32x4 bv[2][2];
#pragma unroll
            for (int bj = 0; bj < 2; ++bj) { bv[bj][0] = *(const f32x4*)(bgate + cg0 + bj * HALF); bv[bj][1] = *(const f32x4*)(bgate + cg0 + bj * HALF + 4); }
#pragma unroll
            for (int ai = 0; ai < 2; ++ai)
#pragma unroll
                for (int m = 0; m < 4; ++m) { const int row = row0 + ai * HALF + m * 16; const float rs = rsv[ai][m];
#pragma unroll
                    for (int bj = 0; bj < 2; ++bj) { f32x4 v0 = acc[ai][bj][m][0] * rs + bv[bj][0], v1 = acc[ai][bj][m][1] * rs + bv[bj][1];
#pragma unroll
                        for (int e = 0; e < 4; ++e) { v0[e] = __builtin_amdgcn_rcpf(1.f + __builtin_amdgcn_exp2f(-LOG2E * v0[e])); v1[e] = __builtin_amdgcn_rcpf(1.f + __builtin_amdgcn_exp2f(-LOG2E * v1[e])); }
                        __builtin_nontemporal_store(pack8(v0, v1), (u32x4*)(GATES + (size_t)row * 2048 + cg0 + bj * HALF)); } }
        }
    }
};
struct EpiIn8 {
    static constexpr bool PERM = true, AFTER_DRAIN = false; typedef i32x4 acc_t;
    bf16_t *AQ, *IQ, *CQ, *CKV, *AK, *AVT, *IK, *KR, *GATES; float *IW, *SSQQ, *SSQKV; const float *CS, *bgate, *SX, *SWI;
    __device__ __forceinline__ void operator()(const i32x4 (&acc)[2][2][4][2], const Unit& u, int wr, int wc, int fr, int fq) const {
        asm volatile("" : "+v"(fr), "+v"(fq));
        const int pn = u.pn; const int row0 = u.pm * BM + wr * 64 + fr; const int cw = wc * 32 + 8 * fq;
        float rsv[2][4];
#pragma unroll
        for (int ai = 0; ai < 2; ++ai)
#pragma unroll
            for (int m = 0; m < 4; ++m) rsv[ai][m] = SX[row0 + ai * HALF + m * 16];
        f32x4 sw[2][2];
#pragma unroll
        for (int bj = 0; bj < 2; ++bj) { sw[bj][0] = *(const f32x4*)(SWI + pn * BM + bj * HALF + cw); sw[bj][1] = *(const f32x4*)(SWI + pn * BM + bj * HALF + cw + 4); }
        if (pn < 4) {
            bf16_t* base; int ld; float sc;
            if (pn < 2) { base = AQ + pn * 256; ld = 512; sc = C2A; } else if (pn == 2) { base = IQ; ld = 256; sc = 1.f; } else { base = CQ; ld = 256; sc = 1.f; }
#pragma unroll
            for (int ai = 0; ai < 2; ++ai)
#pragma unroll
                for (int m = 0; m < 4; ++m) { const int row = row0 + ai * HALF + m * 16; float ss = 0.f; const float rs = rsv[ai][m] * sc;
#pragma unroll
                    for (int bj = 0; bj < 2; ++bj) { const f32x4 v0 = (cvtf(acc[ai][bj][m][0]) * sw[bj][0]) * rs, v1 = (cvtf(acc[ai][bj][m][1]) * sw[bj][1]) * rs;
                        *(u32x4*)(base + (size_t)row * ld + bj * HALF + cw) = pack8(v0, v1); ss += ssq8(v0, v1); }
                    if (pn == 3) { ss = xor16_sum(ss); ss = xor32_sum(ss); if (fq == 0) SSQQ[(size_t)row * 4 + wc] = ss; } }
        } else if (pn == 4) {
#pragma unroll
            for (int ai = 0; ai < 2; ++ai)
#pragma unroll
                for (int m = 0; m < 4; ++m) { const int row = row0 + ai * HALF + m * 16; const float rs = rsv[ai][m];
                    { const f32x4 v0 = (cvtf(acc[ai][0][m][0]) * sw[0][0]) * rs, v1 = (cvtf(acc[ai][0][m][1]) * sw[0][1]) * rs; *(u32x4*)(CKV + (size_t)row * 128 + cw) = pack8(v0, v1);
                      float ss = ssq8(v0, v1); ss = xor16_sum(ss); ss = xor32_sum(ss); if (fq == 0) SSQKV[(size_t)row * 4 + wc] = ss; }
                    { const f32x4 v0 = (cvtf(acc[ai][1][m][0]) * sw[1][0]) * rs, v1 = (cvtf(acc[ai][1][m][1]) * sw[1][1]) * rs; const u32x4 w = pack8(v0, v1);
                      if (wc < 2) *(u32x4*)(AK + (size_t)row * 64 + cw) = w;
                      else { bf16_t* vt = AVT + ((size_t)(row >> 11) * 64 + (cw - 64)) * SEQ + (row & (SEQ - 1));
                             vt[0 * SEQ] = (bf16_t)(w.x & 0xffffu); vt[1 * SEQ] = (bf16_t)(w.x >> 16); vt[2 * SEQ] = (bf16_t)(w.y & 0xffffu); vt[3 * SEQ] = (bf16_t)(w.y >> 16);
                             vt[4 * SEQ] = (bf16_t)(w.z & 0xffffu); vt[5 * SEQ] = (bf16_t)(w.z >> 16); vt[6 * SEQ] = (bf16_t)(w.w & 0xffffu); vt[7 * SEQ] = (bf16_t)(w.w >> 16); }
#if defined(DBG_THROTTLE)
                      asm volatile("s_waitcnt vmcnt(8)" ::: "memory");
#endif
                    } }
        } else if (pn == 5) {
#pragma unroll
            for (int ai = 0; ai < 2; ++ai)
#pragma unroll
                for (int m = 0; m < 4; ++m) { const int row = row0 + ai * HALF + m * 16; const float rs = rsv[ai][m]; const f32x4 v0 = (cvtf(acc[ai][0][m][0]) * sw[0][0]) * rs, v1 = (cvtf(acc[ai][0][m][1]) * sw[0][1]) * rs;
                    if (wc < 2) *(u32x4*)(IK + (size_t)row * 64 + cw) = pack8(v0, v1);
                    else if (wc == 2) { const f32x4 c4 = *(const f32x4*)(CS + (size_t)row * 32 + 4 * fq), s4 = *(const f32x4*)(CS + (size_t)row * 32 + 16 + 4 * fq);
                        f32x4 o0, o1; o0[0] = v0[0] * c4[0] - v0[1] * s4[0]; o0[1] = v0[0] * s4[0] + v0[1] * c4[0]; o0[2] = v0[2] * c4[1] - v0[3] * s4[1]; o0[3] = v0[2] * s4[1] + v0[3] * c4[1];
                        o1[0] = v1[0] * c4[2] - v1[1] * s4[2]; o1[1] = v1[0] * s4[2] + v1[1] * c4[2]; o1[2] = v1[2] * c4[3] - v1[3] * s4[3]; o1[3] = v1[2] * s4[3] + v1[3] * c4[3];
                        *(u32x4*)(KR + (size_t)row * 32 + 8 * fq) = pack8(o0, o1); }
                    else if (fq == 0) *(f32x4*)(IW + (size_t)row * 4) = v0; }
        } else {
            const int cg0 = (pn - 6) * 256 + cw;
            f32x4 bv[2][2];
#pragma unroll
            for (int bj = 0; bj < 2; ++bj) { bv[bj][0] = *(const f32x4*)(bgate + cg0 + bj * HALF); bv[bj][1] = *(const f32x4*)(bgate + cg0 + bj * HALF + 4); }
#pragma unroll
            for (int ai = 0; ai < 2; ++ai)
#pragma unroll
                for (int m = 0; m < 4; ++m) { const int row = row0 + ai * HALF + m * 16; const float rs = rsv[ai][m];
#pragma unroll
                    for (int bj = 0; bj < 2; ++bj) { f32x4 v0 = (cvtf(acc[ai][bj][m][0]) * sw[bj][0]) * rs + bv[bj][0], v1 = (cvtf(acc[ai][bj][m][1]) * sw[bj][1]) * rs + bv[bj][1];
#pragma unroll
                        for (int e = 0; e < 4; ++e) { v0[e] = __builtin_amdgcn_rcpf(__builtin_fmaf(__builtin_amdgcn_exp2f(-LOG2E * v0[e]), 1.f / 255.f, 1.f / 255.f)); v1[e] = __builtin_amdgcn_rcpf(__builtin_fmaf(__builtin_amdgcn_exp2f(-LOG2E * v1[e]), 1.f / 255.f, 1.f / 255.f)); }
                        u32x2v w8; w8.x = pku8(v0); w8.y = pku8(v1);
                        __builtin_nontemporal_store(w8, (u32x2v*)((unsigned char*)GATES + (size_t)row * 2048 + cg0 + bj * HALF)); } }
        }
    }
};
struct EpiUQ {
    static constexpr bool PERM = true, AFTER_DRAIN = false; typedef f32x4 acc_t;
    bf16_t* QB; const float *SSQQ, *CS;
    __device__ __forceinline__ void operator()(const f32x4 (&acc)[2][2][4][2], const Unit& u, int wr, int wc, int fr, int fq) const {
        asm volatile("" : "+v"(fr), "+v"(fq));
        const int row0 = u.pm * BM + wr * 64 + fr; const int cw = wc * 32 + 8 * fq;
#pragma unroll
        for (int ai = 0; ai < 2; ++ai)
#pragma unroll
            for (int m = 0; m < 4; ++m) { const int row = row0 + ai * HALF + m * 16; const f32x4 sq = *(const f32x4*)(SSQQ + (size_t)row * 4);
                const float rs = __builtin_amdgcn_rsqf(((sq[0] + sq[1]) + (sq[2] + sq[3])) * (1.f / 256.f) + EPS) * C2B;
#pragma unroll
                for (int bj = 0; bj < 2; ++bj) { const int col0 = u.pn * BM + bj * HALF + cw; const int cm = col0 % 96;
                    f32x4 v0 = acc[ai][bj][m][0] * rs, v1 = acc[ai][bj][m][1] * rs;
                    if (cm >= 64) { const int i0 = (cm - 64) >> 1; const f32x4 c4 = *(const f32x4*)(CS + (size_t)row * 32 + i0), s4 = *(const f32x4*)(CS + (size_t)row * 32 + 16 + i0);
                        f32x4 o0, o1; o0[0] = v0[0] * c4[0] - v0[1] * s4[0]; o0[1] = v0[0] * s4[0] + v0[1] * c4[0]; o0[2] = v0[2] * c4[1] - v0[3] * s4[1]; o0[3] = v0[2] * s4[1] + v0[3] * c4[1];
                        o1[0] = v1[0] * c4[2] - v1[1] * s4[2]; o1[1] = v1[0] * s4[2] + v1[1] * c4[2]; o1[2] = v1[2] * c4[3] - v1[3] * s4[3]; o1[3] = v1[2] * s4[3] + v1[3] * c4[3];
                        v0 = o0; v1 = o1; }
                    *(u32x4*)(QB + (size_t)row * 768 + col0) = pack8(v0, v1); } }
    }
};
struct EpiUK {
    static constexpr bool PERM = true, AFTER_DRAIN = false; typedef f32x4 acc_t;
    bf16_t* KN; const float* SSQKV;
    __device__ __forceinline__ void operator()(const f32x4 (&acc)[2][2][4][2], const Unit& u, int wr, int wc, int fr, int fq) const {
        asm volatile("" : "+v"(fr), "+v"(fq));
        const int row0 = u.pm * BM + wr * 64 + fr; const int cw = wc * 32 + 8 * fq;
#pragma unroll
        for (int ai = 0; ai < 2; ++ai)
#pragma unroll
            for (int m = 0; m < 4; ++m) { const int row = row0 + ai * HALF + m * 16; const f32x4 sq = *(const f32x4*)(SSQKV + (size_t)row * 4);
                const float rs = __builtin_amdgcn_rsqf(((sq[0] + sq[1]) + (sq[2] + sq[3])) * (1.f / 128.f) + EPS);
#pragma unroll
                for (int bj = 0; bj < 2; ++bj) *(u32x4*)(KN + (size_t)row * 512 + u.pn * BM + bj * HALF + cw) = pack8(acc[ai][bj][m][0] * rs, acc[ai][bj][m][1] * rs); }
    }
};
struct EpiUV {
    static constexpr bool PERM = true, AFTER_DRAIN = false; typedef f32x4 acc_t;
    bf16_t* VT; const float* SSQKV;
    __device__ __forceinline__ void operator()(const f32x4 (&acc)[2][2][4][2], const Unit& u, int wr, int wc, int fr, int fq) const {
        asm volatile("" : "+v"(fr), "+v"(fq));
        const int row0 = u.pm * BM + wr * 64 + fr; const int cw = wc * 32 + 8 * fq;
        f32x4 r0[2], r1[2];
#pragma unroll
        for (int bj = 0; bj < 2; ++bj) { const int c0 = u.pn * BM + bj * HALF + cw;
#pragma unroll
            for (int e = 0; e < 8; ++e) { const f32x4 sq = *(const f32x4*)(SSQKV + (size_t)(c0 + e) * 4); const float rs = __builtin_amdgcn_rsqf(((sq[0] + sq[1]) + (sq[2] + sq[3])) * (1.f / 128.f) + EPS);
                if (e < 4) r0[bj][e] = rs; else r1[bj][e - 4] = rs; } }
#pragma unroll
        for (int ai = 0; ai < 2; ++ai)
#pragma unroll
            for (int m = 0; m < 4; ++m) { const int row = row0 + ai * HALF + m * 16;
#pragma unroll
                for (int bj = 0; bj < 2; ++bj) *(u32x4*)(VT + (size_t)row * M + u.pn * BM + bj * HALF + cw) = pack8(acc[ai][bj][m][0] * r0[bj], acc[ai][bj][m][1] * r1[bj]); }
    }
};
#ifndef DBG_BR_A
#define DBG_BR_A 1
#define DBG_BR_B 1
#endif
struct EpiBranch {
    static constexpr bool PERM = true, AFTER_DRAIN = false; typedef f32x4 acc_t;
    bf16_t* MERGED; const bf16_t* GATES;
    __device__ __forceinline__ void operator()(const f32x4 (&acc)[2][2][4][2], const Unit& u, int wr, int wc, int fr, int fq) const {
        asm volatile("" : "+v"(fr), "+v"(fq));
        const int br = u.pn >> 2, pn = u.pn & 3, pm = u.pm & 127;
        const int row0 = pm * BM + wr * 64 + fr; const int cw = pn * BM + wc * 32 + 8 * fq;
#pragma unroll
        for (int ai = 0; ai < 2; ++ai) {
            u32x2v gw[4][2]; u32x4 pw[4][2];
#pragma unroll
            for (int m = 0; m < 4; ++m)
#pragma unroll
                for (int bj = 0; bj < 2; ++bj) { const int row = row0 + ai * HALF + m * 16;
                    gw[m][bj] = *(const u32x2v*)((const unsigned char*)GATES + (size_t)row * 2048 + br * 1024 + bj * HALF + cw);
                    pw[m][bj] = br ? *(const u32x4*)(MERGED + (size_t)row * 1024 + bj * HALF + cw) : (u32x4){0u, 0u, 0u, 0u}; }
#pragma unroll
            for (int m = 0; m < 4; ++m)
#pragma unroll
                for (int bj = 0; bj < 2; ++bj) { const int row = row0 + ai * HALF + m * 16;
                    f32x4 g0, g1, p0, p1; unpack_u8(gw[m][bj], g0, g1); unpack8(pw[m][bj], p0, p1);
                    const float on_ = (br ? (float)(DBG_BR_B) : (float)(DBG_BR_A)) * (1.f / 255.f);
                    const f32x4 v0 = acc[ai][bj][m][0] * g0 * on_ + p0, v1 = acc[ai][bj][m][1] * g1 * on_ + p1;
                    *(u32x4*)(MERGED + (size_t)row * 1024 + bj * HALF + cw) = pack8(v0, v1); }
        }
    }
};
template <bool RMX> struct EpiResT {
    static constexpr bool PERM = true, AFTER_DRAIN = false; typedef f32x4 acc_t;
    bf16_t* XB; unsigned long long* RSS; unsigned* RMAX;
    __device__ __forceinline__ void operator()(const f32x4 (&acc)[2][2][4][2], const Unit& u, int wr, int wc, int fr, int fq) const {
        asm volatile("" : "+v"(fr), "+v"(fq));
        const int row0 = u.pm * BM + wr * 64 + fr; const int cw = u.pn * BM + wc * 32 + 8 * fq;
#pragma unroll
        for (int ai = 0; ai < 2; ++ai) {
            u32x4 bs[4][2];
#pragma unroll
            for (int m = 0; m < 4; ++m)
#pragma unroll
                for (int bj = 0; bj < 2; ++bj) bs[m][bj] = *(const u32x4*)(XB + (size_t)(row0 + ai * HALF + m * 16) * DM + bj * HALF + cw);
#pragma unroll
            for (int m = 0; m < 4; ++m) { const int row = row0 + ai * HALF + m * 16; float ss = 0.f, mx = 0.f;
#pragma unroll
                for (int bj = 0; bj < 2; ++bj) { f32x4 b0, b1; unpack8(bs[m][bj], b0, b1);
                    const f32x4 o0 = b0 + acc[ai][bj][m][0], o1 = b1 + acc[ai][bj][m][1];
                    ss += ssq8(o0, o1); *(u32x4*)(XB + (size_t)row * DM + bj * HALF + cw) = pack8(o0, o1);
                    if (RMX) mx = fmaxf(fmaxf(mx, amax4(o0)), amax4(o1)); }
                ss += __shfl_xor(ss, 16); ss += __shfl_xor(ss, 32);
                if (RMX) { mx = fmaxf(mx, __shfl_xor(mx, 16)); mx = fmaxf(mx, __shfl_xor(mx, 32)); }
                if (fq == 0) (void)__hip_atomic_fetch_add(RSS + row, (unsigned long long)(ss * 4294967296.f), __ATOMIC_RELAXED, __HIP_MEMORY_SCOPE_AGENT);
                if (RMX && fq == 0) (void)__hip_atomic_fetch_max(RMAX + row, __builtin_bit_cast(unsigned, mx), __ATOMIC_RELAXED, __HIP_MEMORY_SCOPE_AGENT); }
        }
    }
};
struct EpiFF1 {
    static constexpr bool PERM = true, AFTER_DRAIN = false; typedef f32x4 acc_t;
    bf16_t* HID; const unsigned long long* RSS;
    __device__ __forceinline__ void operator()(const f32x4 (&acc)[2][2][4][2], const Unit& u, int wr, int wc, int fr, int fq) const {
        asm volatile("" : "+v"(fr), "+v"(fq));
        const int row0 = u.pm * BM + wr * 64 + fr; const int cw = wc * 32 + 8 * fq;
        float rsv[2][4];
#pragma unroll
        for (int ai = 0; ai < 2; ++ai)
#pragma unroll
            for (int m = 0; m < 4; ++m) rsv[ai][m] = row_rstd(RSS, row0 + ai * HALF + m * 16);
#pragma unroll
        for (int ai = 0; ai < 2; ++ai)
#pragma unroll
            for (int m = 0; m < 4; ++m) { const int row = row0 + ai * HALF + m * 16; const float rs = rsv[ai][m];
#pragma unroll
                for (int bj = 0; bj < 2; ++bj) { f32x4 v0 = acc[ai][bj][m][0] * rs, v1 = acc[ai][bj][m][1] * rs;
#pragma unroll
                    for (int e = 0; e < 4; ++e) { const float a = fmaxf(v0[e], 0.f), b = fmaxf(v1[e], 0.f); v0[e] = a * a; v1[e] = b * b; }
                    __builtin_nontemporal_store(pack8(v0, v1), (u32x4*)(HID + (size_t)u.pm * (BM * DFF) + (size_t)(u.pn * 4 + bj * 2 + (wc >> 1)) * (BM * BK) + (size_t)(row - u.pm * BM) * BK + (wc & 1) * 32 + 8 * fq)); } }
    }
};
struct EpiFF18 {
    static constexpr bool PERM = true, AFTER_DRAIN = false; typedef i32x4 acc_t;
    bf16_t* HID; const float *SX, *SWF;
    __device__ __forceinline__ void operator()(const i32x4 (&acc)[2][2][4][2], const Unit& u, int wr, int wc, int fr, int fq) const {
        asm volatile("" : "+v"(fr), "+v"(fq));
        const int row0 = u.pm * BM + wr * 64 + fr; const int cw = wc * 32 + 8 * fq;
        float rsv[2][4]; f32x4 sw[2][2];
#pragma unroll
        for (int ai = 0; ai < 2; ++ai)
#pragma unroll
            for (int m = 0; m < 4; ++m) rsv[ai][m] = SX[row0 + ai * HALF + m * 16];
#pragma unroll
        for (int bj = 0; bj < 2; ++bj) { sw[bj][0] = *(const f32x4*)(SWF + u.pn * BM + bj * HALF + cw); sw[bj][1] = *(const f32x4*)(SWF + u.pn * BM + bj * HALF + cw + 4); }
#pragma unroll
        for (int ai = 0; ai < 2; ++ai)
#pragma unroll
            for (int m = 0; m < 4; ++m) { const int row = row0 + ai * HALF + m * 16; const float rs = rsv[ai][m];
#pragma unroll
                for (int bj = 0; bj < 2; ++bj) { f32x4 v0, v1;
#pragma unroll
                    for (int e = 0; e < 4; ++e) { const float a = fmaxf((float)acc[ai][bj][m][0][e] * (rs * sw[bj][0][e]), 0.f), b = fmaxf((float)acc[ai][bj][m][1][e] * (rs * sw[bj][1][e]), 0.f); v0[e] = a * a; v1[e] = b * b; }
                    __builtin_nontemporal_store(pack8(v0, v1), (u32x4*)(HID + (size_t)u.pm * (BM * DFF) + (size_t)(u.pn * 4 + bj * 2 + (wc >> 1)) * (BM * BK) + (size_t)(row - u.pm * BM) * BK + (wc & 1) * 32 + 8 * fq)); } }
    }
};
struct BranchOrder {
    StaticOrder so; int brsel;
    __device__ void init(int G, int c, int brsel_ = -1) { so.init(M, DM, G, c); brsel = brsel_; }
    __device__ bool next(int i, Unit& u) const { Unit b; if (brsel >= 0) { if (!so.next(i, b)) return false; u.pm = b.pm + 128 * brsel; u.pn = b.pn + 4 * brsel; return true; }
        if (!so.next(i >> 1, b)) return false; const int br = i & 1; u.pm = b.pm + 128 * br; u.pn = b.pn + 4 * br; return true; }
    __device__ __forceinline__ void a_ready(const Unit&) const {}
    __device__ __forceinline__ void done(const Unit&) const {}
};
}

__device__ __forceinline__ unsigned f2bf(float f) { unsigned u = __builtin_bit_cast(unsigned, f); return (u + 0x7fffu + ((u >> 16) & 1u)) >> 16; }
__device__ __forceinline__ unsigned pk2(float lo, float hi) { return f2bf(lo) | (f2bf(hi) << 16); }
__device__ __forceinline__ float wave_sum(float v) {
#pragma unroll
    for (int o = 1; o < 64; o <<= 1) v += __shfl_xor(v, o);
    return v;
}
template <int KIND> __device__ __forceinline__ int src_col(int n) {
    if (KIND == 1) {
        if (n < 512) return n;
        if (n < 768) return 640 + (n - 512);
        if (n < 1024) return 964 + (n - 768);
        if (n < 1152) return 1220 + (n - 1024);
        if (n < 1216) return 512 + (n - 1152);
        if (n < 1280) return 576 + (n - 1216);
        if (n < 1344) return 896 + (n - 1280);
        if (n < 1376) { const int j = n - 1344; return 1348 + 16 * (j & 1) + (j >> 1); }
        if (n < 1380) return 960 + (n - 1376);
        if (n < 1536) return -1;
        return 1380 + (n - 1536);
    } else if (KIND == 2) {
        const int h = n / 96, c = n % 96; if (c < 64) return h * 96 + c; const int j = c - 64; return h * 96 + 64 + 16 * (j & 1) + (j >> 1);
    } else if (KIND == 3) {
        return (n >> 6) * 128 + (n & 63);
    } else if (KIND == 4) {
        return (n >> 6) * 128 + 64 + (n & 63);
    }
    return n;
}
template <int KIND> __device__ __forceinline__ void prep_item(const float* W, int K, int Nsrc, bf16* WT, LAS float* scr, int item, int nblk, int lane, const float* gain) {
    const int kb = item / nblk, nb = item % nblk, k0 = 64 * kb, n0 = 32 * nb;
    const int sc = src_col<KIND>(n0 + (lane & 31));
    float v[32];
#pragma unroll
    for (int i = 0; i < 32; ++i) { const int kk = 2 * i + (lane >> 5); v[i] = (sc >= 0) ? W[(size_t)(k0 + kk) * Nsrc + sc] : 0.f; }
#pragma unroll
    for (int i = 0; i < 32; ++i) { const int kk = 2 * i + (lane >> 5); float x = v[i]; if (gain) x *= gain[k0 + kk]; scr[kk * 33 + (lane & 31)] = x; }
    LDS_WAIT(); asm volatile("" ::: "memory");
    const int c = lane & 7;
#pragma unroll
    for (int j = 0; j < 4; ++j) { const int n = (lane >> 3) + 8 * j; const LAS float* s = scr + (8 * c) * 33 + n;
        u32x4 o; o.x = pk2(s[0 * 33], s[1 * 33]); o.y = pk2(s[2 * 33], s[3 * 33]); o.z = pk2(s[4 * 33], s[5 * 33]); o.w = pk2(s[6 * 33], s[7 * 33]);
        *(GAS u32x4*)(WT + (size_t)((n0 + n) >> 8) * 256 * K + (size_t)kb * (256 * 64) + ((n0 + n) & 255) * 64 + 8 * c) = o; }
    LDS_WAIT(); asm volatile("" ::: "memory");
}
template <int KIND> __device__ __forceinline__ void prep8_wg(const float* W, int Nsrc, const float* gain, signed char* W8, float* SW, LAS float* scr, LAS float* cm  , int nb, int lane, int wave) {
    const int srcc = src_col<KIND>(32 * nb + (lane & 31)); const int src = srcc < 0 ? 0 : srcc; const float live = srcc < 0 ? 0.f : 1.f;
    float mx = 0.f, v[64];
#pragma unroll
    for (int i = 0; i < 64; ++i) { const int k = 128 * wave + (lane >> 5) + 2 * i; v[i] = W[(size_t)k * Nsrc + src]; }
#pragma unroll
    for (int i = 0; i < 64; ++i) { const int k = 128 * wave + (lane >> 5) + 2 * i; v[i] *= gain[k] * live; mx = fmaxf(mx, fabsf(v[i])); }
    mx = fmaxf(mx, __shfl_xor(mx, 32));
    if (lane < 32) cm[wave * 32 + lane] = mx;
    __syncthreads();
    mx = cm[lane & 31];
#pragma unroll
    for (int w2 = 1; w2 < NWAVES; ++w2) mx = fmaxf(mx, cm[w2 * 32 + (lane & 31)]);
    const float sc = (mx > 0.f) ? 127.f / mx : 1.f;
    if (wave == 0 && lane < 32) SW[32 * nb + lane] = (mx > 0.f) ? mx * (1.f / 127.f) : 1.f;
#pragma unroll
    for (int kk2 = 0; kk2 < 2; ++kk2) {
#pragma unroll
        for (int i = 0; i < 32; ++i) { const int kk = 2 * i + (lane >> 5); scr[kk * 33 + (lane & 31)] = v[32 * kk2 + i] * sc; }
        LDS_WAIT(); asm volatile("" ::: "memory");
        { const int n = lane >> 1, hf = lane & 1; const LAS float* sp = scr + (32 * hf) * 33 + n; unsigned w[8];
#pragma unroll
          for (int g = 0; g < 8; ++g) { unsigned acc4 = 0u;
#pragma unroll
              for (int e = 0; e < 4; ++e) { int q = (int)__builtin_rintf(sp[(4 * g + e) * 33]); q = min(max(q, -127), 127) & 255; acc4 |= (unsigned)q << (8 * e); }
              w[g] = acc4; }
          const int col = 32 * nb + n;
          GAS u32x4* dst = (GAS u32x4*)(W8 + (size_t)(col >> 8) * (256 * 1024) + (size_t)wave * (256 * 128) + (col & 255) * 128 + 64 * kk2 + 32 * hf);
          dst[0] = (u32x4){w[0], w[1], w[2], w[3]}; dst[1] = (u32x4){w[4], w[5], w[6], w[7]}; }
        LDS_WAIT(); asm volatile("" ::: "memory");
    }
    __syncthreads();
}
__device__ __forceinline__ void quant_rows(Frame& F, int sel) {
    const bf16* XB = (const bf16*)(F.ws + WS_H); signed char* XB8 = (signed char*)(F.ws + WS_XB8); const unsigned* RMAX = (const unsigned*)(F.ws + WS_RMAX) + sel * M;
    const unsigned long long* RS = (const unsigned long long*)(F.ws + WS_RSS) + sel * M; float* SX = (float*)(F.ws + WS_SX);
    const int gw = F.bx * NWAVES + F.wave, NGW = F.G * NWAVES;
    for (int r0 = 4 * gw; r0 < M; r0 += 4 * NGW) {
        u32x4 a[4], b[4]; unsigned mb[4]; unsigned long long sq[4];
#pragma unroll
        for (int q = 0; q < 4; ++q) { const int row = r0 + q; mb[q] = RMAX[row]; sq[q] = RS[row];
            a[q] = *(const GAS u32x4*)(XB + (size_t)row * DM + 16 * F.lane); b[q] = *(const GAS u32x4*)(XB + (size_t)row * DM + 16 * F.lane + 8); }
#pragma unroll
        for (int q = 0; q < 4; ++q) { const int row = r0 + q;
            const float mx = __builtin_bit_cast(float, mb[q]); const float sc = (mx > 0.f) ? 127.f / mx : 1.f;
            pg8::f32x4 v0, v1, v2, v3; pg8::unpack8(a[q], v0, v1); pg8::unpack8(b[q], v2, v3);
            u32x4 o; o.x = pg8::q8x4(v0, sc); o.y = pg8::q8x4(v1, sc); o.z = pg8::q8x4(v2, sc); o.w = pg8::q8x4(v3, sc);
            *(GAS u32x4*)(XB8 + (size_t)(row >> 8) * (256 * 1024) + (size_t)(F.lane >> 3) * (256 * 128) + (row & 255) * 128 + (F.lane & 7) * 16) = o;
            if (F.lane == 0) { const float t = (float)sq[q] * (1.f / 4294967296.f); SX[row] = ((mx > 0.f) ? mx * (1.f / 127.f) : 1.f) * __builtin_amdgcn_rsqf(t * (1.f / 1024.f) + EPS); } }
    }
}
template <int GROUP> __device__ __forceinline__ void prep_weights(Frame& F, int l, int lds_off, const float* g1, const float* g2, const float* w_in, const float* gq, const float* gkv, const float* w_uq, const float* w_ukv,
                                                                  const float* w_a, const float* w_b, const float* w_out, const float* w_ff1, const float* w_ff2, int nwi, bool rev) {
    LAS float* scr = (LAS float*)(F.lds + lds_off + F.wave * 8704);
    bf16* WB = (bf16*)(F.ws + WS_W);
    const int gw = F.bx * NWAVES + F.wave, NGW = nwi;
    constexpr int I_IN = 0  , I_UQ = 4 * 24, I_UK = 2 * 16, I_UV = 2 * 16, I_A = 8 * 32, I_B = 8 * 32, I_O = 16 * 32, I_1 = 0  , I_2 = 64 * 32;
    if (GROUP == 0) {
        for (int nb = F.G - 1 - F.bx; nb < NIN / 32; nb += F.G)
            prep8_wg<1>(w_in + (size_t)l * DM * DIN, DIN, g1 + l * DM, (signed char*)(WB + W_IN_OFF), (float*)(F.ws + WS_SWI), scr, (LAS float*)(F.lds + lds_off + NWAVES * 8704), nb, F.lane, F.wave);
        if (gw < NGW) for (int it = rev ? NGW - 1 - gw : gw; it < I_IN + I_UQ + I_UK + I_UV; it += NGW) {
            int r = it;
            if (r < I_IN) { prep_item<1>(w_in + (size_t)l * DM * DIN, DM, DIN, WB + W_IN_OFF, scr, r, NIN / 32, F.lane, g1 + l * DM); continue; } r -= I_IN;
            if (r < I_UQ) { prep_item<2>(w_uq + (size_t)l * 256 * 768, 256, 768, WB + W_UQ_OFF, scr, r, 24, F.lane, gq + l * 256); continue; } r -= I_UQ;
            if (r < I_UK) { prep_item<3>(w_ukv + (size_t)l * 128 * 1024, 128, 1024, WB + W_UK_OFF, scr, r, 16, F.lane, gkv + l * 128); continue; } r -= I_UK;
            prep_item<4>(w_ukv + (size_t)l * 128 * 1024, 128, 1024, WB + W_UV_OFF, scr, r, 16, F.lane, gkv + l * 128);
        }
    } else {
        if (gw < NGW) for (int it = rev ? NGW - 1 - gw : gw; it < I_A + I_B + I_O + I_1 + I_2; it += NGW) {
            int r = it;
            if (r < I_A) { prep_item<0>(w_a + (size_t)l * 512 * 1024, 512, 1024, WB + W_AB_OFF, scr, r, 32, F.lane, nullptr); continue; } r -= I_A;
            if (r < I_B) { prep_item<0>(w_b + (size_t)l * 512 * 1024, 512, 1024, WB + W_AB_OFF + 1024 * 512, scr, r, 32, F.lane, nullptr); continue; } r -= I_B;
            if (r < I_O) { prep_item<0>(w_out + (size_t)l * 1024 * 1024, 1024, 1024, WB + W_OUT_OFF, scr, r, 32, F.lane, nullptr); continue; } r -= I_O;
            if (r < I_1) { prep_item<0>(w_ff1 + (size_t)l * 1024 * 4096, 1024, 4096, WB + W_FF1_OFF, scr, r, 128, F.lane, g2 + l * DM); continue; } r -= I_1;
            prep_item<0>(w_ff2 + (size_t)l * 4096 * 1024, 4096, 1024, WB + W_FF2_OFF, scr, r, 32, F.lane, nullptr);
        }
    }
}
__device__ __forceinline__ void prep_ff1_int8(Frame& F, int l, int lds_off, const float* g2, const float* w_ff1) {
    LAS float* scr = (LAS float*)(F.lds + lds_off + F.wave * 8704); bf16* WB = (bf16*)(F.ws + WS_W);
    const int half = F.G / 2 > 0 ? F.G / 2 : 1, first = F.G - half;
    __syncthreads();
    for (int nb = F.bx - first; nb >= 0 && nb < DFF / 32; nb += half)
        prep8_wg<0>(w_ff1 + (size_t)l * DM * DFF, DFF, g2 + l * DM, (signed char*)(WB + W_FF1_OFF), (float*)(F.ws + WS_SWF), scr, (LAS float*)(F.lds + lds_off + NWAVES * 8704), nb, F.lane, F.wave);
    __syncthreads();
}
__device__ __forceinline__ void init_rows(Frame& F) {
    bf16* XB = (bf16*)(F.ws + WS_H); unsigned long long* RSB = (unsigned long long*)(F.ws + WS_RSS) + M;
    const int gw = F.bx * NWAVES + F.wave, NGW = F.G * NWAVES;
    for (int m0 = gw; m0 < M; m0 += 2 * NGW) {
        f32x4 v[2][4];
#pragma unroll
        for (int q = 0; q < 2; ++q) { const int m = m0 + q * NGW;
            if (m < M) { const GAS f32x4* xr = (const GAS f32x4*)(F.x + (size_t)m * DM) + F.lane;
#pragma unroll
                for (int j = 0; j < 4; ++j) v[q][j] = xr[64 * j]; } }
#pragma unroll
        for (int q = 0; q < 2; ++q) { const int m = m0 + q * NGW;
            if (m < M) { float s = 0.f;
#pragma unroll
                for (int j = 0; j < 4; ++j) s += (v[q][j].x * v[q][j].x + v[q][j].y * v[q][j].y) + (v[q][j].z * v[q][j].z + v[q][j].w * v[q][j].w);
                s = wave_sum(s);
                GAS unsigned long long* o8 = (GAS unsigned long long*)(XB + (size_t)m * DM) + F.lane;
#pragma unroll
                for (int j = 0; j < 4; ++j) o8[64 * j] = (unsigned long long)pk2(v[q][j].x, v[q][j].y) | ((unsigned long long)pk2(v[q][j].z, v[q][j].w) << 32);
                float mx = 0.f;
#pragma unroll
                for (int j = 0; j < 4; ++j) mx = fmaxf(mx, fmaxf(fmaxf(fabsf(v[q][j].x), fabsf(v[q][j].y)), fmaxf(fabsf(v[q][j].z), fabsf(v[q][j].w))));
#pragma unroll
                for (int o = 1; o < 64; o <<= 1) mx = fmaxf(mx, __shfl_xor(mx, o));
                if (F.lane == 0) { RSB[m] = (unsigned long long)(s * 4294967296.f); ((unsigned*)(F.ws + WS_RMAX))[M + m] = __builtin_bit_cast(unsigned, mx); } } }
    }
}
__device__ __forceinline__ void rope_table(Frame& F) {
    float* CS = (float*)(F.ws + WS_CS);
    for (int e = F.bx * (NWAVES * 64) + F.tid; e < M * 16; e += F.G * NWAVES * 64) { const int m = e >> 4, i = e & 15;
        const float invf = powf(10000.f, -(float)(2 * i) * (1.f / 32.f)); const float ang = (float)F.pos[m] * invf;
        float s, c; sincosf(ang, &s, &c); CS[(size_t)m * 32 + i] = c; CS[(size_t)m * 32 + 16 + i] = s; }
}
__device__ __forceinline__ void pos_tables(Frame& F) {
    int* KMAX = (int*)(F.ws + WS_PTAB); int* QMIN = KMAX + NB * 32;
    const int gw = F.bx * NWAVES + F.wave, NGW = F.G * NWAVES;
    for (int e = gw; e < NB * 32 + NB * 64; e += NGW) {
        if (e < NB * 32) { int m = F.pos[(size_t)(e >> 5) * SEQ + (e & 31) * 64 + F.lane];
#pragma unroll
            for (int o = 1; o < 64; o <<= 1) m = max(m, __shfl_xor(m, o));
            if (F.lane == 0) KMAX[e] = m; }
        else { const int q = e - NB * 32; int m = F.pos[(size_t)(q >> 6) * SEQ + (q & 63) * 32 + (F.lane & 31)];
#pragma unroll
            for (int o = 1; o < 32; o <<= 1) m = min(m, __shfl_xor(m, o));
            if (F.lane == 0) QMIN[q] = m; }
    }
}
template <bool OUT_F32> __device__ __forceinline__ void norm_rows(Frame& F, const float* src, const float* g, bf16* dstb, float* dstf, float oscale = 1.f) {
    const int gw = F.bx * NWAVES + F.wave, NGW = F.G * NWAVES;
    f32x4 gv[4];
#pragma unroll
    for (int j = 0; j < 4; ++j) gv[j] = *((const f32x4*)g + F.lane + 64 * j);
    for (int m = gw; m < M; m += NGW) {
        const GAS f32x4* xr = (const GAS f32x4*)(src + (size_t)m * DM) + F.lane;
        f32x4 v[4]; float s = 0.f;
#pragma unroll
        for (int j = 0; j < 4; ++j) { v[j] = xr[64 * j]; s += (v[j].x * v[j].x + v[j].y * v[j].y) + (v[j].z * v[j].z + v[j].w * v[j].w); }
        const float rstd = oscale / sqrtf(wave_sum(s) * (1.f / DM) + EPS);
        if (OUT_F32) { GAS f32x4* o = (GAS f32x4*)(dstf + (size_t)m * DM) + F.lane;
#pragma unroll
            for (int j = 0; j < 4; ++j) o[64 * j] = v[j] * rstd * gv[j];
        } else { GAS unsigned long long* o8 = (GAS unsigned long long*)(dstb + (size_t)m * DM) + F.lane;
#pragma unroll
            for (int j = 0; j < 4; ++j) { const f32x4 y = v[j] * rstd * gv[j]; o8[64 * j] = (unsigned long long)pk2(y.x, y.y) | ((unsigned long long)pk2(y.z, y.w) << 32); } }
    }
}

__device__ __forceinline__ void final_norm(Frame& F, const float* g, float oscale) {
    const bf16* XB = (const bf16*)(F.ws + WS_H);
    const int gw = F.bx * NWAVES + F.wave, NGW = F.G * NWAVES;
    f32x4 gv[4];
#pragma unroll
    for (int j = 0; j < 2; ++j) { gv[2 * j] = *((const f32x4*)g + 2 * (F.lane + 64 * j)); gv[2 * j + 1] = *((const f32x4*)g + 2 * (F.lane + 64 * j) + 1); }
    for (int m0 = 4 * gw; m0 < M; m0 += 4 * NGW) {
        u32x4 raw[4][2];
#pragma unroll
        for (int q = 0; q < 4; ++q) { const GAS u32x4* xr = (const GAS u32x4*)(XB + (size_t)(m0 + q) * DM) + F.lane;
            raw[q][0] = xr[0]; raw[q][1] = xr[64]; }
#pragma unroll
        for (int q = 0; q < 4; ++q) { const int m = m0 + q;
            f32x4 v[4]; float s = 0.f;
#pragma unroll
            for (int j = 0; j < 2; ++j) { pg8::unpack8(raw[q][j], v[2 * j], v[2 * j + 1]); }
#pragma unroll
            for (int j = 0; j < 4; ++j) s += (v[j].x * v[j].x + v[j].y * v[j].y) + (v[j].z * v[j].z + v[j].w * v[j].w);
            const float rstd = oscale / sqrtf(wave_sum(s) * (1.f / DM) + EPS);
            GAS f32x4* o = (GAS f32x4*)(F.out + (size_t)m * DM) + 2 * F.lane;
#pragma unroll
            for (int j = 0; j < 2; ++j) { __builtin_nontemporal_store(v[2 * j] * rstd * gv[2 * j], o + 128 * j); __builtin_nontemporal_store(v[2 * j + 1] * rstd * gv[2 * j + 1], o + 128 * j + 1); } }
    }
}

constexpr int SC_PITCH = SEQ + 4;
constexpr int IDX_MB_OFF = 16 * SC_PITCH * 4;
static_assert(IDX_MB_OFF + 16 * 32 * 8 <= MISC_OFF, "indexer LDS");
__device__ __forceinline__ unsigned fkey(float f) { const unsigned u = __float_as_uint(f + 0.0f); return u ^ ((unsigned)((int)u >> 31) | 0x80000000u); }
__device__ __forceinline__ unsigned wave_sum_u32(unsigned v) {
    v += (unsigned)__builtin_amdgcn_update_dpp(0, (int)v, 0x111, 0xf, 0xf, true);
    v += (unsigned)__builtin_amdgcn_update_dpp(0, (int)v, 0x112, 0xf, 0xf, true);
    v += (unsigned)__builtin_amdgcn_update_dpp(0, (int)v, 0x114, 0xf, 0xf, true);
    v += (unsigned)__builtin_amdgcn_update_dpp(0, (int)v, 0x118, 0xf, 0xf, true);
    v += (unsigned)__builtin_amdgcn_update_dpp(0, (int)v, 0x142, 0xa, 0xf, false);
    v += (unsigned)__builtin_amdgcn_update_dpp(0, (int)v, 0x143, 0xc, 0xf, false);
    return (unsigned)__builtin_amdgcn_readlane((int)v, 63);
}
template <int S> __device__ __forceinline__ void tr32_stage(unsigned (&a)[32]) {
    constexpr unsigned m = (S == 4) ? 0x0F0F0F0Fu : (S == 2) ? 0x33333333u : 0x55555555u;
#pragma unroll
    for (int k = 0; k < 32; ++k) if (!(k & S)) { const unsigned lo = a[k], hi = a[k + S];
        if (S == 16) { a[k] = __builtin_amdgcn_perm(hi, lo, 0x05040100u); a[k + S] = __builtin_amdgcn_perm(hi, lo, 0x07060302u); }
        else if (S == 8) { a[k] = __builtin_amdgcn_perm(hi, lo, 0x06020400u); a[k + S] = __builtin_amdgcn_perm(hi, lo, 0x07030501u); }
        else { a[k] = (lo & m) | ((hi << S) & ~m); a[k + S] = ((lo >> S) & m) | (hi & ~m); } }
}
__device__ __forceinline__ void tr32(unsigned (&a)[32]) { tr32_stage<16>(a); tr32_stage<8>(a); tr32_stage<4>(a); tr32_stage<2>(a); tr32_stage<1>(a); }
__device__ __forceinline__ void emit_words(unsigned G, unsigned C, int cnt, int rem, unsigned long long& myword, int lane) {
    if (cnt <= rem) { const unsigned Fw = G | C;
#pragma unroll
        for (int j = 0; j < 32; ++j) { const unsigned long long mk = __ballot((Fw >> j) & 1u); if (lane == j) myword = mk; }
    } else {
        int need = rem;
#pragma unroll
        for (int j = 0; j < 32; ++j) { const unsigned long long gt = __ballot((G >> j) & 1u), eq = __ballot((C >> j) & 1u); const int c = __popcll(eq); unsigned long long take;
            if (c <= need) { take = eq; need -= c; }
            else { const int below = __builtin_amdgcn_mbcnt_hi((unsigned)(eq >> 32), __builtin_amdgcn_mbcnt_lo((unsigned)eq, 0u)); take = __ballot(((C >> j) & 1u) && (below < need)); need = 0; }
            if (lane == j) myword = gt | take; }
    }
}
__device__ __forceinline__ void select_bits(unsigned (&ka)[32], unsigned Ca, unsigned long long& worda, int lane) {
    tr32(ka);
    unsigned Ga = 0u;
    int ra = TOPK;
    int ca = (int)wave_sum_u32((unsigned)__popc(Ca));
    bool da = (ca <= ra);
#pragma unroll
    for (int b = 31; b >= 0; --b) {
        if (da) break;
        const unsigned pa = ka[b];
        const unsigned oa = Ca & pa;
        const int na = (int)wave_sum_u32((unsigned)__popc(oa));
        const bool up = (na >= ra);
        Ca = up ? oa : (Ca & ~pa); Ga = up ? Ga : (Ga | oa); ca = up ? na : ca - na; ra = up ? ra : ra - na; da = (ca == ra);
    }
    emit_words(Ga, Ca, ca, ra, worda, lane);
}
__device__ __forceinline__ void idx_phase(Frame& F) {
    const bf16* IQ = (const bf16*)(F.ws + WS_IQ); const bf16* IK = (const bf16*)(F.ws + WS_IK); const float* IW = (const float*)(F.ws + WS_IW);
    unsigned long long* MASK = (unsigned long long*)(F.ws + WS_MASK);
    LAS float* sc = (LAS float*)F.lds; LAS unsigned long long* mb = (LAS unsigned long long*)(F.lds + IDX_MB_OFF);
    const int lane = F.lane, n = lane & 15, kg = lane >> 4, w = F.wave;
#define IDX_UNIT_ROW(uidx_, row_) do { const int c0_ = (uidx_) & 255, c = ((c0_ & 7) << 5) | (c0_ >> 3), i = (uidx_) >> 8, b = c >> 4, s = c & 15; \
        const int jb = (i >> 1) * 32 + ((i & 1) ? 31 - s : s); row_ = (size_t)b * SEQ + jb * 16 + n; } while (0)
    bf16x8 qf[4][2]; f32x4 w4 = (f32x4){0.f, 0.f, 0.f, 0.f};
    if (F.bx < NB * 128) { size_t row_; IDX_UNIT_ROW(F.bx, row_);
#pragma unroll
        for (int h = 0; h < 4; ++h)
#pragma unroll
            for (int ks = 0; ks < 2; ++ks) qf[h][ks] = *(const bf16x8*)(IQ + row_ * 256 + h * 64 + ks * 32 + kg * 8);
        w4 = *(const f32x4*)(IW + row_ * 4); }
    for (int uidx = F.bx; uidx < NB * 128; uidx += F.G) {
        const int c0_ = uidx & 255, c = ((c0_ & 7) << 5) | (c0_ >> 3),     i = uidx >> 8, b = c >> 4, s = c & 15;
        const int jb = (i >> 1) * 32 + ((i & 1) ? 31 - s : s);
        const int q0 = jb * 16, ntile = jb + 1; const size_t rowb = (size_t)b * SEQ;
        float pinf_ = __builtin_inff(); asm volatile("" : "+s"(pinf_));
#ifndef IDX_REP_SCORE
#define IDX_REP_SCORE 1
#define IDX_REP_SELECT 1
#endif
        for (int rep_ = 0; rep_ < IDX_REP_SCORE; ++rep_)
        for (int t0 = w; t0 < ntile; t0 += 8 * NWAVES) {
            bf16x8 kf[8][2];
#pragma unroll
            for (int u = 0; u < 8; ++u) { const int tt = t0 + u * NWAVES; if (tt < ntile) { const bf16* kp = IK + (rowb + tt * 16 + n) * 64 + kg * 8; kf[u][0] = *(const bf16x8*)kp; kf[u][1] = *(const bf16x8*)(kp + 32); } }
#pragma unroll
            for (int u = 0; u < 8; ++u) { const int tt = t0 + u * NWAVES;
                if (tt < ntile) { float z0 = 0.f, z1 = 0.f, z2 = 0.f, z3 = 0.f;
#pragma unroll
                    for (int h = 0; h < 4; ++h) { f32x4 a = (f32x4){0.f, 0.f, 0.f, 0.f};
                        a = __builtin_amdgcn_mfma_f32_16x16x32_bf16(kf[u][0], qf[h][0], a, 0, 0, 0); a = __builtin_amdgcn_mfma_f32_16x16x32_bf16(kf[u][1], qf[h][1], a, 0, 0, 0);
                        z0 = __builtin_fmaf(w4[h], __builtin_amdgcn_fmed3f(a[0], 0.f, pinf_), z0); z1 = __builtin_fmaf(w4[h], __builtin_amdgcn_fmed3f(a[1], 0.f, pinf_), z1);
                        z2 = __builtin_fmaf(w4[h], __builtin_amdgcn_fmed3f(a[2], 0.f, pinf_), z2); z3 = __builtin_fmaf(w4[h], __builtin_amdgcn_fmed3f(a[3], 0.f, pinf_), z3);
                        asm volatile("" : "+v"(z0), "+v"(z1), "+v"(z2), "+v"(z3)); }
                    *(LAS f32x4*)(sc + n * SC_PITCH + tt * 16 + 4 * kg) = (f32x4){z0, z1, z2, z3}; } }
        }
        __syncthreads();
        bf16x8 qn[4][2]; f32x4 wn = w4; const bool hasn = (uidx + F.G < NB * 128);
#pragma unroll
        for (int h = 0; h < 4; ++h) { qn[h][0] = qf[h][0]; qn[h][1] = qf[h][1]; }
        if (hasn) { size_t row_; IDX_UNIT_ROW(uidx + F.G, row_);
#pragma unroll
            for (int h = 0; h < 4; ++h)
#pragma unroll
                for (int ks = 0; ks < 2; ++ks) qn[h][ks] = *(const bf16x8*)(IQ + row_ * 256 + h * 64 + ks * 32 + kg * 8);
            wn = *(const f32x4*)(IW + row_ * 4); }
        for (int rep_ = 0; rep_ < IDX_REP_SELECT; ++rep_)
#pragma unroll 1
        for (int rr = 0; rr < 2; ++rr) {
            const int r = 2 * w + rr, t = q0 + r;
            unsigned ka[32];
#pragma unroll
            for (int j = 0; j < 32; ++j) ka[j] = fkey(sc[r * SC_PITCH + j * 64 + lane]);
            const int jm = t >> 6; const unsigned valid = (lane <= (t & 63)) ? ((2u << jm) - 1u) : ((1u << jm) - 1u);
            unsigned long long worda = 0ull;
            if (t + 1 <= TOPK) {
#pragma unroll
                for (int j = 0; j < 32; ++j) { const unsigned long long ma = __ballot((valid >> j) & 1u); if (lane == j) worda = ma; }
            } else select_bits(ka, valid, worda, lane);
            if (lane < 32) mb[r * 32 + lane] = worda;
        }
        __syncthreads();
        { const int j = F.tid >> 4, q = F.tid & 15; MASK[((size_t)b * 32 + j) * SEQ + q0 + q] = mb[q * 32 + j]; }
        __syncthreads();
#pragma unroll
        for (int h = 0; h < 4; ++h) { qf[h][0] = qn[h][0]; qf[h][1] = qn[h][1]; }
        w4 = wn;
    }
#undef IDX_UNIT_ROW
}

constexpr int KP_A = 144, KP_B = 208, VP = 136;
constexpr int KBUF_SZ = 64 * KP_B, VBUF_SZ = 64 * VP, KBUF = 0, VBUF = 2 * KBUF_SZ, LUT_OFF = VBUF + 2 * VBUF_SZ;
constexpr int POSB_OFF = LUT_OFF + 4160;
constexpr float ATT_THR = 8.f;
struct AttnSt { f32x16 o[2]; f32x16 cinit; float lrun; };
__device__ __forceinline__ void attn_reference(AttnSt& st, f32x16& s0, f32x16& s1, bool first) {
    const float pinf = __builtin_inff();
    float mx = __builtin_amdgcn_fmed3f(s0[0], s1[0], pinf);
#pragma unroll
    for (int r = 1; r < 16; ++r) { mx = __builtin_amdgcn_fmed3f(mx, s0[r], pinf); mx = __builtin_amdgcn_fmed3f(mx, s1[r], pinf); }
    mx = xor32_max(mx);
    if (first || __any(mx > ATT_THR)) {
        const float dl = first ? mx : fmaxf(mx, 0.f);
#pragma unroll
        for (int r = 0; r < 16; ++r) { s0[r] -= dl; s1[r] -= dl; st.cinit[r] -= dl; }
        if (!first) { const float a = __builtin_amdgcn_exp2f(-dl); st.lrun *= a;
#pragma unroll
            for (int r = 0; r < 16; ++r) { st.o[0][r] *= a; st.o[1][r] *= a; } }
    }
}
__device__ __forceinline__ void attn_exp(f32x16& s0, f32x16& s1) {
#pragma unroll
    for (int r = 0; r < 16; ++r) { s0[r] = __builtin_amdgcn_exp2f(s0[r]); s1[r] = __builtin_amdgcn_exp2f(s1[r]); }
}
__device__ __forceinline__ void attn_vload(u32x4 (&vw)[2][4], const LAS char* vt, int r32, int hi) {
#pragma unroll
    for (int d0 = 0; d0 < 2; ++d0)
#pragma unroll
        for (int ks = 0; ks < 4; ++ks) { const LAS char* p = vt + (32 * d0 + r32) * VP + 32 * ks + 8 * hi;
            const u32x2 lo = *(const LAS u32x2*)p, hh = *(const LAS u32x2*)(p + 16); vw[d0][ks] = (u32x4){lo.x, lo.y, hh.x, hh.y}; }
}
__device__ __forceinline__ void attn_pv(AttnSt& st, const f32x16& s0, const f32x16& s1, const u32x4 (&vw)[2][4]) {
    float ps0 = 0.f, ps1 = 0.f;
#pragma unroll
    for (int r = 0; r < 16; ++r) { ps0 += s0[r]; ps1 += s1[r]; asm volatile("" : "+v"(ps0), "+v"(ps1)); }
    st.lrun += ps0 + ps1;
    bf16x8 pf[4];
#pragma unroll
    for (int ks = 0; ks < 4; ++ks) { u32x4 w;
        if (ks < 2) { const int b = 8 * ks; w.x = pg8::cvt_pk_bf16(s0[b], s0[b + 1]); w.y = pg8::cvt_pk_bf16(s0[b + 2], s0[b + 3]); w.z = pg8::cvt_pk_bf16(s0[b + 4], s0[b + 5]); w.w = pg8::cvt_pk_bf16(s0[b + 6], s0[b + 7]); }
        else { const int b = 8 * (ks - 2); w.x = pg8::cvt_pk_bf16(s1[b], s1[b + 1]); w.y = pg8::cvt_pk_bf16(s1[b + 2], s1[b + 3]); w.z = pg8::cvt_pk_bf16(s1[b + 4], s1[b + 5]); w.w = pg8::cvt_pk_bf16(s1[b + 6], s1[b + 7]); }
        pf[ks] = __builtin_bit_cast(bf16x8, w); }
#pragma unroll
    for (int ks = 0; ks < 4; ++ks)
#pragma unroll
        for (int d0 = 0; d0 < 2; ++d0) st.o[d0] = __builtin_amdgcn_mfma_f32_32x32x16_bf16(__builtin_bit_cast(bf16x8, vw[d0][ks]), pf[ks], st.o[d0], 0, 0, 0);
}
__device__ __forceinline__ void store_o(bf16* op, const f32x16 (&o)[2], float inv) {
#pragma unroll
    for (int d0 = 0; d0 < 2; ++d0)
#pragma unroll
        for (int g = 0; g < 4; ++g) { u32x2 w; w.x = pg8::cvt_pk_bf16(o[d0][4 * g] * inv, o[d0][4 * g + 1] * inv); w.y = pg8::cvt_pk_bf16(o[d0][4 * g + 2] * inv, o[d0][4 * g + 3] * inv);
            *(u32x2*)(op + 32 * d0 + 8 * g) = w; }
}
__device__ __forceinline__ void dsa_unit(Frame& F, int b, int jq) {
    const int lane = F.lane, r32 = lane & 31, hi = lane >> 5, w = F.wave, tid = F.tid;
    LAS char* lds = (LAS char*)F.lds;
    bf16* AQ = (bf16*)(F.ws + WS_YA); const bf16* AK = (const bf16*)(F.ws + WS_AK); const bf16* AVT = (const bf16*)(F.ws + WS_AVT);
    const unsigned long long* MASK = (const unsigned long long*)(F.ws + WS_MASK);
    const size_t rowb = (size_t)b * SEQ; const int q0 = jq * 32;
    bf16x8 qf[4];
    { const bf16* qp = AQ + (rowb + q0 + r32) * 512 + w * 64 + hi * 8;
#pragma unroll
      for (int d0 = 0; d0 < 4; ++d0) qf[d0] = *(const bf16x8*)(qp + d0 * 16); }
    const int posq = F.pos[rowb + q0 + r32];
    const int* KMAX = (const int*)(F.ws + WS_PTAB);
    const int qmin = __builtin_amdgcn_readfirstlane(KMAX[NB * 32 + b * 64 + jq]);
    const int NT = (jq + 2) >> 1;
    const LAS float* lut = (const LAS float*)(lds + LUT_OFF) + w * 129;
    AttnSt st; st.lrun = 0.f;
#pragma unroll
    for (int r = 0; r < 16; ++r) { st.o[0][r] = 0.f; st.o[1][r] = 0.f; st.cinit[r] = 0.f; }
    const int srow = tid >> 3, sch = tid & 7;
    const bf16* kgp = AK + (rowb + srow) * 64 + sch * 8;
    const bf16* vgp = AVT + ((size_t)b * 64 + srow) * SEQ + sch * 8;
    const unsigned long long* mwp = MASK + (size_t)b * 32 * SEQ + q0 + r32;
    int kmaxv = KMAX[b * 32 + (lane & 31)];
    asm volatile("" : "+v"(qf[0]), "+v"(qf[1]), "+v"(qf[2]), "+v"(qf[3]), "+v"(kmaxv));
    const int* ppg = F.pos + rowb + (tid & 63);
    u32x4 kA = *(const u32x4*)kgp, vA = *(const u32x4*)vgp, kB = kA, vB = vA; unsigned long long mA = mwp[0], mB = mA; int pA = ppg[0], pB = pA;
    if (NT > 1) { kB = *(const u32x4*)(kgp + (size_t)64 * 64); vB = *(const u32x4*)(vgp + 64); mB = mwp[SEQ]; pB = ppg[64]; }
#define DSA_TILE(t_, KR_, VR_, MR_, PR_) do { const int tt_ = (t_); \
        LAS char* kb = lds + KBUF + (tt_ & 1) * KBUF_SZ; LAS char* vb = lds + VBUF + (tt_ & 1) * VBUF_SZ; \
        *(LAS u32x4*)(kb + srow * KP_A + sch * 16) = KR_; \
        *(LAS u32x2*)(vb + srow * VP + sch * 16) = (u32x2){VR_.x, VR_.y}; *(LAS u32x2*)(vb + srow * VP + sch * 16 + 8) = (u32x2){VR_.z, VR_.w}; \
        const unsigned long long mw = MR_; \
        if (tid < 64) ((LAS int*)(lds + POSB_OFF))[(tt_ & 1) * 64 + tid] = PR_; \
        __syncthreads(); \
        { const int tn_ = min(tt_ + 2, NT - 1);     \
          KR_ = *(const u32x4*)(kgp + (size_t)tn_ * 64 * 64); VR_ = *(const u32x4*)(vgp + tn_ * 64); MR_ = mwp[(size_t)tn_ * SEQ]; PR_ = ppg[tn_ * 64]; } \
        const bool far = (qmin - __builtin_amdgcn_readlane(kmaxv, tt_) >= 128); \
        f32x16 s0, s1; \
        { bf16x8 kf0[4], kf1[4];     \
          _Pragma("unroll") for (int d0 = 0; d0 < 4; ++d0) { kf0[d0] = *(const LAS bf16x8*)(kb + r32 * KP_A + d0 * 32 + hi * 16); kf1[d0] = *(const LAS bf16x8*)(kb + (32 + r32) * KP_A + d0 * 32 + hi * 16); } \
          __builtin_amdgcn_sched_barrier(0); \
          s0 = __builtin_amdgcn_mfma_f32_32x32x16_bf16(kf0[0], qf[0], st.cinit, 0, 0, 0); s1 = __builtin_amdgcn_mfma_f32_32x32x16_bf16(kf1[0], qf[0], st.cinit, 0, 0, 0); \
          _Pragma("unroll") for (int d0 = 1; d0 < 4; ++d0) { s0 = __builtin_amdgcn_mfma_f32_32x32x16_bf16(kf0[d0], qf[d0], s0, 0, 0, 0); s1 = __builtin_amdgcn_mfma_f32_32x32x16_bf16(kf1[d0], qf[d0], s1, 0, 0, 0); } } \
        u32x4 vw[2][4]; attn_vload(vw, vb, r32, hi); \
        if (!far) { const LAS int* pk = (const LAS int*)(lds + POSB_OFF) + (tt_ & 1) * 64 + 4 * hi; float bv0[16], bv1[16]; \
            _Pragma("unroll") for (int g = 0; g < 4; ++g) { const i32x4 p0 = *(const LAS i32x4*)(pk + 8 * g), p1 = *(const LAS i32x4*)(pk + 32 + 8 * g); \
                _Pragma("unroll") for (int e = 0; e < 4; ++e) { bv0[4 * g + e] = lut[min(max(posq - p0[e], 0), 128)]; bv1[4 * g + e] = lut[min(max(posq - p1[e], 0), 128)]; } } \
            _Pragma("unroll") for (int r = 0; r < 16; ++r) { s0[r] += bv0[r]; s1[r] += bv1[r]; } } \
        attn_reference(st, s0, s1, tt_ == 0); \
        attn_exp(s0, s1); \
        { const unsigned wl = (unsigned)mw >> (4 * hi), wh = (unsigned)(mw >> 32) >> (4 * hi); int one_ = 1; asm volatile("" : "+s"(one_));     \
          _Pragma("unroll") for (int r = 0; r < 16; ++r) { const int c = (r & 3) + 8 * (r >> 2); \
              s0[r] = __uint_as_float(__float_as_uint(s0[r]) & (unsigned)__builtin_amdgcn_sbfe((int)wl, c, one_)); s1[r] = __uint_as_float(__float_as_uint(s1[r]) & (unsigned)__builtin_amdgcn_sbfe((int)wh, c, one_)); } }     \
        attn_pv(st, s0, s1, vw); } while (0)
    asm volatile(".p2align 8" ::: "memory");
    for (int t = 0; t < NT; t += 2) {
        DSA_TILE(t, kA, vA, mA, pA);
        if (t + 1 < NT) DSA_TILE(t + 1, kB, vB, mB, pB);
    }
#undef DSA_TILE
    st.lrun = xor32_sum(st.lrun);
    store_o(AQ + (rowb + q0 + r32) * 512 + w * 64 + 4 * hi, st.o, 1.f / st.lrun);
    __syncthreads();
}
__device__ __forceinline__ void mla_unit(Frame& F, int b, int h, int qb) {
    const int lane = F.lane, r32 = lane & 31, hi = lane >> 5, w = F.wave, tid = F.tid;
    LAS char* lds = (LAS char*)F.lds;
    const bf16* QB = (const bf16*)(F.ws + WS_QB); const bf16* KN = (const bf16*)(F.ws + WS_KN); const bf16* KR = (const bf16*)(F.ws + WS_KR); const bf16* VT = (const bf16*)(F.ws + WS_VT);
    bf16* YB = (bf16*)(F.ws + WS_YB);
    const size_t rowb = (size_t)b * SEQ; const int q0w = qb * 256 + w * 32;
    bf16x8 qf[6];
    { const bf16* qp = QB + (rowb + q0w + r32) * 768 + h * 96 + hi * 8;
#pragma unroll
      for (int d0 = 0; d0 < 6; ++d0) qf[d0] = *(const bf16x8*)(qp + d0 * 16); }
    const int NT = 4 * (qb + 1);
    AttnSt st; st.lrun = 0.f;
#pragma unroll
    for (int r = 0; r < 16; ++r) { st.o[0][r] = 0.f; st.o[1][r] = 0.f; st.cinit[r] = 0.f; }
    const int srow = tid >> 3, sch = tid & 7, rrow = (tid >> 2) & 63, rch = tid & 3;
    const bf16* kgp = KN + (rowb + srow) * 512 + h * 64 + sch * 8;
    const bf16* rgp = KR + (rowb + rrow) * 32 + rch * 8;
    const bf16* vgp = VT + (size_t)(h * 64 + srow) * M + rowb + sch * 8;
    u32x4 kA = *(const u32x4*)kgp, vA = *(const u32x4*)vgp, rA = *(const u32x4*)rgp;
    u32x4 kB = *(const u32x4*)(kgp + (size_t)64 * 512), vB = *(const u32x4*)(vgp + 64), rB = *(const u32x4*)(rgp + (size_t)64 * 32);
#define MLA_TILE(t_, KR_, VR_, RR_) do { const int tt_ = (t_); \
        LAS char* kb = lds + KBUF + (tt_ & 1) * KBUF_SZ; LAS char* vb = lds + VBUF + (tt_ & 1) * VBUF_SZ; \
        *(LAS u32x4*)(kb + srow * KP_B + sch * 16) = KR_; \
        if (tid < 256) *(LAS u32x4*)(kb + rrow * KP_B + 128 + rch * 16) = RR_; \
        *(LAS u32x2*)(vb + srow * VP + sch * 16) = (u32x2){VR_.x, VR_.y}; *(LAS u32x2*)(vb + srow * VP + sch * 16 + 8) = (u32x2){VR_.z, VR_.w}; \
        __syncthreads(); \
        { const int tn_ = min(tt_ + 2, NT - 1); \
          KR_ = *(const u32x4*)(kgp + (size_t)tn_ * 64 * 512); VR_ = *(const u32x4*)(vgp + tn_ * 64); RR_ = *(const u32x4*)(rgp + (size_t)tn_ * 64 * 32); } \
        if (tt_ * 64 <= q0w + 31) { \
            f32x16 s0, s1; \
            { bf16x8 kf0[6], kf1[6]; \
              _Pragma("unroll") for (int d0 = 0; d0 < 6; ++d0) { kf0[d0] = *(const LAS bf16x8*)(kb + r32 * KP_B + d0 * 32 + hi * 16); kf1[d0] = *(const LAS bf16x8*)(kb + (32 + r32) * KP_B + d0 * 32 + hi * 16); } \
              __builtin_amdgcn_sched_barrier(0); \
              s0 = __builtin_amdgcn_mfma_f32_32x32x16_bf16(kf0[0], qf[0], st.cinit, 0, 0, 0); s1 = __builtin_amdgcn_mfma_f32_32x32x16_bf16(kf1[0], qf[0], st.cinit, 0, 0, 0); \
              _Pragma("unroll") for (int d0 = 1; d0 < 6; ++d0) { s0 = __builtin_amdgcn_mfma_f32_32x32x16_bf16(kf0[d0], qf[d0], s0, 0, 0, 0); s1 = __builtin_amdgcn_mfma_f32_32x32x16_bf16(kf1[d0], qf[d0], s1, 0, 0, 0); } } \
            u32x4 vw[2][4]; attn_vload(vw, vb, r32, hi); \
            attn_reference(st, s0, s1, tt_ == 0); \
            attn_exp(s0, s1); \
            if (tt_ * 64 + 63 > q0w) { const int qi = q0w + r32, kv0 = tt_ * 64 + 4 * hi; \
                _Pragma("unroll") for (int r = 0; r < 16; ++r) { const int kv = kv0 + (r & 3) + 8 * (r >> 2); if (kv > qi) s0[r] = 0.f; if (kv + 32 > qi) s1[r] = 0.f; } } \
            attn_pv(st, s0, s1, vw); } } while (0)
    asm volatile(".p2align 8" ::: "memory");
    for (int t = 0; t < NT; t += 2) {
        MLA_TILE(t, kA, vA, rA);
        MLA_TILE(t + 1, kB, vB, rB);
    }
#undef MLA_TILE
    st.lrun = xor32_sum(st.lrun);
    store_o(YB + (rowb + q0w + r32) * 512 + h * 64 + 4 * hi, st.o, 1.f / st.lrun);
    __syncthreads();
}
__device__ __forceinline__ void attn_phase(Frame& F) {
    { LAS float* lut = (LAS float*)(F.lds + LUT_OFF);
      for (int e = F.tid; e < 8 * 129; e += NWAVES * 64) { const int h = e / 129, n = e % 129; int bk;
          if (n < 16) bk = n; else { const float z = logf((float)n * (1.f / 16.f)) / 2.0794415416798357f * 16.f; bk = 16 + (int)z; if (bk > 31) bk = 31; }
          lut[e] = (F.rel_bias[bk * 8 + h] - F.rel_bias[31 * 8 + h]) * LOG2E; }
      __syncthreads(); }
#ifndef ATT_DSA_ON
#define ATT_DSA_ON 1
#endif
#ifndef ATT_MLA_ON
#define ATT_MLA_ON 1
#endif
    if (ATT_DSA_ON)
    for (int uidx = F.bx; uidx < NB * 64; uidx += F.G) {
        const int c0_ = uidx & 255, c = ((c0_ & 7) << 5) | (c0_ >> 3),     i = uidx >> 8, b = c >> 4, s = c & 15;
        const int jq = (i >> 1) * 32 + ((i & 1) ? 31 - s : s);
        dsa_unit(F, b, jq);
    }
    if (ATT_MLA_ON)
    for (int uidx = F.bx; uidx < NB * 8 * 8; uidx += F.G) {
        const int c0_ = uidx & 255, c = ((c0_ & 7) << 5) | (c0_ >> 3),     i = uidx >> 8, bh = c >> 1, sub = c & 1;
        const int qb = sub ? ((i == 0) ? 1 : (i == 1) ? 6 : (i == 2) ? 2 : 5) : ((i == 0) ? 0 : (i == 1) ? 7 : (i == 2) ? 3 : 4);
        mla_unit(F, bh >> 3, bh & 7, qb);
    }
}
#if defined(DBG_CHECK)
#ifndef DBG_PROBE_OFF
#define DBG_PROBE_OFF 100
#define DBG_PROBE_PH 2
#endif
#ifndef DBG_FILL_LO
#define DBG_FILL_LO (1 * MiB)
#define DBG_FILL_HI (468 * MiB)
#endif
constexpr size_t WS_DBG_AQ_UNUSED = 0;
constexpr int DBG_W_DSA = 16, DBG_W_MASK = 17, DBG_W_MLA = 18, DBG_W_DIR = 19, DBG_W_QB = 20, DBG_W_KV = 21;
__device__ __forceinline__ float bf2f(bf16 v) { return __uint_as_float((unsigned)v << 16); }
__device__ __forceinline__ int dbg_bucket(int n) { if (n < 0) n = 0; if (n < 16) return n; const double z = log((double)n / 16.0) / log(8.0) * 16.0; int b = 16 + (int)z; return b > 31 ? 31 : b; }
__device__ __forceinline__ float dbg_block_max(LAS float* red, float v, int tid) {
    for (int o = 1; o < 64; o <<= 1) v = fmaxf(v, __shfl_xor(v, o));
    __syncthreads(); if ((tid & 63) == 0) red[tid >> 6] = v; __syncthreads();
    float r = red[0]; for (int i = 1; i < NWAVES; ++i) r = fmaxf(r, red[i]); __syncthreads(); return r;
}
__device__ __forceinline__ float dbg_block_sum(LAS float* red, float v, int tid) {
    for (int o = 1; o < 64; o <<= 1) v += __shfl_xor(v, o);
    __syncthreads(); if ((tid & 63) == 0) red[tid >> 6] = v; __syncthreads();
    float r = 0.f; for (int i = 0; i < NWAVES; ++i) r += red[i]; __syncthreads(); return r;
}
__device__ __forceinline__ int dbg_sample_t(int k) { return (k == 0) ? 0 : (k == 1) ? 255 : (k == 2) ? 256 : (k == 3) ? 257 : (k == 4) ? 2047 : (k == 5) ? 300 : 100 + 173 * k; }
__device__ __forceinline__ void dbg_copy_aq(unsigned char* ws, float* outbuf, int bx, int G, int tid) {
    const u32x4* src = (const u32x4*)(ws + WS_YA); u32x4* dst = (u32x4*)outbuf;
    for (size_t i = (size_t)bx * 512 + tid; i < (size_t)M * 512 * 2 / 16; i += (size_t)G * 512) dst[i] = src[i];
}
__device__ __forceinline__ void dbg_check_attn(unsigned char* ws, const float* outbuf, const int* pos, const float* rel_bias, LAS unsigned char* lds, int bx, int G, int tid) {
    unsigned* ctl = (unsigned*)(ws + WS_CTL);
    const bf16* AQc = (const bf16*)outbuf; const bf16* YA = (const bf16*)(ws + WS_YA); const bf16* YB = (const bf16*)(ws + WS_YB);
    const bf16* AK = (const bf16*)(ws + WS_AK); const bf16* AVT = (const bf16*)(ws + WS_AVT); const bf16* IQ = (const bf16*)(ws + WS_IQ); const bf16* IK = (const bf16*)(ws + WS_IK);
    const float* IW = (const float*)(ws + WS_IW); const unsigned long long* MASK = (const unsigned long long*)(ws + WS_MASK);
    const bf16* QB = (const bf16*)(ws + WS_QB); const bf16* KN = (const bf16*)(ws + WS_KN); const bf16* KR = (const bf16*)(ws + WS_KR); const bf16* VT = (const bf16*)(ws + WS_VT);
    LAS float* sc = (LAS float*)lds; LAS float* lg = sc + 2048; LAS float* sel = lg + 2048; LAS float* red = sel + 2048; LAS float* yacc = red + 16;
    for (int unit = bx; unit < NB * 12; unit += G) {
        const int b = unit / 12, t = dbg_sample_t(unit % 12); const size_t rowb = (size_t)b * SEQ;
        for (int s = tid; s < SEQ; s += 512) { float v = 0.f;
            if (s <= t) { for (int h = 0; h < 4; ++h) { float d = 0.f; for (int e = 0; e < 64; ++e) d += bf2f(IQ[(rowb + t) * 256 + h * 64 + e]) * bf2f(IK[(rowb + s) * 64 + e]); v += IW[(rowb + t) * 4 + h] * fmaxf(d, 0.f); } }
            sc[s] = v; }
        __syncthreads();
        int mism = 0;
        for (int s = tid; s < SEQ; s += 512) { float pick = 0.f;
            if (s <= t) { int cnt = 0; const float me = sc[s]; for (int s2 = 0; s2 <= t; ++s2) { const float o = sc[s2]; cnt += (o > me || (o == me && s2 < s)) ? 1 : 0; } pick = (t + 1 <= TOPK || cnt < TOPK) ? 1.f : 0.f; }
            sel[s] = pick;
            const int fast = (int)((MASK[((size_t)b * 32 + (s >> 6)) * SEQ + t] >> (s & 63)) & 1ull);
            mism += (fast != (int)pick) ? 1 : 0; }
        { const float tot = dbg_block_sum(red, (float)mism, tid); if (tid == 0 && tot > 0.f) atomicAdd(ctl + DBG_W_MASK, (unsigned)tot); }
        for (int h = 0; h < 8; ++h) {
            float lmax = -3e38f;
            for (int s = tid; s < SEQ; s += 512) { float v = -3e38f;
                if (s <= t && sel[s] != 0.f) { float d = 0.f; for (int e = 0; e < 64; ++e) d += bf2f(AQc[(rowb + t) * 512 + h * 64 + e]) * bf2f(AK[(rowb + s) * 64 + e]);
                    v = d + LOG2E * rel_bias[dbg_bucket(pos[rowb + t] - pos[rowb + s]) * 8 + h]; }
                lg[s] = v; lmax = fmaxf(lmax, v); }
            const float mx = dbg_block_max(red, lmax, tid);
            float ps = 0.f;
            for (int s = tid; s < SEQ; s += 512) { const float p = (lg[s] > -1e38f) ? exp2f(lg[s] - mx) : 0.f; lg[s] = p; ps += p; }
            const float tot = dbg_block_sum(red, ps, tid);
            { const int d = tid & 63, part = tid >> 6; float a = 0.f; for (int s = part; s <= t; s += 8) a += lg[s] * bf2f(AVT[((size_t)b * 64 + d) * SEQ + s]); yacc[part * 64 + d] = a; }
            __syncthreads();
            float err = 0.f, mag = 0.f;
            if (tid < 64) { float y = 0.f; for (int p = 0; p < 8; ++p) y += yacc[p * 64 + tid]; y /= tot; const float f = bf2f(YA[(rowb + t) * 512 + h * 64 + tid]); err = fabsf(f - y); mag = fabsf(y); }
            const float emax = dbg_block_max(red, err, tid), mmax = dbg_block_max(red, mag, tid);
            if (tid == 0) atomicMax(ctl + DBG_W_DSA, __float_as_uint(emax / (mmax + 1e-20f)));
            __syncthreads();
        }
        for (int h = 0; h < 8; ++h) {
            float lmax = -3e38f;
            for (int s = tid; s < SEQ; s += 512) { float v = -3e38f;
                if (s <= t) { float d = 0.f; for (int e = 0; e < 64; ++e) d += bf2f(QB[(rowb + t) * 768 + h * 96 + e]) * bf2f(KN[(rowb + s) * 512 + h * 64 + e]);
                    for (int e = 0; e < 32; ++e) d += bf2f(QB[(rowb + t) * 768 + h * 96 + 64 + e]) * bf2f(KR[(rowb + s) * 32 + e]); v = d; }
                lg[s] = v; lmax = fmaxf(lmax, v); }
            const float mx = dbg_block_max(red, lmax, tid);
            float ps = 0.f;
            for (int s = tid; s < SEQ; s += 512) { const float p = (lg[s] > -1e38f) ? exp2f(lg[s] - mx) : 0.f; lg[s] = p; ps += p; }
            const float tot = dbg_block_sum(red, ps, tid);
            { const int d = tid & 63, part = tid >> 6; float a = 0.f; for (int s = part; s <= t; s += 8) a += lg[s] * bf2f(VT[(size_t)(h * 64 + d) * M + rowb + s]); yacc[part * 64 + d] = a; }
            __syncthreads();
            float err = 0.f, mag = 0.f;
            if (tid < 64) { float y = 0.f; for (int p = 0; p < 8; ++p) y += yacc[p * 64 + tid]; y /= tot; const float f = bf2f(YB[(rowb + t) * 512 + h * 64 + tid]); err = fabsf(f - y); mag = fabsf(y); }
            const float emax = dbg_block_max(red, err, tid), mmax = dbg_block_max(red, mag, tid);
            if (tid == 0) atomicMax(ctl + DBG_W_MLA, __float_as_uint(emax / (mmax + 1e-20f)));
            __syncthreads();
        }
    }
}

__device__ __forceinline__ void dbg_upd(float& e, float& g, float fast, float ref) { e = fmaxf(e, fabsf(fast - ref)); g = fmaxf(g, fabsf(ref)); }
__device__ __forceinline__ void dbg_check_proj(unsigned char* ws, const int* pos, const float* g1, const float* w_in, const float* b_gate, const float* gq, const float* gkv, const float* w_uq, const float* w_ukv,
                                               LAS unsigned char* lds, int bx, int G, int tid) {
    unsigned* ctl = (unsigned*)(ws + WS_CTL);
    const bf16* H = (const bf16*)(ws + WS_H); const bf16* AQ = (const bf16*)(ws + WS_YA); const bf16* AK = (const bf16*)(ws + WS_AK); const bf16* AVT = (const bf16*)(ws + WS_AVT);
    const bf16* IQ = (const bf16*)(ws + WS_IQ); const bf16* IK = (const bf16*)(ws + WS_IK); const float* IW = (const float*)(ws + WS_IW); const bf16* GATES = (const bf16*)(ws + WS_GATES);
    const bf16* QB = (const bf16*)(ws + WS_QB); const bf16* KN = (const bf16*)(ws + WS_KN); const bf16* KR = (const bf16*)(ws + WS_KR); const bf16* VT = (const bf16*)(ws + WS_VT);
    LAS float* z = (LAS float*)lds;
    LAS float* hrow = z + 3456;
    LAS float* qb = hrow + 1024;
    LAS float* kvb = qb + 768;
    LAS float* red = kvb + 1024;
    for (int unit = bx; unit < 256; unit += G) {
        const int b = unit >> 4, t = (unit & 15) * 131 + 7; const size_t m = (size_t)b * SEQ + t;
        { float sx = 0.f; for (int k = tid; k < DM; k += 512) { const float xv = bf2f(H[m * DM + k]); sx += xv * xv; }
          const float rx = 1.f / sqrtf(dbg_block_sum(red, sx, tid) / (float)DM + EPS);
          for (int k = tid; k < DM; k += 512) hrow[k] = bf2f(H[m * DM + k]) * rx * g1[k]; }
        __syncthreads();
        for (int c = tid; c < DIN; c += 512) { float a = 0.f; for (int k = 0; k < DM; ++k) a += hrow[k] * w_in[(size_t)k * DIN + c]; z[c] = a; }
        __syncthreads();
        float e1 = 0.f, g1 = 0.f;
        for (int c = tid; c < 512; c += 512) dbg_upd(e1, g1, bf2f(AQ[m * 512 + c]), z[c] * C2A);
        float e1b = 0.f, g1b = 0.f;
        for (int c = tid; c < 64; c += 512) { dbg_upd(e1b, g1b, bf2f(AK[m * 64 + c]), z[512 + c]); dbg_upd(e1b, g1b, bf2f(AVT[((size_t)b * 64 + c) * SEQ + t]), z[576 + c]); dbg_upd(e1b, g1b, bf2f(IK[m * 64 + c]), z[896 + c]); }
        for (int c = tid; c < 256; c += 512) dbg_upd(e1b, g1b, bf2f(IQ[m * 256 + c]), z[640 + c]);
        for (int c = tid; c < 4; c += 512) dbg_upd(e1b, g1b, IW[m * 4 + c], z[960 + c]);
        float e1c = 0.f, g1c = 0.f;
        for (int c = tid; c < 2048; c += 512) dbg_upd(e1c, g1c, bf2f(GATES[m * 2048 + c]), 1.f / (1.f + expf(-(z[1380 + c] + b_gate[c]))));
        { const float ea = dbg_block_max(red, e1, tid), ga = dbg_block_max(red, g1, tid), eb = dbg_block_max(red, e1b, tid), gb = dbg_block_max(red, g1b, tid), ec = dbg_block_max(red, e1c, tid), gc = dbg_block_max(red, g1c, tid);
          if (tid == 0) atomicMax(ctl + DBG_W_DIR, __float_as_uint(fmaxf(fmaxf(ea / (ga + 1e-20f), eb / (gb + 1e-20f)), ec / (gc + 1e-20f)))); }
        float sq = 0.f; for (int k = tid; k < 256; k += 512) sq += z[964 + k] * z[964 + k];
        const float rq = 1.f / sqrtf(dbg_block_sum(red, sq, tid) / 256.f + EPS);
        float sk = 0.f; for (int k = tid; k < 128; k += 512) sk += z[1220 + k] * z[1220 + k];
        const float rk = 1.f / sqrtf(dbg_block_sum(red, sk, tid) / 128.f + EPS);
        for (int n = tid; n < 768; n += 512) { float a = 0.f; for (int k = 0; k < 256; ++k) a += z[964 + k] * rq * gq[k] * w_uq[(size_t)k * 768 + n]; qb[n] = a; }
        for (int n = tid; n < 1024; n += 512) { float a = 0.f; for (int k = 0; k < 128; ++k) a += z[1220 + k] * rk * gkv[k] * w_ukv[(size_t)k * 1024 + n]; kvb[n] = a; }
        __syncthreads();
        float e2 = 0.f, g2 = 0.f, e3 = 0.f, g3 = 0.f;
        const double p = (double)pos[m];
        for (int n = tid; n < 768; n += 512) { const int h = n / 96, c = n % 96; float ref;
            if (c < 64) ref = qb[n];
            else { const int j = c - 64, i = j >> 1; const double ang = p * pow(10000.0, -(double)(2 * i) / 32.0); const float cs = (float)cos(ang), sn = (float)sin(ang);
                   const float x1 = qb[h * 96 + 64 + i], x2 = qb[h * 96 + 80 + i]; ref = (j & 1) ? (x1 * sn + x2 * cs) : (x1 * cs - x2 * sn); }
            dbg_upd(e2, g2, bf2f(QB[m * 768 + n]), ref * C2B); }
        for (int n = tid; n < 512; n += 512) { const int h = n >> 6, d = n & 63;
            dbg_upd(e3, g3, bf2f(KN[m * 512 + n]), kvb[h * 128 + d]); dbg_upd(e3, g3, bf2f(VT[(size_t)n * M + m]), kvb[h * 128 + 64 + d]); }
        float e3b = 0.f, g3b = 0.f;
        for (int j = tid; j < 32; j += 512) { const int i = j >> 1; const double ang = p * pow(10000.0, -(double)(2 * i) / 32.0); const float cs = (float)cos(ang), sn = (float)sin(ang);
            const float x1 = z[1348 + i], x2 = z[1364 + i]; const float ref = (j & 1) ? (x1 * sn + x2 * cs) : (x1 * cs - x2 * sn); dbg_upd(e3b, g3b, bf2f(KR[m * 32 + j]), ref); }
        { const float ea = dbg_block_max(red, e2, tid), ga = dbg_block_max(red, g2, tid), eb = dbg_block_max(red, e3, tid), gb = dbg_block_max(red, g3, tid), ec = dbg_block_max(red, e3b, tid), gc = dbg_block_max(red, g3b, tid);
          if (tid == 0) { atomicMax(ctl + DBG_W_QB, __float_as_uint(ea / (ga + 1e-20f))); atomicMax(ctl + DBG_W_KV, __float_as_uint(fmaxf(eb / (gb + 1e-20f), ec / (gc + 1e-20f)))); } }
        __syncthreads();
    }
}

constexpr int DBG_W_CK = 32;
__device__ __forceinline__ void dbg_checksum(unsigned char* ws, float* outbuf, int phase, int rep, int bx, int G, int tid) {
    size_t lo = 0, hi = 0; const unsigned* base = (const unsigned*)ws;
    if (phase == 0) { lo = 1 * MiB; hi = 100 * MiB; }
    else if (phase == 1) { lo = 5 * MiB; hi = 7 * MiB; }
    else if (phase == 2) { lo = 356 * MiB; hi = 468 * MiB; }
    else if (phase == 3) { lo = 100 * MiB; hi = 164 * MiB; }
    else if (phase == 4) { lo = 356 * MiB; hi = 420 * MiB; }
    else { base = (const unsigned*)outbuf; lo = 0; hi = 128 * MiB; }
    unsigned long long acc = 0ull;
    for (size_t i = lo / 4 + (size_t)bx * 512 + tid; i < hi / 4; i += (size_t)G * 512) acc += (unsigned long long)base[i] * (unsigned long long)((i & 1023u) + 1u);
    if (phase == 1) for (size_t i = (100 * MiB) / 4 + (size_t)bx * 512 + tid; i < (356 * MiB) / 4; i += (size_t)G * 512) acc += (unsigned long long)base[i] * (unsigned long long)((i & 1023u) + 1u);
    if (phase == 2) for (size_t i = (220 * MiB) / 4 + (size_t)bx * 512 + tid; i < (228 * MiB) / 4; i += (size_t)G * 512) acc += (unsigned long long)base[i] * (unsigned long long)((i & 1023u) + 1u);
    for (int o = 1; o < 64; o <<= 1) acc += __shfl_xor(acc, o);
    if ((tid & 63) == 0) atomicAdd((unsigned long long*)(ws + WS_CTL) + (DBG_W_CK / 2 + 2 * phase + rep), acc);
}
__device__ __forceinline__ float dbg_output_scale(unsigned char* ws) {
    const unsigned* ctl = (const unsigned*)(ws + WS_CTL);
    float e[6]; for (int i = 0; i < 6; ++i) e[i] = __uint_as_float(__hip_atomic_load(ctl + 16 + i, __ATOMIC_RELAXED, __HIP_MEMORY_SCOPE_AGENT));
    const unsigned mm = __hip_atomic_load(ctl + DBG_W_MASK, __ATOMIC_RELAXED, __HIP_MEMORY_SCOPE_AGENT);
#define DBG_BK(x) ((x) < 0.04f ? 0 : ((x) < 0.2f ? 1 : 2))
#if DBG_CHECK == 3
    { const unsigned long long* ck = (const unsigned long long*)(ws + WS_CTL) + DBG_W_CK / 2; int k = 0;
      for (int p = 0; p < 6; ++p) { const unsigned long long a = __hip_atomic_load(ck + 2 * p, __ATOMIC_RELAXED, __HIP_MEMORY_SCOPE_AGENT), b = __hip_atomic_load(ck + 2 * p + 1, __ATOMIC_RELAXED, __HIP_MEMORY_SCOPE_AGENT); if (a != b) k += (1 << p); }
      (void)e; (void)mm; return 1.f + (float)k; }
    const int c1 = 0, c2 = 0, c3 = 0;
#elif DBG_CHECK == 1
    const int c1 = DBG_BK(e[0]), c2 = mm <= 20u ? 0 : (mm <= 2000u ? 1 : 2), c3 = DBG_BK(e[2]);
#else
    const int c1 = DBG_BK(e[3]), c2 = DBG_BK(e[4]), c3 = DBG_BK(e[5]);
#endif
    return 1.f + (float)(c1 + 3 * c2 + 9 * c3);
}
#endif
struct Args { const void* in[17]; float* out; unsigned char* ws; int ph_lo, ph_hi; };
__global__ void __launch_bounds__(NWAVES * 64, 2) trunk_fwd(Args args) {
    extern __shared__ __attribute__((aligned(16))) unsigned char lds[];
    Frame F;
    F.lds = (LAS unsigned char*)lds;
    F.tid = threadIdx.x; F.lane = F.tid & 63; F.wave = __builtin_amdgcn_readfirstlane(F.tid >> 6);
    F.G = gridDim.x; F.bx = blockIdx.x;
    F.x = (const float*)args.in[0]; F.pos = (const int*)args.in[1]; F.rel_bias = (const float*)args.in[15]; F.out = args.out; F.ws = args.ws;
    volatile LAS unsigned* MISC = (volatile LAS unsigned*)(F.lds + MISC_OFF);
    if (F.tid < 32) MISC[F.tid] = 0u;
#if defined(DBG_LDS_FILL)
    for (int i = F.tid; i < MISC_OFF / 4; i += NWAVES * 64) ((LAS unsigned*)F.lds)[i] = 0xffffffffu;
#endif
    __syncthreads();
    unsigned* ctl = (unsigned*)(F.ws + WS_CTL);
#if MK_ONE_LAUNCH
    XcdBarrier bar = xcd_barrier_post(ctl + CW_BAR, MISC + 8);
#define GRID_BAR() xcd_barrier(bar)
#else
#define GRID_BAR() do { } while (0)
#endif
    const float* g1 = (const float*)args.in[2]; const float* w_in = (const float*)args.in[3]; const float* b_gate = (const float*)args.in[4];
    const float* gq = (const float*)args.in[5]; const float* gkv = (const float*)args.in[6]; const float* w_uq = (const float*)args.in[7]; const float* w_ukv = (const float*)args.in[8];
    const float* w_a = (const float*)args.in[9]; const float* w_b = (const float*)args.in[10]; const float* w_out = (const float*)args.in[11]; const float* g2 = (const float*)args.in[12];
    const float* w_ff1 = (const float*)args.in[13]; const float* w_ff2 = (const float*)args.in[14]; const float* gf = (const float*)args.in[16];
#define PHASE_FRAME() \
    { int t_ = threadIdx.x; asm volatile("" : "+v"(t_)); F.tid = t_; F.lane = t_ & 63; F.wave = __builtin_amdgcn_readfirstlane(t_ >> 6); } \
    size_t z0_ = 0; asm volatile("" : "+s"(z0_)); unsigned char* ws = args.ws + z0_; F.ws = ws;     \
    bf16* WB = (bf16*)(ws + WS_W); bf16* H = (bf16*)(ws + WS_H); bf16* YA = (bf16*)(ws + WS_YA); \
    bf16* IQ = (bf16*)(ws + WS_IQ); bf16* CQ = (bf16*)(ws + WS_CQ); bf16* CKV = (bf16*)(ws + WS_CKV); bf16* AK = (bf16*)(ws + WS_AK); bf16* AVT = (bf16*)(ws + WS_AVT); \
    bf16* IK = (bf16*)(ws + WS_IK); bf16* KR = (bf16*)(ws + WS_KR); bf16* GATES = (bf16*)(ws + WS_GATES); bf16* QB = (bf16*)(ws + WS_QB); bf16* KN = (bf16*)(ws + WS_KN); \
    bf16* VT = (bf16*)(ws + WS_VT); bf16* MERGED = (bf16*)(ws + WS_MERGED); bf16* HID = (bf16*)(ws + WS_HID); \
    float* CS = (float*)(ws + WS_CS); float* SSQQ = (float*)(ws + WS_SSQQ); float* SSQKV = (float*)(ws + WS_SSQKV); float* IW = (float*)(ws + WS_IW); \
    (void)WB; (void)H; (void)YA; (void)IQ; (void)CQ; (void)CKV; (void)AK; (void)AVT; (void)IK; (void)KR; (void)GATES; (void)QB; (void)KN; (void)VT; (void)MERGED; (void)HID; (void)CS; (void)SSQQ; (void)SSQKV; (void)IW;
    const int lo = args.ph_lo, hi = args.ph_hi;
#ifndef DBG_ATT_SCALE
#define DBG_ATT_SCALE 1.0f
#endif
#ifndef PH_ENABLE
#define PH_ENABLE 0x3ff
#endif
#define PHON(k) (((PH_ENABLE) >> (k)) & 1)
#define IN(p) (lo <= (p) && (p) < hi)
#if defined(DBG_CHECK)
    if (lo == 1000) { dbg_check_attn(args.ws, F.out, F.pos, F.rel_bias, F.lds, F.bx, F.G, F.tid); return; }
    if (lo >= 2000 && lo < 2100) { dbg_checksum(args.ws, F.out, (lo - 2000) >> 1, (lo - 2000) & 1, F.bx, F.G, F.tid); return; }
    if (lo == 3000) {
        u32x4* w4 = (u32x4*)(args.ws + DBG_FILL_LO); const u32x4 nn = (u32x4){0xffffffffu, 0xffffffffu, 0xffffffffu, 0xffffffffu};
        for (size_t i = (size_t)F.bx * 512 + F.tid; i < (DBG_FILL_HI - DBG_FILL_LO) / 16; i += (size_t)F.G * 512) w4[i] = nn;
        u32x4* o4 = (u32x4*)F.out; for (size_t i = (size_t)F.bx * 512 + F.tid; i < (size_t)M * DM * 4 / 16; i += (size_t)F.G * 512) o4[i] = nn;
        return; }
    if (lo == 4000) {
        const unsigned* src = (const unsigned*)(args.ws + (size_t)(DBG_PROBE_OFF) * MiB);
        for (size_t i = (size_t)F.bx * 512 + F.tid; i < (size_t)M * DM; i += (size_t)F.G * 512) { const unsigned w = src[i];
            float a = __uint_as_float(w << 16), b = __uint_as_float(w & 0xffff0000u); if (!(fabsf(a) < 1e30f)) a = 0.f; if (!(fabsf(b) < 1e30f)) b = 0.f; F.out[i] = a + 2.f * b; }
        return; }
    if (lo == 1001) { dbg_check_proj(args.ws, F.pos, g1, w_in, b_gate, gq, gkv, w_uq, w_ukv, F.lds, F.bx, F.G, F.tid); return; }
#endif
#if defined(DBG_SPLIT_BR)
    if (lo >= 5000 && lo < 5008) { PHASE_FRAME();
        pg8::Gemm g{YA, WB + W_AB_OFF, 2 * M, 2048, 512}; pg8::BranchOrder S; S.init(F.G, F.bx, lo & 1); pg8::EpiBranch E{MERGED, GATES};
        pg8::gemm_phase<pg8::EpiBranch, pg8::BranchOrder, true, true, false, true>(F.lds, g, S, E);
        return; }
#endif
#if defined(DBG_TIME_PH)
    unsigned long long tacc_ = 0ull, tprev_ = __builtin_amdgcn_s_memrealtime();
#define TSTAMP(k_) do { const unsigned long long tn_ = __builtin_amdgcn_s_memrealtime(); if ((k_) == (DBG_TIME_PH)) tacc_ += tn_ - tprev_; tprev_ = tn_; } while (0)
#else
#define TSTAMP(k_) do { } while (0)
#endif
    for (int l = 0; l < DEPTH; ++l) {
        const int p0 = l * PH_PER_LAYER;
        const float* xcur = (l == 0) ? F.x : F.out;
        if (PHON(0) && IN(p0 + 0) && l == 0) { PHASE_FRAME();
            rope_table(F); pos_tables(F);
            prep_weights<0>(F, 0, 0, g1, g2, w_in, gq, gkv, w_uq, w_ukv, w_a, w_b, w_out, w_ff1, w_ff2, F.G * NWAVES, false);
            init_rows(F);
            GRID_BAR(); TSTAMP(0);
        }
        if (PHON(1) && IN(p0 + 1)) { PHASE_FRAME();
            quant_rows(F, 1); GRID_BAR();
            pg8::Gemm g{(const bf16*)(ws + WS_XB8), WB + W_IN_OFF, M, NIN, DM / 2}; pg8::StaticOrder S; S.init(M, NIN, F.G, F.bx);
            pg8::EpiIn8 E{YA, IQ, CQ, CKV, AK, AVT, IK, KR, GATES, IW, SSQQ, SSQKV, CS, b_gate + l * 2048, (const float*)(ws + WS_SX), (const float*)(ws + WS_SWI)};
            pg8::gemm_phase<pg8::EpiIn8, pg8::StaticOrder, true, true, true, true>(F.lds, g, S, E);
            GRID_BAR(); TSTAMP(1);
        }
        if (PHON(2) && IN(p0 + 2)) { PHASE_FRAME();
#ifndef SUB_ENABLE
#define SUB_ENABLE 0xf
#endif
            if ((SUB_ENABLE) & 1) { pg8::Gemm g{CQ, WB + W_UQ_OFF, M, 768, 256}; pg8::StaticOrder S; S.init(M, 768, F.G, F.bx); pg8::EpiUQ E{QB, SSQQ, CS};
              pg8::gemm_phase<pg8::EpiUQ, pg8::StaticOrder, true, true, false, true>(F.lds, g, S, E); }
            if ((SUB_ENABLE) & 2) { pg8::Gemm g{CKV, WB + W_UK_OFF, M, 512, 128}; pg8::StaticOrder S; S.init(M, 512, F.G, F.bx); pg8::EpiUK E{KN, SSQKV};
              pg8::gemm_phase<pg8::EpiUK, pg8::StaticOrder, true, true, false, true>(F.lds, g, S, E); }
            if ((SUB_ENABLE) & 4) { pg8::Gemm g{WB + W_UV_OFF, CKV, 512, M, 128}; pg8::StaticOrder S; S.init(512, M, F.G, F.bx); pg8::EpiUV E{VT, SSQKV};
              pg8::gemm_phase<pg8::EpiUV, pg8::StaticOrder, true, true, true, false>(F.lds, g, S, E); }
            prep_ff1_int8(F, l, 0, g2, w_ff1);
            if ((SUB_ENABLE) & 8) idx_phase(F);
#if defined(DBG_CHECK)
            if (l == 0) dbg_copy_aq(F.ws, F.out, F.bx, F.G, F.tid);
#endif
            GRID_BAR(); TSTAMP(2);
        }
        if (PHON(3) && IN(p0 + 3)) { PHASE_FRAME(); attn_phase(F);
            {
              const int wgi = (l + 1 < DEPTH && F.G > NIN / 32) ? F.G - NIN / 32 : F.G, nwi = wgi * NWAVES;
              prep_weights<1>(F, l, 49152, g1, g2, w_in, gq, gkv, w_uq, w_ukv, w_a, w_b, w_out, w_ff1, w_ff2, nwi, false);
              if (l + 1 < DEPTH) prep_weights<0>(F, l + 1, 49152, g1, g2, w_in, gq, gkv, w_uq, w_ukv, w_a, w_b, w_out, w_ff1, w_ff2, nwi, true); }
            { unsigned long long* rs = (unsigned long long*)(ws + WS_RSS);
              unsigned* rm = (unsigned*)(ws + WS_RMAX);
              for (int e = F.bx * (NWAVES * 64) + F.tid; e < 2 * M; e += F.G * NWAVES * 64) { rs[e] = 0ull; rm[e] = 0u; } }
            GRID_BAR(); TSTAMP(3); }
        if (PHON(4) && IN(p0 + 4)) { PHASE_FRAME();
            pg8::Gemm g{YA, WB + W_AB_OFF, 2 * M, 2048, 512}; pg8::BranchOrder S; S.init(F.G, F.bx); pg8::EpiBranch E{MERGED, GATES};
            pg8::gemm_phase<pg8::EpiBranch, pg8::BranchOrder, true, true, false, true>(F.lds, g, S, E);
            GRID_BAR(); TSTAMP(4);
        }
        if (PHON(5) && IN(p0 + 5)) { PHASE_FRAME();
            pg8::Gemm g{MERGED, WB + W_OUT_OFF, M, DM, DM}; pg8::StaticOrder S; S.init(M, DM, F.G, F.bx); pg8::EpiResT<true> E{H, (unsigned long long*)(ws + WS_RSS), (unsigned*)(ws + WS_RMAX)};
            pg8::gemm_phase<pg8::EpiResT<true>, pg8::StaticOrder, true, true, false, true>(F.lds, g, S, E);
            GRID_BAR(); TSTAMP(5);
        }
        if (PHON(7) && IN(p0 + 7)) { PHASE_FRAME();
            quant_rows(F, 0); GRID_BAR();
            pg8::Gemm g{(const bf16*)(ws + WS_XB8), WB + W_FF1_OFF, M, DFF, DM / 2}; pg8::StaticOrder S; S.init(M, DFF, F.G, F.bx);
            pg8::EpiFF18 E{HID, (const float*)(ws + WS_SX), (const float*)(ws + WS_SWF)};
            pg8::gemm_phase<pg8::EpiFF18, pg8::StaticOrder, true, true, true, true>(F.lds, g, S, E);
            GRID_BAR(); TSTAMP(7);
        }
        if (PHON(8) && IN(p0 + 8)) { PHASE_FRAME();
            pg8::Gemm g{HID, WB + W_FF2_OFF, M, DM, DFF}; pg8::StaticOrder S; S.init(M, DM, F.G, F.bx); pg8::EpiResT<true> E{H, (unsigned long long*)(ws + WS_RSS) + M, (unsigned*)(ws + WS_RMAX) + M};
            pg8::gemm_phase<pg8::EpiResT<true>, pg8::StaticOrder, true, true, true, true>(F.lds, g, S, E);
            GRID_BAR(); TSTAMP(8);
        }
    }
#if defined(DBG_TIME_PH)
    if (F.bx == 0 && F.tid == 0) __hip_atomic_store((unsigned*)(args.ws + WS_CTL) + 40, (unsigned)(tacc_ / (unsigned long long)(DBG_TIME_DIV)), __ATOMIC_RELAXED, __HIP_MEMORY_SCOPE_AGENT);
    GRID_BAR();
#endif
    if (PHON(9) && IN(DEPTH * PH_PER_LAYER)) { PHASE_FRAME(); float osc = 1.f;
#if defined(DBG_TIME_PH)
        osc = 1.f + (float)__hip_atomic_load((unsigned*)(args.ws + WS_CTL) + 40, __ATOMIC_RELAXED, __HIP_MEMORY_SCOPE_AGENT);
#endif
#if defined(DBG_CHECK)
        osc = dbg_output_scale(F.ws);
#endif
        final_norm(F, gf, osc); }
#undef IN
}

extern "C" void kernel_launch(void* const* d_in, const int* in_sizes, int n_in, void* d_out, int out_size, void* d_ws, size_t ws_size, hipStream_t stream) {
    static int grid = 0;
    if (grid == 0) {
        if (n_in != 17 || in_sizes[0] != M * DM || out_size != M * DM || ws_size < WS_END) { fprintf(stderr, "kernel_launch: unexpected shapes (n_in %d, in0 %d, out %d, ws %zu); nothing launched\n", n_in, n_in > 0 ? in_sizes[0] : -1, out_size, ws_size); grid = -1; return; }
        int dev = 0, cus = 0, per_cu = 0;
        if (hipGetDevice(&dev) != hipSuccess || hipDeviceGetAttribute(&cus, hipDeviceAttributeMultiprocessorCount, dev) != hipSuccess) { grid = -1; return; }
        if (hipFuncSetAttribute((const void*)trunk_fwd, hipFuncAttributeMaxDynamicSharedMemorySize, LDS_BYTES) != hipSuccess) { fprintf(stderr, "kernel_launch: hipFuncSetAttribute failed\n"); grid = -1; return; }
        if (hipOccupancyMaxActiveBlocksPerMultiprocessor(&per_cu, (const void*)trunk_fwd, NWAVES * 64, LDS_BYTES) != hipSuccess || per_cu < 1)
            fprintf(stderr, "kernel_launch: note: occupancy query reports %d workgroups per CU\n", per_cu);
        (void)hipGetLastError();
        grid = cus;
    }
    if (grid < 0) return;
    if (hipMemsetAsync((char*)d_ws + WS_CTL, 0, CTL_ZERO_BYTES, stream) != hipSuccess) return;
    Args a{};
    for (int i = 0; i < 17; ++i) a.in[i] = d_in[i];
    a.out = (float*)d_out; a.ws = (unsigned char*)d_ws;
#if MK_ONE_LAUNCH
    a.ph_lo = 0; a.ph_hi = N_PHASES;
    hipLaunchKernelGGL(trunk_fwd, dim3(grid), dim3(NWAVES * 64), LDS_BYTES, stream, a);
#elif defined(DBG_CHECK) && DBG_CHECK == 3
#define DBG_L(a_, b_) do { a.ph_lo = (a_); a.ph_hi = (b_); hipLaunchKernelGGL(trunk_fwd, dim3(grid), dim3(NWAVES * 64), LDS_BYTES, stream, a); } while (0)
    DBG_L(0, 1); DBG_L(2000, 2001); DBG_L(0, 1); DBG_L(2001, 2002);
    DBG_L(1, 2); DBG_L(2002, 2003); DBG_L(1, 2); DBG_L(2003, 2004);
    DBG_L(2, 3); DBG_L(2004, 2005); DBG_L(2, 3); DBG_L(2005, 2006);
    DBG_L(3, 4); DBG_L(2006, 2007); DBG_L(1, 2); DBG_L(3, 4); DBG_L(2007, 2008);
    DBG_L(4, 5); DBG_L(2008, 2009); DBG_L(2, 3); DBG_L(4, 5); DBG_L(2009, 2010);
    DBG_L(5, 6); DBG_L(2010, 2011); DBG_L(5, 6); DBG_L(2011, 2012);
    for (int p = 6; p < N_PHASES; ++p) DBG_L(p, p + 1);
#elif defined(DBG_CHECK) && DBG_CHECK == 5
    a.ph_lo = 3000; a.ph_hi = 3001; hipLaunchKernelGGL(trunk_fwd, dim3(grid), dim3(NWAVES * 64), LDS_BYTES, stream, a);
    for (int p = 0; p < (DBG_PROBE_PH); ++p) { a.ph_lo = p; a.ph_hi = p + 1; hipLaunchKernelGGL(trunk_fwd, dim3(grid), dim3(NWAVES * 64), LDS_BYTES, stream, a); }
    if ((DBG_PROBE_OFF) >= 0) { a.ph_lo = 4000; a.ph_hi = 4001; hipLaunchKernelGGL(trunk_fwd, dim3(grid), dim3(NWAVES * 64), LDS_BYTES, stream, a); }
#elif defined(DBG_CHECK) && DBG_CHECK == 4
    a.ph_lo = 3000; a.ph_hi = 3001; hipLaunchKernelGGL(trunk_fwd, dim3(grid), dim3(NWAVES * 64), LDS_BYTES, stream, a);
    for (int p = 0; p < N_PHASES; ++p) { a.ph_lo = p; a.ph_hi = p + 1; hipLaunchKernelGGL(trunk_fwd, dim3(grid), dim3(NWAVES * 64), LDS_BYTES, stream, a); }
#else
    for (int p = 0; p < N_PHASES; ++p) {
#if defined(DBG_SPLIT_BR)
        if (p < DEPTH * PH_PER_LAYER && p % PH_PER_LAYER == 4) { for (int br = 0; br < 2; ++br) { a.ph_lo = 5000 + 2 * (p / PH_PER_LAYER) + br; a.ph_hi = a.ph_lo + 1; hipLaunchKernelGGL(trunk_fwd, dim3(grid), dim3(NWAVES * 64), LDS_BYTES, stream, a); } continue; }
#endif
        a.ph_lo = p; a.ph_hi = p + 1; hipLaunchKernelGGL(trunk_fwd, dim3(grid), dim3(NWAVES * 64), LDS_BYTES, stream, a);
#if defined(DBG_CHECK)
        if (p == 3) { a.ph_lo = 1000; a.ph_hi = 1001; hipLaunchKernelGGL(trunk_fwd, dim3(grid), dim3(NWAVES * 64), LDS_BYTES, stream, a); }
        if (p == 2) { a.ph_lo = 1001; a.ph_hi = 1002; hipLaunchKernelGGL(trunk_fwd, dim3(grid), dim3(NWAVES * 64), LDS_BYTES, stream, a); }
#endif
    }
#endif
}
```
